# Optimizing an MI355X kernel written in HIP

```python
import jax
import jax.numpy as jnp
from jax import lax

D_MODEL = 2048
BATCH = 4
SEQ = 4096
DEPTH = 4

CTX_LEN = 256
GRID_W = 64
HEAD_DIM = 128
N_HEADS = 8
N_KV_HEADS = 2
Q_PER_KV = N_HEADS // N_KV_HEADS
ATTN_WIDTH = N_HEADS * HEAD_DIM
KV_WIDTH = N_KV_HEADS * HEAD_DIM
CONV_WIDTH = D_MODEL - ATTN_WIDTH
CONV_K = 3
IN_WIDTH = ATTN_WIDTH + 2 * KV_WIDTH + 3 * CONV_WIDTH
IN_SPLITS = (
    ATTN_WIDTH,
    ATTN_WIDTH + KV_WIDTH,
    ATTN_WIDTH + 2 * KV_WIDTH,
    ATTN_WIDTH + 2 * KV_WIDTH + CONV_WIDTH,
    ATTN_WIDTH + 2 * KV_WIDTH + 2 * CONV_WIDTH,
)
MLP_HIDDEN = 4 * D_MODEL
N_MOD = 6
ROPE_THETA = 10000.0
AXIS_DIM = HEAD_DIM // 2
BLOCK_Q = 128
EPS = 1e-6

kernel_name = 'hybrid_dit_parallel_shortconv_gqa'


def rms_norm(x, g):
    x32 = x.astype(jnp.float32)
    y = x32 * lax.rsqrt(jnp.mean(x32 * x32, axis=-1, keepdims=True) + EPS)
    return (y * g.astype(jnp.float32)).astype(x.dtype)


def modulate(h, shift, scale):
    return h * (1 + scale) + shift


def adaln(cond, w, b):
    return [m[..., None, :] for m in jnp.split(jax.nn.silu(cond) @ w + b, N_MOD, axis=-1)]


def axial_rope_tables(rows):
    row = jnp.broadcast_to(jnp.arange(rows, dtype=jnp.float32)[:, None], (rows, GRID_W)).reshape(-1)
    col = jnp.broadcast_to(jnp.arange(GRID_W, dtype=jnp.float32)[None, :], (rows, GRID_W)).reshape(-1)
    inv_freq = ROPE_THETA ** (-jnp.arange(0, AXIS_DIM, 2, dtype=jnp.float32) / AXIS_DIM)
    ang_r = row[:, None] * inv_freq[None, :]
    ang_c = col[:, None] * inv_freq[None, :]
    ang_r = jnp.concatenate([ang_r, ang_r], axis=-1)
    ang_c = jnp.concatenate([ang_c, ang_c], axis=-1)
    return jnp.cos(ang_r), jnp.sin(ang_r), jnp.cos(ang_c), jnp.sin(ang_c)


def _rotate_axis(x, cos, sin):
    x1, x2 = jnp.split(x, 2, axis=-1)
    return x * cos + jnp.concatenate([-x2, x1], axis=-1) * sin


def apply_axial_rope(x, tables):
    cos_r, sin_r, cos_c, sin_c = [t[None, :, None, :] for t in tables]
    xr, xc = jnp.split(x.astype(jnp.float32), 2, axis=-1)
    out = jnp.concatenate([_rotate_axis(xr, cos_r, sin_r), _rotate_axis(xc, cos_c, sin_c)], axis=-1)
    return out.astype(x.dtype)


def gqa_attend(q, k, v):
    s = jnp.einsum('bqhrd,bthd->bhrqt', q, k, preferred_element_type=jnp.float32) * (HEAD_DIM ** -0.5)
    p = jax.nn.softmax(s, axis=-1).astype(v.dtype)
    return jnp.einsum('bhrqt,bthd->bqhrd', p, v)


def latent_attention(q, k, v):
    b, s = q.shape[0], q.shape[1]
    n_blocks = s // BLOCK_Q
    qb = q.reshape(b, n_blocks, BLOCK_Q, N_KV_HEADS, Q_PER_KV, HEAD_DIM).swapaxes(0, 1)
    out = lax.map(lambda blk: gqa_attend(blk, k, v), qb)
    return out.swapaxes(0, 1).reshape(b, s, ATTN_WIDTH)


def context_attention(q, k, v):
    b, t = q.shape[0], q.shape[1]
    qg = q.reshape(b, t, N_KV_HEADS, Q_PER_KV, HEAD_DIM)
    return gqa_attend(qg, k, v).reshape(b, t, ATTN_WIDTH)


def mixer_inputs(h, w_in, q_g, k_g):
    b, t = h.shape[0], h.shape[1]
    q, k, v, gate_b, gate_c, u = jnp.split(h @ w_in, list(IN_SPLITS), axis=-1)
    q = rms_norm(q.reshape(b, t, N_HEADS, HEAD_DIM), q_g)
    k = rms_norm(k.reshape(b, t, N_KV_HEADS, HEAD_DIM), k_g)
    v = v.reshape(b, t, N_KV_HEADS, HEAD_DIM)
    return q, k, v, gate_b, gate_c, u


def short_conv_mixer(gate_b, gate_c, u, w, bias):
    z = jnp.pad(gate_c * u, ((0, 0), (1, 1), (0, 0)))
    conv = z[:, :-2] * w[0] + z[:, 1:-1] * w[1] + z[:, 2:] * w[2] + bias
    return gate_b * conv


def merge_heads(attn, conv, attn_g, conv_g, w_out):
    return jnp.concatenate([rms_norm(attn, attn_g), rms_norm(conv, conv_g)], axis=-1) @ w_out


def sq_relu_mlp(h, w1, w2):
    return jnp.square(jax.nn.relu(h @ w1)) @ w2


def setup_inputs(seed: int = 0) -> dict:
    key = jax.random.key(seed)
    ks = jax.random.split(key, 18)
    f32 = jnp.float32

    def nrm(k, shape, scale):
        return jax.random.normal(k, shape, f32) * scale

    def gain(k, shape):
        return 1.0 + nrm(k, shape, 0.05)

    return {
        'x': nrm(ks[0], (BATCH, SEQ, D_MODEL), 1.0),
        'c': nrm(ks[1], (BATCH, D_MODEL), 1.0),
        'ctx': nrm(ks[2], (BATCH, CTX_LEN, D_MODEL), 1.0),
        'c_ctx': nrm(ks[3], (D_MODEL,), 1.0),
        'w_ada': nrm(ks[4], (DEPTH, D_MODEL, N_MOD * D_MODEL), 0.5 * D_MODEL ** -0.5),
        'b_ada': nrm(ks[5], (DEPTH, N_MOD * D_MODEL), 0.02),
        'norm1_g': gain(ks[6], (DEPTH, D_MODEL)),
        'w_in': nrm(ks[7], (DEPTH, D_MODEL, IN_WIDTH), D_MODEL ** -0.5),
        'q_norm_g': gain(ks[8], (DEPTH, HEAD_DIM)),
        'k_norm_g': gain(ks[9], (DEPTH, HEAD_DIM)),
        'conv_w': nrm(ks[10], (DEPTH, CONV_K, CONV_WIDTH), CONV_K ** -0.5),
        'conv_b': nrm(ks[11], (DEPTH, CONV_WIDTH), 0.02),
        'attn_out_g': gain(ks[12], (DEPTH, ATTN_WIDTH)),
        'conv_out_g': gain(ks[13], (DEPTH, CONV_WIDTH)),
        'w_out': nrm(ks[14], (DEPTH, D_MODEL, D_MODEL), D_MODEL ** -0.5),
        'norm2_g': gain(ks[15], (DEPTH, D_MODEL)),
        'w_mlp_in': nrm(ks[16], (DEPTH, D_MODEL, MLP_HIDDEN), D_MODEL ** -0.5),
        'w_mlp_out': nrm(ks[17], (DEPTH, MLP_HIDDEN, D_MODEL), MLP_HIDDEN ** -0.5),
    }


def reference(x, c, ctx, c_ctx, w_ada, b_ada, norm1_g, w_in, q_norm_g, k_norm_g,
              conv_w, conv_b, attn_out_g, conv_out_g, w_out, norm2_g, w_mlp_in, w_mlp_out):
    rows = x.shape[1] // GRID_W
    tables = axial_rope_tables(rows)
    for l in range(DEPTH):
        sh1, sc1, g1, sh2, sc2, g2 = adaln(c, w_ada[l], b_ada[l])
        csh1, csc1, cg1, csh2, csc2, cg2 = adaln(c_ctx, w_ada[l], b_ada[l])

        hx = modulate(rms_norm(x, norm1_g[l]), sh1, sc1)
        hc = modulate(rms_norm(ctx, norm1_g[l]), csh1, csc1)
        qx, kx, vx, bx, cx, ux = mixer_inputs(hx, w_in[l], q_norm_g[l], k_norm_g[l])
        qc, kc, vc, bc, cc, uc = mixer_inputs(hc, w_in[l], q_norm_g[l], k_norm_g[l])

        qx = apply_axial_rope(qx, tables)
        kx = apply_axial_rope(kx, tables)
        k_all = jnp.concatenate([kx, kc], axis=1)
        v_all = jnp.concatenate([vx, vc], axis=1)
        attn_x = latent_attention(qx, k_all, v_all)
        conv_x = short_conv_mixer(bx, cx, ux, conv_w[l], conv_b[l])
        x_new = x + g1 * merge_heads(attn_x, conv_x, attn_out_g[l], conv_out_g[l], w_out[l])
        x_new = x_new + g2 * sq_relu_mlp(modulate(rms_norm(x_new, norm2_g[l]), sh2, sc2),
                                         w_mlp_in[l], w_mlp_out[l])

        if l < DEPTH - 1:
            attn_c = context_attention(qc, kc, vc)
            conv_c = short_conv_mixer(bc, cc, uc, conv_w[l], conv_b[l])
            ctx = ctx + cg1 * merge_heads(attn_c, conv_c, attn_out_g[l], conv_out_g[l], w_out[l])
            ctx = ctx + cg2 * sq_relu_mlp(modulate(rms_norm(ctx, norm2_g[l]), csh2, csc2),
                                          w_mlp_in[l], w_mlp_out[l])
        x = x_new
    return x
```

```cpp
#include <hip/hip_runtime.h>
#include <cstdio>
#include <cstdint>
namespace pg8 {
#define PG8_LAS __attribute__((address_space(3)))
typedef unsigned short bf16_t;
typedef short bf16x8 __attribute__((ext_vector_type(8)));
typedef float f32x4 __attribute__((ext_vector_type(4)));
typedef unsigned u32x4 __attribute__((ext_vector_type(4)));
constexpr int BM = 256, BK = 64, HALF = 128, HTB = HALF * BK * 2  , STAGE_BYTES = 8 * HTB, NXCD = 8, WGM = 8;

__host__ __device__ __forceinline__ int lds_byte(int r, int c) { const int st = (r >> 4) * 2 + (c >> 5), rr = r & 15, cc = c & 31, ob = rr * 64 + cc * 2; return st * 1024 + (ob ^ (((ob >> 9) & 1) << 5)); }
__host__ __device__ __forceinline__ void stage_rc(int b, int& R, int& C) { const int st = b / 1024, sb = b % 1024, swz = sb ^ (((sb >> 9) & 1) << 5); R = (st >> 1) * 16 + swz / 64; C = (st & 1) * 32 + (swz % 64) / 2; }
__host__ __device__ __forceinline__ int perm32(int rho) { const int n = rho >> 4, i = rho & 15; return 8 * (i >> 2) + 4 * n + (i & 3); }

struct Unit { int pm, pn, k0, nt, kind; };
struct Gemm { const bf16_t* A; const bf16_t* Bt; int M, N, K; };

struct StaticOrder {
    int nM, nN, nwg, G, c, ntf;
    __host__ __device__ void init(int M, int N, int K, int G_, int c_) { nM = M / BM; nN = N / BM; nwg = nM * nN; G = G_; c = c_; ntf = K / BK; }
    __host__ __device__ bool next(int i, Unit& u) const {
        const long L = (long)i * G + c; if (L >= nwg) return false;
        int wgid = (int)L; { const int q = nwg / NXCD, r = nwg % NXCD, xcd = wgid % NXCD, off = wgid / NXCD; wgid = (xcd < r ? xcd * (q + 1) : r * (q + 1) + (xcd - r) * q) + off; }
        const int nig = WGM * nN, gid = wgid / nig, fm = gid * WGM, gsz = (nM - fm) < WGM ? (nM - fm) : WGM;
        u.pm = fm + ((wgid % nig) % gsz); u.pn = (wgid % nig) / gsz; u.k0 = 0; u.nt = ntf; u.kind = 0; return true;
    }
    __device__ __forceinline__ void a_ready(const Unit&) const {}
    __device__ __forceinline__ void done(const Unit&) const {}
};

__device__ __forceinline__ unsigned cvt_pk_bf16(float lo, float hi) { unsigned r; asm volatile("v_cvt_pk_bf16_f32 %0, %1, %2" : "=v"(r) : "v"(lo), "v"(hi)); return r; }
typedef float f32x2 __attribute__((ext_vector_type(2)));


__device__ __forceinline__ float relu1(float x) { float r; asm("v_max_f32 %0, 0, %1" : "=v"(r) : "v"(x)); return r; }
#define PG8_PAIR_STORE(P, LDC, W0, W1) do { const u32x4 snd_ = hb ? (W0) : (W1); u32x4 rcv_; \
    rcv_.x = (unsigned)__builtin_amdgcn_mov_dpp((int)snd_.x, 0xB1, 0xF, 0xF, true); rcv_.y = (unsigned)__builtin_amdgcn_mov_dpp((int)snd_.y, 0xB1, 0xF, 0xF, true); \
    rcv_.z = (unsigned)__builtin_amdgcn_mov_dpp((int)snd_.z, 0xB1, 0xF, 0xF, true); rcv_.w = (unsigned)__builtin_amdgcn_mov_dpp((int)snd_.w, 0xB1, 0xF, 0xF, true); \
    *(u32x4*)(P) = hb ? rcv_ : (W0); *(u32x4*)((P) + (LDC)) = hb ? (W1) : rcv_; } while (0)
template <int ACT, bool ZF = false> struct EpiBf16 {
    static constexpr bool PERM = true, AFTER_DRAIN = false, MIDK = false; static constexpr int MIDK_TILE = 0;
    __device__ __forceinline__ void mid(f32x4 (&)[2][2][4][2], const Unit&, int) const {}
    __device__ __forceinline__ void pre(const Unit&, int, int, int) const {}
    bf16_t* O; int ldc; bf16_t* V;
    __device__ __forceinline__ void operator()(const f32x4 (&acc)[2][2][4][2], const Unit& u, int wr, int wc, int fr, int fq) const {
        const int row0 = u.pm * BM + wr * 64 + fr; const int col0 = u.pn * BM + wc * 64 + 8 * fq;
        if constexpr (ZF) {
            if (u.pn == 5) {
                const int hb = fr & 1, b = u.pm < 64 ? (u.pm >> 4) : (u.pm - 64), pos0 = (u.pm < 64 ? (u.pm & 15) * BM : 4096) + wr * 64 + fr - hb;
                bf16_t* vbase = V + ((size_t)(b * 2 + (wc >> 1)) * 4352 + pos0) * 128 + (wc & 1) * 64 + 8 * fq + 32 * hb;
#pragma unroll
                for (int ai = 0; ai < 2; ++ai)
#pragma unroll
                    for (int m = 0; m < 4; ++m) { u32x4 w[2];
#pragma unroll
                        for (int bj = 0; bj < 2; ++bj) { const f32x4 v0 = acc[ai][bj][m][0], v1 = acc[ai][bj][m][1];
                            w[bj].x = cvt_pk_bf16(v0[0], v0[1]); w[bj].y = cvt_pk_bf16(v0[2], v0[3]); w[bj].z = cvt_pk_bf16(v1[0], v1[1]); w[bj].w = cvt_pk_bf16(v1[2], v1[3]); }
                        bf16_t* rp = vbase + (size_t)(ai * HALF + m * 16) * 128;
                        PG8_PAIR_STORE(rp, 128, w[0], w[1]); }
                return;
            }
            if (u.pn >= 10) {
                const int zc0 = 2560 + (u.pn - 10) * HALF + wc * 32 + 8 * fq;
#pragma unroll
                for (int ai = 0; ai < 2; ++ai)
#pragma unroll
                    for (int m = 0; m < 4; ++m) { const f32x4 v0 = acc[ai][0][m][0] * acc[ai][1][m][0], v1 = acc[ai][0][m][1] * acc[ai][1][m][1];
                        u32x4 w; w.x = cvt_pk_bf16(v0[0], v0[1]); w.y = cvt_pk_bf16(v0[2], v0[3]); w.z = cvt_pk_bf16(v1[0], v1[1]); w.w = cvt_pk_bf16(v1[2], v1[3]);
                        *(u32x4*)(O + (size_t)(row0 + ai * HALF + m * 16) * ldc + zc0) = w; }
                return;
            }
        }
        const int hb = fr & 1; bf16_t* base = O + (size_t)(row0 - hb) * ldc + col0 + 32 * hb;
#pragma unroll
        for (int ai = 0; ai < 2; ++ai)
#pragma unroll
            for (int m = 0; m < 4; ++m) { u32x4 w[2];
#pragma unroll
                for (int bj = 0; bj < 2; ++bj) { f32x4 v0 = acc[ai][bj][m][0], v1 = acc[ai][bj][m][1];
                    if (ACT == 2) { _Pragma("unroll") for (int e_ = 0; e_ < 4; ++e_) { v0[e_] = relu1(v0[e_]); v1[e_] = relu1(v1[e_]); } v0 = v0 * v0; v1 = v1 * v1; }
                    w[bj].x = cvt_pk_bf16(v0[0], v0[1]); w[bj].y = cvt_pk_bf16(v0[2], v0[3]); w[bj].z = cvt_pk_bf16(v1[0], v1[1]); w[bj].w = cvt_pk_bf16(v1[2], v1[3]); }
                bf16_t* rp = base + (size_t)(ai * HALF + m * 16) * ldc;
                PG8_PAIR_STORE(rp, ldc, w[0], w[1]); }
    }
};

template <bool MIDK_> struct EpiResid {
    static constexpr bool PERM = true, AFTER_DRAIN = false, MIDK = MIDK_; static constexpr int MIDK_TILE = 16;
    const float* xin_f; const bf16_t* xin_b; float* xout_f; bf16_t* xout_b; const float* gate; int gstride; bf16_t* part; const float* rsa; PG8_LAS unsigned char* stash;
    __device__ __forceinline__ void pre(const Unit& u, int wr, int fr, int tid) const {
        if constexpr (MIDK_) {
            typedef __fp16 h2 __attribute__((ext_vector_type(2)));
            const int row0 = (u.kind == 0 ? u.pm * BM : 0) + wr * 64 + fr; float t[8], f[8];
            {
                f32x4 q[8][2];
#pragma unroll
                for (int i = 0; i < 8; ++i) { const float* rp = rsa + (size_t)(row0 + (i >> 2) * HALF + (i & 3) * 16) * 8; q[i][0] = *(const f32x4*)rp; q[i][1] = *(const f32x4*)(rp + 4); }
                asm volatile("" ::: "memory");
#pragma unroll
                for (int i = 0; i < 8; ++i) t[i] = ((q[i][0][0] + q[i][0][1]) + (q[i][0][2] + q[i][0][3])) + ((q[i][1][0] + q[i][1][1]) + (q[i][1][2] + q[i][1][3]));
            }
#pragma unroll
            for (int i = 0; i < 8; ++i) f[i] = 1.0f / sqrtf(t[i] * (1.f / 1024.f) + 1e-6f);
            u32x4 w;
            w.x = __builtin_bit_cast(unsigned, __builtin_amdgcn_cvt_pkrtz(f[0], f[1])); w.y = __builtin_bit_cast(unsigned, __builtin_amdgcn_cvt_pkrtz(f[2], f[3]));
            w.z = __builtin_bit_cast(unsigned, __builtin_amdgcn_cvt_pkrtz(f[4], f[5])); w.w = __builtin_bit_cast(unsigned, __builtin_amdgcn_cvt_pkrtz(f[6], f[7]));
            *(PG8_LAS u32x4*)(stash + tid * 16) = w;
        }
    }
    __device__ __forceinline__ void mid(f32x4 (&acc)[2][2][4][2], const Unit& u, int tid) const {
        if (u.kind != 0) return;
        typedef _Float16 hf2 __attribute__((ext_vector_type(2)));
        const u32x4 w = *(const PG8_LAS u32x4*)(stash + tid * 16);
        const unsigned wq[4] = {w.x, w.y, w.z, w.w}; float f[8];
#pragma unroll
        for (int i = 0; i < 4; ++i) { const hf2 p = __builtin_bit_cast(hf2, wq[i]); f[2 * i] = (float)p[0]; f[2 * i + 1] = (float)p[1]; }
#pragma unroll
        for (int ai = 0; ai < 2; ++ai)
#pragma unroll
            for (int m = 0; m < 4; ++m)
#pragma unroll
                for (int bj = 0; bj < 2; ++bj)
#pragma unroll
                    for (int n = 0; n < 2; ++n) acc[ai][bj][m][n] = acc[ai][bj][m][n] * f[ai * 4 + m];
    }
    __device__ __forceinline__ void operator()(const f32x4 (&acc)[2][2][4][2], const Unit& u, int wr, int wc, int fr, int fq) const {
        int prow = (u.pm < 64 ? u.pm : u.pm - 64) * BM + wr * 64 + fr, col0 = u.pn * BM + wc * 64 + 8 * fq;
        asm volatile("" : "+v"(prow), "+v"(col0));
        const int hb = prow & 1;
        if (u.kind == 0) {
            const float* gp = gate + (size_t)(u.pm >> 4) * gstride + col0;
            f32x4 gv[2][2];
#pragma unroll
            for (int bj = 0; bj < 2; ++bj)
#pragma unroll
                for (int n = 0; n < 2; ++n) gv[bj][n] = *(const f32x4*)(gp + bj * 32 + n * 4);
            if (xin_f) {
#pragma unroll
                for (int am = 0; am < 4; ++am) { const int ai = am >> 1, mh = am & 1;
                    f32x4 xv[2][2][2];
#pragma unroll
                    for (int mm = 0; mm < 2; ++mm) { const size_t off = (size_t)(prow + ai * HALF + (2 * mh + mm) * 16) * 2048 + col0;
#pragma unroll
                        for (int bj = 0; bj < 2; ++bj)
#pragma unroll
                            for (int n = 0; n < 2; ++n) xv[mm][bj][n] = *(const f32x4*)(xin_f + off + bj * 32 + n * 4); }
                    asm volatile("" ::: "memory");
#pragma unroll
                    for (int mm = 0; mm < 2; ++mm) { const int m = 2 * mh + mm; const size_t off = (size_t)(prow + ai * HALF + m * 16) * 2048 + col0;
                        u32x4 w[2];
#pragma unroll
                        for (int bj = 0; bj < 2; ++bj) { const f32x4 v0 = xv[mm][bj][0] + gv[bj][0] * acc[ai][bj][m][0], v1 = xv[mm][bj][1] + gv[bj][1] * acc[ai][bj][m][1];
                            w[bj].x = cvt_pk_bf16(v0[0], v0[1]); w[bj].y = cvt_pk_bf16(v0[2], v0[3]); w[bj].z = cvt_pk_bf16(v1[0], v1[1]); w[bj].w = cvt_pk_bf16(v1[2], v1[3]); }
                        PG8_PAIR_STORE(xout_b + off - (size_t)hb * 2048 + 32 * hb, 2048, w[0], w[1]); }
                    asm volatile("" ::: "memory");
                }
            } else {
                const bool of = xout_f != nullptr;
#pragma unroll
                for (int ai = 0; ai < 2; ++ai) {
                    u32x4 raw[4][2];
#pragma unroll
                    for (int m = 0; m < 4; ++m) { const size_t off = (size_t)(prow + ai * HALF + m * 16) * 2048 + col0;
#pragma unroll
                        for (int bj = 0; bj < 2; ++bj) raw[m][bj] = *(const u32x4*)(xin_b + off + bj * 32); }
                    asm volatile("" ::: "memory");
#pragma unroll
                    for (int m = 0; m < 4; ++m) { const size_t off = (size_t)(prow + ai * HALF + m * 16) * 2048 + col0;
                        u32x4 w[2];
#pragma unroll
                        for (int bj = 0; bj < 2; ++bj) { const u32x4 rw = raw[m][bj];
                            f32x4 x0, x1;
                            x0[0] = __builtin_bit_cast(float, rw.x << 16); x0[1] = __builtin_bit_cast(float, rw.x & 0xffff0000u); x0[2] = __builtin_bit_cast(float, rw.y << 16); x0[3] = __builtin_bit_cast(float, rw.y & 0xffff0000u);
                            x1[0] = __builtin_bit_cast(float, rw.z << 16); x1[1] = __builtin_bit_cast(float, rw.z & 0xffff0000u); x1[2] = __builtin_bit_cast(float, rw.w << 16); x1[3] = __builtin_bit_cast(float, rw.w & 0xffff0000u);
                            const f32x4 v0 = x0 + gv[bj][0] * acc[ai][bj][m][0], v1 = x1 + gv[bj][1] * acc[ai][bj][m][1];
                            if (of) { *(f32x4*)(xout_f + off + bj * 32) = v0; *(f32x4*)(xout_f + off + bj * 32 + 4) = v1; }
                            else { w[bj].x = cvt_pk_bf16(v0[0], v0[1]); w[bj].y = cvt_pk_bf16(v0[2], v0[3]); w[bj].z = cvt_pk_bf16(v1[0], v1[1]); w[bj].w = cvt_pk_bf16(v1[2], v1[3]); } }
                        if (!of) PG8_PAIR_STORE(xout_b + off - (size_t)hb * 2048 + 32 * hb, 2048, w[0], w[1]); }
                    asm volatile("" ::: "memory");
                }
            }
        } else {
            bf16_t* po = part + (size_t)(u.kind - 1) * 1024 * 2048;
#pragma unroll
            for (int ai = 0; ai < 2; ++ai)
#pragma unroll
                for (int m = 0; m < 4; ++m) { const size_t off = (size_t)(prow + ai * HALF + m * 16) * 2048 + col0;
                    u32x4 w[2];
#pragma unroll
                    for (int bj = 0; bj < 2; ++bj) { const f32x4 v0 = acc[ai][bj][m][0], v1 = acc[ai][bj][m][1];
                        w[bj].x = cvt_pk_bf16(v0[0], v0[1]); w[bj].y = cvt_pk_bf16(v0[2], v0[3]); w[bj].z = cvt_pk_bf16(v1[0], v1[1]); w[bj].w = cvt_pk_bf16(v1[2], v1[3]); }
                    PG8_PAIR_STORE(po + off - (size_t)hb * 2048 + 32 * hb, 2048, w[0], w[1]); }
        }
    }
};

struct ResidOrder {
    StaticOrder lat; int has_ctx, kc, ntc;
    __device__ void init(int Mlat, int N, int K, int G, int c, int has_ctx_) { lat.init(Mlat, N, K, G, c); has_ctx = has_ctx_; kc = K / 8; ntc = kc / BK; }
    __device__ bool next(int i, Unit& u) const {
        if (lat.next(i, u)) return true;
        if (!has_ctx) return false;
        const long L = (long)i * lat.G + lat.c; const int j = (int)(L - lat.nwg); if (j >= 256) return false;
        const int ks = j & 7; u.pn = (j >> 3) & 7; u.pm = lat.nM + (j >> 6); u.k0 = ks * kc; u.nt = ntc; u.kind = 1 + ks; return true;
    }
    __device__ __forceinline__ void a_ready(const Unit&) const {}
    __device__ __forceinline__ void done(const Unit&) const {}
};

template <class Epi, class Sched, bool ALIGN_EPI = false, bool SP2 = false>
__device__ __forceinline__ void gemm_phase(PG8_LAS unsigned char* lds, const Gemm g, const Sched& S, const Epi& E, int wave_id) {
    unsigned z_ = 0u; asm volatile("" : "+v"(z_)); const int lane_ = (int)__builtin_amdgcn_mbcnt_hi(~0u, __builtin_amdgcn_mbcnt_lo(~0u, z_));
    const int wid = wave_id, lane = lane_, tid = wid * 64 + lane, wr = wid >> 2, wc = wid & 3, fr = lane & 15, fq = lane >> 4;
    const int K = g.K;
    unsigned voffA[2], voffB[2];
#pragma unroll
    for (int i = 0; i < 2; ++i) { int R, C; stage_rc(tid * 16 + i * 8192, R, C); const int Rb = Epi::PERM ? (64 * (R >> 5) + perm32(R & 31)) : R;
        voffA[i] = (unsigned)(R * K + C) * 2u; voffB[i] = (unsigned)(Rb * K + C) * 2u; }
    const size_t kstep = (size_t)(BK * 2);
    const size_t hstep = (size_t)HALF * K * 2;
    const size_t hstepB = Epi::PERM ? (size_t)32 * K * 2 : hstep;
    const size_t tstep = 2 * hstep;
    const unsigned ldsw = (unsigned)wid * 1024u;
    const int aoff = lds_byte(wr * 64 + fr, fq * 8), boff = lds_byte(wc * 32 + fr, fq * 8);
#define PG8_SA(b, h) (((b) * 2 + (h)) * HTB)
#define PG8_SB(b, h) ((4 + (b) * 2 + (h)) * HTB)
#define PG8_STAGE(bufoff, gbase, voff) do { _Pragma("unroll") for (int _i = 0; _i < 2; ++_i) \
        __builtin_amdgcn_global_load_lds((const unsigned*)((const char*)(gbase) + (voff)[_i]), (PG8_LAS unsigned*)(lds + (bufoff) + ldsw + _i * 8192), 16, 0, 0); } while (0)
#define PG8_LDA(dst, b, h) do { _Pragma("unroll") for (int m = 0; m < 4; ++m) _Pragma("unroll") for (int k = 0; k < 2; ++k) dst[m][k] = *(const PG8_LAS bf16x8*)(lds + PG8_SA(b, h) + aoff + m * 2048 + k * 1024); } while (0)
#define PG8_LDB(dst, b, h) do { _Pragma("unroll") for (int n = 0; n < 2; ++n) _Pragma("unroll") for (int k = 0; k < 2; ++k) dst[n][k] = *(const PG8_LAS bf16x8*)(lds + PG8_SB(b, h) + boff + n * 2048 + k * 1024); } while (0)
#define PG8_MMA(ai, bj, At, Bt) do { __builtin_amdgcn_s_setprio(1); _Pragma("unroll") for (int m = 0; m < 4; ++m) _Pragma("unroll") for (int n = 0; n < 2; ++n) _Pragma("unroll") for (int k = 0; k < 2; ++k) \
        acc[ai][bj][m][n] = __builtin_amdgcn_mfma_f32_16x16x32_bf16(Bt[n][k], At[m][k], acc[ai][bj][m][n], 0, 0, 0); __builtin_amdgcn_s_setprio(0); } while (0)
#define PG8_WAIT_V(n) asm volatile("s_waitcnt vmcnt(" #n ")" ::: "memory")
#define PG8_WAIT_L(n) asm volatile("s_waitcnt lgkmcnt(" #n ")" ::: "memory")
#define PG8_BAR __builtin_amdgcn_s_barrier()
#define PG8_SCHED __builtin_amdgcn_sched_barrier(0)
    Unit cur, nxt; int ui = 0;
    if (!S.next(0, cur)) return;
    f32x4 acc[2][2][4][2];
#pragma unroll
    for (int a = 0; a < 2; ++a)
#pragma unroll
        for (int b = 0; b < 2; ++b)
#pragma unroll
            for (int m = 0; m < 4; ++m)
#pragma unroll
                for (int n = 0; n < 2; ++n) acc[a][b][m][n] = (f32x4){0.f, 0.f, 0.f, 0.f};
    bf16x8 At[4][2], B0[2][2], B1[2][2];
    const char* cA = (const char*)g.A + (size_t)cur.pm * tstep + (size_t)cur.k0 * 2; const char* cB = (const char*)g.Bt + (size_t)cur.pn * tstep + (size_t)cur.k0 * 2;
    S.a_ready(cur);
    if constexpr (Epi::MIDK) E.pre(cur, wr, fr, tid);
    if constexpr (SP2) {
        PG8_STAGE(PG8_SB(0, 0), cB, voffB); PG8_STAGE(PG8_SB(0, 1), cB + hstepB, voffB); PG8_STAGE(PG8_SA(0, 0), cA, voffA); PG8_STAGE(PG8_SA(0, 1), cA + hstep, voffA);
        if (wr == 1) PG8_BAR;
        PG8_WAIT_V(2); PG8_BAR;
        PG8_STAGE(PG8_SB(1, 0), cB + kstep, voffB); PG8_STAGE(PG8_SA(1, 0), cA + kstep, voffA); PG8_STAGE(PG8_SB(1, 1), cB + hstepB + kstep, voffB);
        PG8_WAIT_V(6); PG8_BAR;
    } else {
        PG8_STAGE(PG8_SB(0, 0), cB, voffB); PG8_STAGE(PG8_SA(0, 0), cA, voffA); PG8_STAGE(PG8_SB(0, 1), cB + hstepB, voffB); PG8_STAGE(PG8_SA(0, 1), cA + hstep, voffA);
        if (wr == 1) PG8_BAR;
        PG8_WAIT_V(4); PG8_BAR;
        PG8_STAGE(PG8_SB(1, 0), cB + kstep, voffB); PG8_STAGE(PG8_SA(1, 0), cA + kstep, voffA); PG8_STAGE(PG8_SB(1, 1), cB + hstepB + kstep, voffB);
        PG8_WAIT_V(6); PG8_BAR;
    }
    for (;;) {
        const bool has_next = S.next(ui + 1, nxt);
        const char* nA = has_next ? (const char*)g.A + (size_t)nxt.pm * tstep + (size_t)nxt.k0 * 2 : cA; const char* nB = has_next ? (const char*)g.Bt + (size_t)nxt.pn * tstep + (size_t)nxt.k0 * 2 : cB;
        const int nt = cur.nt;
        for (int t = 0; t < nt; t += 2) {
            const bool last = (t == nt - 2);
            const char* a1 = cA + (size_t)(t + 1) * kstep;
            const char* a2 = last ? nA : cA + (size_t)(t + 2) * kstep; const char* b2 = last ? nB : cB + (size_t)(t + 2) * kstep;
            const char* a3 = a2 + kstep; const char* b3 = b2 + kstep;
            if (last && has_next) S.a_ready(nxt);
            if constexpr (Epi::MIDK) { if (t == Epi::MIDK_TILE) E.mid(acc, cur, tid); }
            if constexpr (SP2) {
            PG8_LDB(B0, 0, 0); PG8_LDB(B1, 0, 1); PG8_SCHED; PG8_LDA(At, 0, 0); PG8_STAGE(PG8_SA(1, 1), a1 + hstep, voffA);
            PG8_WAIT_V(8); PG8_WAIT_L(0); PG8_BAR; PG8_MMA(0, 0, At, B0); PG8_MMA(0, 1, At, B1); PG8_BAR; PG8_SCHED;
            PG8_LDA(At, 0, 1); PG8_STAGE(PG8_SB(0, 0), b2, voffB); PG8_STAGE(PG8_SB(0, 1), b2 + hstepB, voffB); PG8_STAGE(PG8_SA(0, 0), a2, voffA);
            PG8_WAIT_V(8); PG8_WAIT_L(0); PG8_BAR; PG8_MMA(1, 0, At, B0); PG8_MMA(1, 1, At, B1); PG8_BAR; PG8_SCHED;
            PG8_LDB(B0, 1, 0); PG8_LDB(B1, 1, 1); PG8_SCHED; PG8_LDA(At, 1, 0); PG8_STAGE(PG8_SA(0, 1), a2 + hstep, voffA);
            PG8_WAIT_V(8); PG8_WAIT_L(0); PG8_BAR; PG8_MMA(0, 0, At, B0); PG8_MMA(0, 1, At, B1); PG8_BAR; PG8_SCHED;
            PG8_LDA(At, 1, 1); PG8_STAGE(PG8_SB(1, 0), b3, voffB); PG8_STAGE(PG8_SB(1, 1), b3 + hstepB, voffB); PG8_STAGE(PG8_SA(1, 0), a3, voffA);
            PG8_WAIT_V(8); PG8_WAIT_L(0); PG8_BAR; PG8_MMA(1, 0, At, B0); PG8_MMA(1, 1, At, B1); PG8_BAR; PG8_SCHED;
            } else {
            PG8_LDB(B0, 0, 0); PG8_SCHED; PG8_LDA(At, 0, 0); PG8_STAGE(PG8_SA(1, 1), a1 + hstep, voffA);
            PG8_WAIT_L(8); PG8_BAR; PG8_WAIT_L(0); PG8_MMA(0, 0, At, B0); PG8_BAR; PG8_SCHED;
            PG8_LDB(B1, 0, 1); PG8_STAGE(PG8_SB(0, 0), b2, voffB);
            PG8_BAR; PG8_WAIT_L(0); PG8_MMA(0, 1, At, B1); PG8_BAR;
            PG8_LDA(At, 0, 1); PG8_STAGE(PG8_SA(0, 0), a2, voffA);
            PG8_BAR; PG8_WAIT_L(0); PG8_MMA(1, 0, At, B0); PG8_BAR; PG8_SCHED;
            PG8_STAGE(PG8_SB(0, 1), b2 + hstepB, voffB);
            PG8_WAIT_V(6); PG8_BAR; PG8_MMA(1, 1, At, B1); PG8_BAR;
            PG8_LDB(B0, 1, 0); PG8_SCHED; PG8_LDA(At, 1, 0); PG8_STAGE(PG8_SA(0, 1), a2 + hstep, voffA);
            PG8_WAIT_L(8); PG8_BAR; PG8_WAIT_L(0); PG8_MMA(0, 0, At, B0); PG8_BAR; PG8_SCHED;
            PG8_LDB(B1, 1, 1); PG8_STAGE(PG8_SB(1, 0), b3, voffB);
            PG8_BAR; PG8_WAIT_L(0); PG8_MMA(0, 1, At, B1); PG8_BAR;
            PG8_LDA(At, 1, 1); PG8_STAGE(PG8_SA(1, 0), a3, voffA);
            PG8_BAR; PG8_WAIT_L(0); PG8_MMA(1, 0, At, B0); PG8_BAR; PG8_SCHED;
            PG8_STAGE(PG8_SB(1, 1), b3 + hstepB, voffB);
            PG8_WAIT_V(6); PG8_BAR; PG8_MMA(1, 1, At, B1); PG8_BAR;
            }
        }
        if constexpr (ALIGN_EPI) { if (wr == 0) PG8_BAR; }
        if constexpr (!Epi::AFTER_DRAIN) { E(acc, cur, wr, wc, fr, fq); S.done(cur); }
        if (!has_next) break;
        if constexpr (Epi::MIDK) E.pre(nxt, wr, fr, tid);
#pragma unroll
        for (int a = 0; a < 2; ++a)
#pragma unroll
            for (int b = 0; b < 2; ++b)
#pragma unroll
                for (int m = 0; m < 4; ++m)
#pragma unroll
                    for (int n = 0; n < 2; ++n) acc[a][b][m][n] = (f32x4){0.f, 0.f, 0.f, 0.f};
        cur = nxt; cA = nA; cB = nB; ++ui;
        if constexpr (ALIGN_EPI) { if (wr == 1) PG8_BAR; }
    }
    PG8_WAIT_V(0);
    if constexpr (!ALIGN_EPI) { if (wr == 0) PG8_BAR; }
    PG8_BAR;
    if constexpr (Epi::AFTER_DRAIN) { E.fused(acc, cur, wr, wc, fr, fq, lds, wid, lane); S.done(cur); }
#undef PG8_SA
#undef PG8_SB
#undef PG8_STAGE
#undef PG8_LDA
#undef PG8_LDB
#undef PG8_MMA
#undef PG8_WAIT_V
#undef PG8_WAIT_L
#undef PG8_BAR
#undef PG8_SCHED
}
}

namespace attn {
typedef unsigned short bf16;
using bf16x8 = __attribute__((ext_vector_type(8))) short;
using s16x4  = __attribute__((ext_vector_type(4))) short;
using f32x16 = __attribute__((ext_vector_type(16))) float;
using u32x4  = __attribute__((ext_vector_type(4))) unsigned;
constexpr int   D = 128, NW = 8, QBLK = 32, KVBLK = 64;
constexpr float SCALE = 0.088388347648318440f;
constexpr float THR = 8.f;
constexpr int SDEPTH = 2;
constexpr int LDQ = 128, LDK = 128, LDO = 2048;
constexpr size_t SHM_V = KVBLK * D * 2, SHM_K = KVBLK * D * 2, SHM_ATTN = 4 * SHM_V + 4 * SHM_K;
#define LAS3 __attribute__((address_space(3)))
#define KSWZ(row, colB) ((row) * 256 + ((colB) ^ (((row) & 7) << 4)))
#define SBAR() __builtin_amdgcn_sched_barrier(0)
__device__ __forceinline__ int crow(int r, int hi) { return (r & 3) + 8 * (r >> 2) + 4 * hi; }
__device__ __forceinline__ unsigned cvtpk(float lo, float hi) {
  unsigned r; asm volatile("v_cvt_pk_bf16_f32 %0, %1, %2" : "=v"(r) : "v"(lo), "v"(hi)); return r;
}
__device__ __forceinline__ bf16x8 ld8(const bf16* p) { return *reinterpret_cast<const bf16x8*>(p); }

__device__ __forceinline__ void partialSM(f32x16& p0, f32x16& p1, float& m_reg, float& mn, float& alpha) {
  constexpr float C = SCALE * 1.4426950408889634f;
  float pmax = p0[0]; for (int r = 1; r < 16; ++r) pmax = fmaxf(pmax, p0[r]); for (int r = 0; r < 16; ++r) pmax = fmaxf(pmax, p1[r]);
  { auto rr = __builtin_amdgcn_permlane32_swap(__float_as_uint(pmax), __float_as_uint(pmax), false, false);
    pmax = fmaxf(__uint_as_float(rr[0]), __uint_as_float(rr[1])); }
  if (__builtin_expect(__all(pmax - m_reg <= THR / SCALE), 1)) { mn = m_reg; alpha = 1.f; }
  else { mn = fmaxf(m_reg, pmax); alpha = __builtin_amdgcn_exp2f((m_reg - mn) * C); m_reg = mn; }
  float mnC = -mn * C;
  for (int r = 0; r < 16; ++r) p0[r] = fmaf(p0[r], C, mnC); for (int r = 0; r < 16; ++r) p1[r] = fmaf(p1[r], C, mnC);
  for (int r = 0; r < 16; ++r) p0[r] = __builtin_amdgcn_exp2f(p0[r]);
}
__device__ __forceinline__ void finishSM(f32x16& p0, f32x16& p1, float alpha, float& l_reg, bf16x8& pa0, bf16x8& pa1, bf16x8& pa2, bf16x8& pa3) {
  for (int r = 0; r < 16; ++r) p1[r] = __builtin_amdgcn_exp2f(p1[r]);
  float ps = 0; for (int r = 0; r < 16; ++r) ps += p0[r]; for (int r = 0; r < 16; ++r) ps += p1[r];
  { auto rr = __builtin_amdgcn_permlane32_swap(__float_as_uint(ps), __float_as_uint(ps), false, false);
    ps = __uint_as_float(rr[0]) + __uint_as_float(rr[1]); }
  l_reg = l_reg * alpha + ps;
#define PK4(P, BASE, OUT) do { unsigned a0 = cvtpk(P[BASE + 0], P[BASE + 1]), a1 = cvtpk(P[BASE + 2], P[BASE + 3]);   \
    unsigned b0 = cvtpk(P[BASE + 4], P[BASE + 5]), b1 = cvtpk(P[BASE + 6], P[BASE + 7]);                              \
    auto r0 = __builtin_amdgcn_permlane32_swap(a0, b0, false, false); auto r1 = __builtin_amdgcn_permlane32_swap(a1, b1, false, false); \
    u32x4 w = {r0[0], r1[0], r0[1], r1[1]}; OUT = *reinterpret_cast<bf16x8*>(&w); } while (0)
  PK4(p0, 0, pa0); PK4(p0, 8, pa1); PK4(p1, 0, pa2); PK4(p1, 8, pa3);
#undef PK4
}
__device__ __forceinline__ float amax3(float a, float b, float c) { float r; asm("v_max3_f32 %0, %1, %2, %3" : "=v"(r) : "v"(a), "v"(b), "v"(c)); return r; }
__device__ __forceinline__ float amax2(float a, float b) { float r; asm("v_max_f32 %0, %1, %2" : "=v"(r) : "v"(a), "v"(b)); return r; }
constexpr float THR2 = 11.541560327111707f;
__device__ __forceinline__ void softmax_step(f32x16& p0, f32x16& p1, f32x16& mt, bool first, float& alpha, float& l_reg, bf16x8& pa0, bf16x8& pa1, bf16x8& pa2, bf16x8& pa3) {
  float mc[4];
#pragma unroll
  for (int k = 0; k < 4; ++k) { float m = amax3(p0[k], p0[k + 4], p0[k + 8]); m = amax3(m, p0[k + 12], p1[k]); m = amax3(m, p1[k + 4], p1[k + 8]); mc[k] = amax2(m, p1[k + 12]); }
  float pmax = amax2(amax3(mc[0], mc[1], mc[2]), mc[3]);
  { auto rr = __builtin_amdgcn_permlane32_swap(__float_as_uint(pmax), __float_as_uint(pmax), false, false);
    pmax = amax2(__uint_as_float(rr[0]), __uint_as_float(rr[1])); }
  alpha = 1.f;
  if (__builtin_expect(first || !__all(pmax <= THR2), 0)) {
    const float delta = first ? pmax : fmaxf(pmax, 0.f);
    alpha = first ? 1.f : __builtin_amdgcn_exp2f(-delta);
    for (int r = 0; r < 16; ++r) { p0[r] -= delta; p1[r] -= delta; mt[r] -= delta; }
  }
  for (int r = 0; r < 16; ++r) p0[r] = __builtin_amdgcn_exp2f(p0[r]);
  for (int r = 0; r < 16; ++r) p1[r] = __builtin_amdgcn_exp2f(p1[r]);
  float s0 = p0[0] + p0[4], s1 = p0[1] + p0[5], s2 = p0[2] + p0[6], s3 = p0[3] + p0[7];
  s0 += p0[8]; s1 += p0[9]; s2 += p0[10]; s3 += p0[11]; s0 += p0[12]; s1 += p0[13]; s2 += p0[14]; s3 += p0[15];
  s0 += p1[0]; s1 += p1[1]; s2 += p1[2]; s3 += p1[3]; s0 += p1[4]; s1 += p1[5]; s2 += p1[6]; s3 += p1[7];
  s0 += p1[8]; s1 += p1[9]; s2 += p1[10]; s3 += p1[11]; s0 += p1[12]; s1 += p1[13]; s2 += p1[14]; s3 += p1[15];
  float ps = (s0 + s1) + (s2 + s3);
  { auto rr = __builtin_amdgcn_permlane32_swap(__float_as_uint(ps), __float_as_uint(ps), false, false);
    ps = __uint_as_float(rr[0]) + __uint_as_float(rr[1]); }
  l_reg = l_reg * alpha + ps;
#define PK4(P, BASE, OUT) do { unsigned a0 = cvtpk(P[BASE + 0], P[BASE + 1]), a1 = cvtpk(P[BASE + 2], P[BASE + 3]);   \
    unsigned b0 = cvtpk(P[BASE + 4], P[BASE + 5]), b1 = cvtpk(P[BASE + 6], P[BASE + 7]);                              \
    auto r0 = __builtin_amdgcn_permlane32_swap(a0, b0, false, false); auto r1 = __builtin_amdgcn_permlane32_swap(a1, b1, false, false); \
    u32x4 w = {r0[0], r1[0], r0[1], r1[1]}; OUT = *reinterpret_cast<bf16x8*>(&w); } while (0)
  PK4(p0, 0, pa0); PK4(p0, 8, pa1); PK4(p1, 0, pa2); PK4(p1, 8, pa3);
#undef PK4
}
template <int OFF> __device__ __forceinline__ bf16x8 kread(int a) { bf16x8 r; asm volatile("ds_read_b128 %0, %1 offset:%2" : "=&v"(r) : "v"(a), "i"(OFF) : "memory"); return r; }
#define KWAIT(N, X, Y) asm volatile("s_waitcnt lgkmcnt(" #N ")" : "+v"(X), "+v"(Y) :: "memory")
#define QM(X, D0) do { p0 = __builtin_amdgcn_mfma_f32_32x32x16_bf16(X##0, qr[D0], p0, 0, 0, 0); p1 = __builtin_amdgcn_mfma_f32_32x32x16_bf16(X##1, qr[D0], p1, 0, 0, 0); } while (0)
#define QKT_ISSUE2() bf16x8 a0 = kread<0>(ka[0]), a1 = kread<8192>(ka[0]); bf16x8 b0 = kread<0>(ka[1]), b1 = kread<8192>(ka[1])
#define QKT_REST() do { \
  KWAIT(2, a0, a1); p0 = __builtin_amdgcn_mfma_f32_32x32x16_bf16(a0, qr[0], mt, 0, 0, 0); p1 = __builtin_amdgcn_mfma_f32_32x32x16_bf16(a1, qr[0], mt, 0, 0, 0); \
  bf16x8 c0 = kread<0>(ka[2]), c1 = kread<8192>(ka[2]); \
  KWAIT(2, b0, b1); QM(b, 1); \
  a0 = kread<0>(ka[3]); a1 = kread<8192>(ka[3]); \
  KWAIT(2, c0, c1); QM(c, 2); \
  b0 = kread<128>(ka[0]); b1 = kread<8320>(ka[0]); \
  KWAIT(2, a0, a1); QM(a, 3); \
  c0 = kread<128>(ka[1]); c1 = kread<8320>(ka[1]); \
  KWAIT(2, b0, b1); QM(b, 4); \
  a0 = kread<128>(ka[2]); a1 = kread<8320>(ka[2]); \
  KWAIT(2, c0, c1); QM(c, 5); \
  b0 = kread<128>(ka[3]); b1 = kread<8320>(ka[3]); \
  KWAIT(2, a0, a1); QM(a, 6); \
  KWAIT(0, b0, b1); QM(b, 7); } while (0)
__device__ __forceinline__ void qkt(f32x16& p0, f32x16& p1, const int (&ka)[4], const bf16x8* qr, const f32x16& mt) {
  QKT_ISSUE2(); QKT_REST();
}
__device__ __forceinline__ int v_st(int k, int c) { const int kk = (k & ~0xC) | ((k & 4) << 1) | ((k & 8) >> 1); return ((kk >> 3) * 4 + (c >> 5)) * 512 + ((kk & 7) * 32 + (c & 31)) * 2; }
__device__ __forceinline__ int v_rd_base(int lane) { return ((lane & 3) << 3) | (((lane >> 2) & 3) << 6) | (((lane >> 4) & 1) << 5) | (((lane >> 5) & 1) << 8); }
constexpr int v_rd_off(int d0, int ks, int half) { return d0 * 512 + ks * 4096 + half * 2048; }
template <int OFF> __device__ __forceinline__ s16x4 tr_read(int vb) {
  s16x4 r; asm volatile("ds_read_b64_tr_b16 %0, %1 offset:%2" : "=&v"(r) : "v"(vb), "i"(OFF) : "memory"); return r;
}
#define TRSET(S, D0) do { S##0 = tr_read<v_rd_off(D0, 0, 0)>(vb); S##1 = tr_read<v_rd_off(D0, 0, 1)>(vb); S##2 = tr_read<v_rd_off(D0, 1, 0)>(vb); S##3 = tr_read<v_rd_off(D0, 1, 1)>(vb); \
    S##4 = tr_read<v_rd_off(D0, 2, 0)>(vb); S##5 = tr_read<v_rd_off(D0, 2, 1)>(vb); S##6 = tr_read<v_rd_off(D0, 3, 0)>(vb); S##7 = tr_read<v_rd_off(D0, 3, 1)>(vb); } while (0)
#define TWAIT(N, S) asm volatile("s_waitcnt lgkmcnt(" #N ")" : "+v"(S##0), "+v"(S##1), "+v"(S##2), "+v"(S##3), "+v"(S##4), "+v"(S##5), "+v"(S##6), "+v"(S##7) :: "memory")
#define PK(L, H) (bf16x8){L[0], L[1], L[2], L[3], H[0], H[1], H[2], H[3]}
#define PVM(OD, S) do { OD = __builtin_amdgcn_mfma_f32_32x32x16_bf16(pa0, PK(S##0, S##1), OD, 0, 0, 0); OD = __builtin_amdgcn_mfma_f32_32x32x16_bf16(pa1, PK(S##2, S##3), OD, 0, 0, 0); \
    OD = __builtin_amdgcn_mfma_f32_32x32x16_bf16(pa2, PK(S##4, S##5), OD, 0, 0, 0); OD = __builtin_amdgcn_mfma_f32_32x32x16_bf16(pa3, PK(S##6, S##7), OD, 0, 0, 0); } while (0)
struct TrPre { s16x4 a0, a1, a2, a3, a4, a5, a6, a7, b0, b1, b2, b3, b4, b5, b6, b7; };
__device__ __forceinline__ TrPre pv_head(int vb) {
  s16x4 a0, a1, a2, a3, a4, a5, a6, a7, b0, b1, b2, b3, b4, b5, b6, b7;
  TRSET(a, 0); TRSET(b, 1);
  return TrPre{a0, a1, a2, a3, a4, a5, a6, a7, b0, b1, b2, b3, b4, b5, b6, b7};
}
__device__ __forceinline__ void pv_d0(f32x16* o, int vb, bf16x8 pa0, bf16x8 pa1, bf16x8 pa2, bf16x8 pa3, const TrPre& h) {
  s16x4 a0 = h.a0, a1 = h.a1, a2 = h.a2, a3 = h.a3, a4 = h.a4, a5 = h.a5, a6 = h.a6, a7 = h.a7, b0 = h.b0, b1 = h.b1, b2 = h.b2, b3 = h.b3, b4 = h.b4, b5 = h.b5, b6 = h.b6, b7 = h.b7;
  TWAIT(8, a); PVM(o[0], a);
  TRSET(a, 2);
  TWAIT(8, b); PVM(o[1], b);
  TRSET(b, 3);
  TWAIT(8, a); PVM(o[2], a);
  TWAIT(0, b); PVM(o[3], b);
}
__device__ __forceinline__ void mstep(f32x16* o, int vb, bf16x8 pa0, bf16x8 pa1, bf16x8 pa2, bf16x8 pa3, const TrPre& h, f32x16& p0, f32x16& p1, const int (&ka)[4], const bf16x8* qr, const f32x16& mt) {
  s16x4 u0 = h.a0, u1 = h.a1, u2 = h.a2, u3 = h.a3, u4 = h.a4, u5 = h.a5, u6 = h.a6, u7 = h.a7, w0 = h.b0, w1 = h.b1, w2 = h.b2, w3 = h.b3, w4 = h.b4, w5 = h.b5, w6 = h.b6, w7 = h.b7;
#define TDONE(S) asm volatile("" : "+v"(S##0), "+v"(S##1), "+v"(S##2), "+v"(S##3), "+v"(S##4), "+v"(S##5), "+v"(S##6), "+v"(S##7) :: "memory")
  bf16x8 a0 = kread<0>(ka[0]), a1 = kread<8192>(ka[0]);
  bf16x8 b0 = kread<0>(ka[1]), b1 = kread<8192>(ka[1]);
  TWAIT(12, u); PVM(o[0], u);
  TRSET(u, 2);
  KWAIT(10, a0, a1); TDONE(w);
  p0 = __builtin_amdgcn_mfma_f32_32x32x16_bf16(a0, qr[0], mt, 0, 0, 0); p1 = __builtin_amdgcn_mfma_f32_32x32x16_bf16(a1, qr[0], mt, 0, 0, 0);
  bf16x8 c0 = kread<0>(ka[2]), c1 = kread<8192>(ka[2]);
  KWAIT(10, b0, b1); QM(b, 1);
  a0 = kread<0>(ka[3]); a1 = kread<8192>(ka[3]);
  PVM(o[1], w);
  TRSET(w, 3);
  KWAIT(10, c0, c1); TDONE(u);
  QM(c, 2);
  b0 = kread<128>(ka[0]); b1 = kread<8320>(ka[0]);
  KWAIT(10, a0, a1); QM(a, 3);
  c0 = kread<128>(ka[1]); c1 = kread<8320>(ka[1]);
  PVM(o[2], u);
  KWAIT(2, b0, b1); TDONE(w);
  QM(b, 4);
  a0 = kread<128>(ka[2]); a1 = kread<8320>(ka[2]);
  KWAIT(2, c0, c1); QM(c, 5);
  b0 = kread<128>(ka[3]); b1 = kread<8320>(ka[3]);
  PVM(o[3], w);
  KWAIT(2, a0, a1); QM(a, 6);
  KWAIT(0, b0, b1); QM(b, 7);
#undef TDONE
}
#undef TRSET
#undef TWAIT
#undef PK
#undef PVM

__device__ __forceinline__ void attn_dense_body(const bf16* __restrict__ Qb, const bf16* __restrict__ Kh, const bf16* __restrict__ Vh,
                                                bf16* __restrict__ Ob, const float* __restrict__ gain, float* __restrict__ rsa, int seq, char* lds, char* scratch, int wave_id) {
  unsigned z_ = 0u; asm volatile("" : "+v"(z_)); const int lane_ = (int)__builtin_amdgcn_mbcnt_hi(~0u, __builtin_amdgcn_mbcnt_lo(~0u, z_));
    const int wid = wave_id, lane = lane_, tid = wid * 64 + lane, r32 = lane & 31, hi = lane >> 5;
  bf16* V_lds = (bf16*)lds; bf16* K_lds = (bf16*)(lds + 4 * SHM_V);
  float* ws = (float*)scratch + wid * 64; float* li_l = ws; float* al_l = ws + 32;
  float l_reg = 0; f32x16 o[4] = {}; f32x16 mt = {}; bf16x8 qr[8];
  const bf16* Qw = Qb + (long)(wid * QBLK + r32) * LDQ + hi * 8;
#pragma unroll
  for (int d0 = 0; d0 < 8; ++d0) qr[d0] = ld8(Qw + d0 * 16);
  const int vb0 = (int)(uintptr_t)V_lds + v_rd_base(lane);
  int kb4[4];
#pragma unroll
  for (int q = 0; q < 4; ++q) kb4[q] = (int)(uintptr_t)K_lds + r32 * 256 + ((32 * q + 16 * hi) ^ ((r32 & 7) << 4));
#define KADDR(b) do { _Pragma("unroll") for (int q_ = 0; q_ < 4; ++q_) ka[q_] = kb4[q_] + (b) * (int)SHM_K; } while (0)
  int ka[4];
  unsigned gk[2], gv[2];
#pragma unroll
  for (int i = 0; i < 2; ++i) { const int blk = 2 * wid + i, row = blk * 4 + (lane >> 4); gk[i] = (unsigned)(row * 256 + (((lane & 15) ^ (row & 7)) << 4));
    const int st = blk * 2 + (lane >> 5), kk = (st >> 2) * 8 + ((lane >> 2) & 7), key = (kk & ~0xC) | ((kk & 4) << 1) | ((kk & 8) >> 1); gv[i] = (unsigned)(key * 256 + ((st & 3) * 32 + (lane & 3) * 8) * 2); }
  const unsigned ldsV = (unsigned)(uintptr_t)V_lds + (unsigned)wid * 2048u, ldsK = (unsigned)(uintptr_t)K_lds + (unsigned)wid * 2048u;
#define DMA(b, t) do { const char* kg_ = (const char*)Kh + (size_t)(t) * (KVBLK * LDK * 2); const char* vg_ = (const char*)Vh + (size_t)(t) * (KVBLK * LDK * 2); \
    _Pragma("unroll") for (int i_ = 0; i_ < 2; ++i_) { \
      __builtin_amdgcn_global_load_lds((const unsigned*)(kg_ + gk[i_]), (LAS3 unsigned*)(uintptr_t)(ldsK + (unsigned)(b) * (unsigned)SHM_K + i_ * 1024u), 16, 0, 0); \
      __builtin_amdgcn_global_load_lds((const unsigned*)(vg_ + gv[i_]), (LAS3 unsigned*)(uintptr_t)(ldsV + (unsigned)(b) * (unsigned)SHM_V + i_ * 1024u), 16, 0, 0); } } while (0)
#define LANDED() do { asm volatile("s_waitcnt vmcnt(0)" ::: "memory"); __builtin_amdgcn_s_barrier(); asm volatile("" ::: "memory"); } while (0)
#define RESC(a) do { if (__any((a) < 1.f)) { if (hi == 0) al_l[r32] = (a); asm volatile("s_waitcnt lgkmcnt(0)" ::: "memory"); \
    for (int d = 0; d < 4; ++d) for (int r = 0; r < 16; ++r) o[d][r] *= al_l[crow(r, hi)]; } } while (0)
  f32x16 p0, p1; float al; bf16x8 pa0, pa1, pa2, pa3; const int NT = seq / KVBLK;
  DMA(0, 0); DMA(1, 1); DMA(2, 2); DMA(3, 3);
  asm volatile("s_waitcnt vmcnt(12)" ::: "memory"); SBAR(); __builtin_amdgcn_s_barrier(); SBAR();
#define BARP() do { SBAR(); asm volatile("" ::: "memory"); __builtin_amdgcn_s_barrier(); asm volatile("" ::: "memory"); SBAR(); } while (0)
#define BARD(t) do { SBAR(); if ((t) == 0) asm volatile("s_waitcnt vmcnt(8)" ::: "memory"); else if ((t) + 2 < NT) asm volatile("s_waitcnt vmcnt(4)" ::: "memory"); else asm volatile("s_waitcnt vmcnt(0)" ::: "memory"); \
    __builtin_amdgcn_s_barrier(); asm volatile("" ::: "memory"); SBAR(); } while (0)
#define SSTEP(first) do { softmax_step(p0, p1, mt, first, al, l_reg, pa0, pa1, pa2, pa3); RESC(al); } while (0)
  if (wid < 4) {
    KADDR(0); qkt(p0, p1, ka, qr, mt);
    BARP();
    for (int t = 0; t + 1 < NT; ++t) {
      if (t >= 2 && t + 2 < NT) DMA((t + 2) & 3, t + 2);
      SSTEP(t == 0);
      const TrPre h = pv_head(vb0 + (t & 3) * (int)SHM_V);
      BARD(t);
      KADDR((t + 1) & 3); mstep(o, vb0 + (t & 3) * (int)SHM_V, pa0, pa1, pa2, pa3, h, p0, p1, ka, qr, mt);
      BARP();
    }
    SSTEP(false); { const TrPre h = pv_head(vb0 + ((NT - 1) & 3) * (int)SHM_V); BARD(NT - 1);
    pv_d0(o, vb0 + ((NT - 1) & 3) * (int)SHM_V, pa0, pa1, pa2, pa3, h); }
  } else {
    BARP();
    TrPre h = pv_head(vb0);
    for (int t = 0; t < NT; ++t) {
      KADDR(t & 3);
      if (t > 0) mstep(o, vb0 + ((t - 1) & 3) * (int)SHM_V, pa0, pa1, pa2, pa3, h, p0, p1, ka, qr, mt); else qkt(p0, p1, ka, qr, mt);
      BARD(t);
      if (t >= 1 && t + 3 < NT) DMA((t + 3) & 3, t + 3);
      SSTEP(t == 0);
      h = pv_head(vb0 + (t & 3) * (int)SHM_V);
      if (t + 1 < NT) BARP();
    }
    pv_d0(o, vb0 + ((NT - 1) & 3) * (int)SHM_V, pa0, pa1, pa2, pa3, h);
  }
#undef BARP
#undef BARD
#undef SSTEP
  if (hi == 0) li_l[r32] = l_reg; asm volatile("s_waitcnt lgkmcnt(0)" ::: "memory");
  float rli[16];
#pragma unroll
  for (int r = 0; r < 16; ++r) rli[r] = __builtin_amdgcn_rcpf(li_l[crow(r, hi)]);
  bf16* Ow = Ob + (long)(wid * QBLK) * LDO; float* rw = rsa + wid * QBLK * 8;
  float gq[4];
#pragma unroll
  for (int d0 = 0; d0 < 4; ++d0) gq[d0] = gain[d0 * 32 + r32];
  const bool odd = (lane & 1) != 0; float srow = 0.f;
#pragma unroll
  for (int r = 0; r < 16; r += 2) { float ss0 = 0.f, ss1 = 0.f;
#pragma unroll
    for (int d0 = 0; d0 < 4; ++d0) { const float v0 = o[d0][r] * rli[r], v1 = o[d0][r + 1] * rli[r + 1]; ss0 += v0 * v0; ss1 += v1 * v1;
      const float g0 = v0 * gq[d0], g1 = v1 * gq[d0]; const float recv = __shfl_xor(odd ? g0 : g1, 1);
      const unsigned w = odd ? cvtpk(recv, g1) : cvtpk(g0, recv);
      *(unsigned*)(Ow + (long)crow(odd ? r + 1 : r, hi) * LDO + d0 * 32 + (r32 & ~1)) = w; }
#pragma unroll
    for (int sft = 1; sft < 32; sft <<= 1) { ss0 += __shfl_xor(ss0, sft); ss1 += __shfl_xor(ss1, sft); }
    srow = (r32 == r) ? ss0 : srow; srow = (r32 == r + 1) ? ss1 : srow; }
  if (r32 < 16) rw[crow(r32, hi) * 8] = srow;
#undef DMA
#undef LANDED
#undef RESC
#undef KADDR
}
#undef KSWZ
#undef SBAR
}

constexpr int NWAVES = 8;
constexpr int DM = 2048, NB = 4, SEQ = 4096, CTX = 256, NL = 4;
constexpr int HD = 128, NH = 8, NKV = 2, AW = 1024, KVW = 256, CW = 1024, INW = 4608, FF = 8192;
constexpr int ML = NB * SEQ, MC = NB * CTX, MT = ML + MC;
constexpr int SKV = SEQ + CTX;
constexpr int MODW = 6 * DM;
constexpr float EPS = 1e-6f;
constexpr int C_Q = 0, C_K = 1024, C_V = 1280, C_GB = 1536, C_GC = 2560, C_U = 3584, C_Z = 2560;

constexpr size_t MiB = 1u << 20;
constexpr size_t WS_CTL = 0, CTL_ZERO_BYTES = 64 * 1024;
constexpr size_t WS_MOD = 1 * MiB;
constexpr size_t WS_XC = 2 * MiB;
constexpr size_t WS_W = 16 * MiB;
constexpr size_t W_IN_E = (size_t)INW * DM, W_OUT_E = (size_t)DM * DM, W_1_E = (size_t)FF * DM, W_2_E = (size_t)DM * FF, W_LAYER_E = W_IN_E + W_OUT_E + W_1_E + W_2_E;
constexpr size_t WS_H = WS_W + NL * W_LAYER_E * 2 + 8 * MiB;
constexpr size_t WS_BIG = WS_H + (size_t)MT * DM * 2 + 4 * MiB;
constexpr size_t BIG_QKV = 0, BIG_Q = 156 * MiB, BIG_K = 192 * MiB, BIG_V = 202 * MiB;
constexpr size_t WS_MRG = WS_BIG + (size_t)MT * FF * 2 + 4 * MiB;
constexpr size_t WS_AO = WS_MRG + (size_t)MT * DM * 2 + 4 * MiB;
constexpr size_t WS_PART = WS_AO + (size_t)MT * AW * 4 + 4 * MiB;
constexpr size_t WS_END = WS_PART + (size_t)8 * MC * DM * 4 + 4 * MiB;
static_assert((size_t)MT * INW * 2 <= BIG_Q && BIG_Q + (size_t)MT * AW * 2 <= BIG_K && BIG_K + (size_t)NB * NKV * SKV * HD * 2 <= BIG_V && BIG_V + (size_t)NB * NKV * SKV * HD * 2 <= (size_t)MT * FF * 2, "overlay map");
static_assert((size_t)NL * 5 * MODW * 4 <= 1 * MiB && WS_XC + (size_t)MC * DM * 4 <= WS_W, "small map");
constexpr int CW_BAR = 4096;
constexpr size_t WS_RSA = 11 * MiB;
static_assert(WS_RSA >= WS_XC + (size_t)MC * DM * 4 && WS_RSA + (size_t)MT * 8 * 4 <= WS_W && (CW_BAR + 3456) * 4 <= (int)CTL_ZERO_BYTES, "CTL / RSA map");

constexpr int RING_OFF = 0, RING_BYTES = 131072;
constexpr int ROPE_OFF = RING_BYTES;
constexpr int MISC_OFF = ROPE_OFF + 16384;
constexpr int STASH_OFF = MISC_OFF + 256;
constexpr int LDS_BYTES = STASH_OFF + NWAVES * 64 * 16;

#define GAS __attribute__((address_space(1)))
#define LAS __attribute__((address_space(3)))
typedef unsigned short bf16;
typedef unsigned v4u __attribute__((ext_vector_type(4)));
typedef unsigned v2u __attribute__((ext_vector_type(2)));
typedef float f32x4 __attribute__((ext_vector_type(4)));
typedef float f32x2 __attribute__((ext_vector_type(2)));
#define LDS_WAIT() asm volatile("s_waitcnt lgkmcnt(0)" ::: "memory")
__device__ __forceinline__ unsigned pk2(float lo, float hi) { unsigned r; asm volatile("v_cvt_pk_bf16_f32 %0, %1, %2" : "=v"(r) : "v"(lo), "v"(hi)); return r; }
__device__ __forceinline__ float bflo(unsigned w) { return __builtin_bit_cast(float, w << 16); }
__device__ __forceinline__ float bfhi(unsigned w) { return __builtin_bit_cast(float, w & 0xffff0000u); }
__device__ __forceinline__ float wave_sum(float v) {
#pragma unroll
    for (int o = 1; o < 64; o <<= 1) v += __shfl_xor(v, o);
    return v;
}
__device__ __forceinline__ void ld16(const bf16* p, float (&x)[16]) {
    const v4u a = *(const v4u*)p, b = *(const v4u*)(p + 8);
    x[0] = bflo(a.x); x[1] = bfhi(a.x); x[2] = bflo(a.y); x[3] = bfhi(a.y); x[4] = bflo(a.z); x[5] = bfhi(a.z); x[6] = bflo(a.w); x[7] = bfhi(a.w);
    x[8] = bflo(b.x); x[9] = bfhi(b.x); x[10] = bflo(b.y); x[11] = bfhi(b.y); x[12] = bflo(b.z); x[13] = bfhi(b.z); x[14] = bflo(b.w); x[15] = bfhi(b.w);
}
struct Raw16 { v4u a, b; };
__device__ __forceinline__ Raw16 ldraw16(const bf16* p) { Raw16 r; r.a = *(const v4u*)p; r.b = *(const v4u*)(p + 8); return r; }
__device__ __forceinline__ void unpack16(const Raw16& r, float (&x)[16]) {
    x[0] = bflo(r.a.x); x[1] = bfhi(r.a.x); x[2] = bflo(r.a.y); x[3] = bfhi(r.a.y); x[4] = bflo(r.a.z); x[5] = bfhi(r.a.z); x[6] = bflo(r.a.w); x[7] = bfhi(r.a.w);
    x[8] = bflo(r.b.x); x[9] = bfhi(r.b.x); x[10] = bflo(r.b.y); x[11] = bfhi(r.b.y); x[12] = bflo(r.b.z); x[13] = bfhi(r.b.z); x[14] = bflo(r.b.w); x[15] = bfhi(r.b.w);
}
__device__ __forceinline__ void st16(bf16* p, const float (&x)[16]) {
    v4u a, b; a.x = pk2(x[0], x[1]); a.y = pk2(x[2], x[3]); a.z = pk2(x[4], x[5]); a.w = pk2(x[6], x[7]);
    b.x = pk2(x[8], x[9]); b.y = pk2(x[10], x[11]); b.z = pk2(x[12], x[13]); b.w = pk2(x[14], x[15]);
    *(v4u*)p = a; *(v4u*)(p + 8) = b;
}
__device__ __forceinline__ void ld16f(const float* p, float (&x)[16]) {
#pragma unroll
    for (int i = 0; i < 4; ++i) { const f32x4 v = *(const f32x4*)(p + 4 * i); x[4 * i] = v.x; x[4 * i + 1] = v.y; x[4 * i + 2] = v.z; x[4 * i + 3] = v.w; }
}
#define XB_TMO      128
#define XB_XCNT(j)  (256  + 64 * (j))
#define XB_XSUB(j)  (1280 + 64 * (j))
#define XB_XGEN(j)  (2304 + 64 * (j))
#define XB_TOP      3328
#define XB_TOPGEN   3392
#define XCD_BAR_WORDS 3456
#define XB_SPIN_CAP (1u << 18)

__device__ __forceinline__ unsigned xb_ld(unsigned* p)              { return __hip_atomic_load(p, __ATOMIC_RELAXED, __HIP_MEMORY_SCOPE_AGENT); }
__device__ __forceinline__ unsigned xb_add(unsigned* p, unsigned v) { return __hip_atomic_fetch_add(p, v, __ATOMIC_RELAXED, __HIP_MEMORY_SCOPE_AGENT); }
__device__ __forceinline__ unsigned xb_xcc_id() { return (unsigned)__builtin_amdgcn_s_getreg((3 << 11) | 20) & 0xFu; }
#define XB_SPIN(cond, bar) do { unsigned _sp = 0; while (cond) { __builtin_amdgcn_s_sleep(1); \
    if ((++_sp & 255u) == 0u) { if (xb_ld(&(bar)[XB_TMO])) break; if (_sp > XB_SPIN_CAP) { atomicAdd(&(bar)[XB_TMO], 1u); break; } } } } while (0)

struct XcdBarrier {
    unsigned* bar; unsigned x;
    volatile LAS unsigned* st;
};

__device__ __forceinline__ XcdBarrier xcd_barrier_post(unsigned* bar, volatile LAS unsigned* st, bool leader) {
    XcdBarrier b; b.bar = bar; b.x = xb_xcc_id(); b.st = st;
    if (leader) (void)xb_add(&bar[XB_XCNT(b.x)], 1u);
    return b;
}
__device__ __forceinline__ void xcd_barrier_complete(unsigned* bar, unsigned x, unsigned& nloc, unsigned& nx) {
    const unsigned G = gridDim.x * gridDim.y * gridDim.z;
    unsigned sum, cnt, mine, sp = 0u;
    for (;;) {
        sum = 0u; cnt = 0u; mine = 0u;
#pragma unroll
        for (unsigned j = 0; j < 16; ++j) { const unsigned c = xb_ld(&bar[XB_XCNT(j)]); sum += c; cnt += (c > 0u) ? 1u : 0u; mine = (j == x) ? c : mine; }
        if (sum == G) break;
        __builtin_amdgcn_s_sleep(1);
        if ((++sp & 255u) == 0u) { if (xb_ld(&bar[XB_TMO])) break; if (sp > XB_SPIN_CAP) { atomicAdd(&bar[XB_TMO], 1u); break; } }
    }
    nloc = mine > 0u ? mine : 1u; nx = cnt > 0u ? cnt : 1u;
}

__device__ __forceinline__ void xcd_barrier(const XcdBarrier& b, bool leader) {
    asm volatile("s_waitcnt vmcnt(0)" ::: "memory");
    __syncthreads();
    if (leader) {
        unsigned* bar = b.bar;
        __builtin_amdgcn_s_waitcnt(0);
        unsigned nloc = b.st[0], nx = b.st[1];
        if (nloc == 0u) { xcd_barrier_complete(bar, b.x, nloc, nx); b.st[0] = nloc; b.st[1] = nx; }
        const unsigned old = xb_add(&bar[XB_XSUB(b.x)], 1u);
        const unsigned gen = old / nloc;
        if (old + 1u == (gen + 1u) * nloc) {
            __builtin_amdgcn_fence(__ATOMIC_RELEASE, "agent");
            asm volatile("s_waitcnt vmcnt(0)" ::: "memory");
            const unsigned og = xb_add(&bar[XB_TOP], 1u);
            const unsigned tg = og / nx;
            if (og + 1u == (tg + 1u) * nx) xb_add(&bar[XB_TOPGEN], 1u);
            else XB_SPIN(xb_ld(&bar[XB_TOPGEN]) == tg, bar);
            __builtin_amdgcn_fence(__ATOMIC_ACQUIRE, "agent");
            xb_add(&bar[XB_XGEN(b.x)], 1u);
            asm volatile("s_waitcnt vmcnt(0)" ::: "memory");
        } else {
            XB_SPIN(xb_ld(&bar[XB_XGEN(b.x)]) == gen, bar);
            __builtin_amdgcn_fence(__ATOMIC_ACQUIRE, "agent");
            asm volatile("s_waitcnt vmcnt(0)" ::: "memory");
        }
    }
    __syncthreads();
}


__device__ __forceinline__ void p0_transpose_item(const float* W, int K, int N, bf16* WT, LAS float* scr, int item, int lane, bool zperm = false) {
    const int nblk = N / 32, kb = item / nblk, nb = item % nblk, k0 = 64 * kb, n0 = 32 * nb;
    int nd0 = n0; if (zperm && n0 >= C_GC) { const int isu = n0 >= C_U, g = n0 - (isu ? C_U : C_GC); nd0 = C_GC + 256 * (g >> 7) + 64 * ((g >> 5) & 3) + 32 * isu + (g & 31); }
    {
        f32x4 t[8]; const int rr = lane >> 3, c4 = 4 * (lane & 7);
#pragma unroll
        for (int i = 0; i < 8; ++i) t[i] = *(const f32x4*)(W + (size_t)(k0 + rr + 8 * i) * N + n0 + c4);
        asm volatile("" ::: "memory");
#pragma unroll
        for (int i = 0; i < 8; ++i) { LAS float* d = scr + (rr + 8 * i) * 33 + c4; d[0] = t[i].x; d[1] = t[i].y; d[2] = t[i].z; d[3] = t[i].w; }
    }
    LDS_WAIT(); asm volatile("" ::: "memory");
    const int c = lane & 7;
#pragma unroll
    for (int j = 0; j < 4; ++j) { const int n = (lane >> 3) + 8 * j; const LAS float* s = scr + (8 * c) * 33 + n;
        v4u o; o.x = pk2(s[0 * 33], s[1 * 33]); o.y = pk2(s[2 * 33], s[3 * 33]); o.z = pk2(s[4 * 33], s[5 * 33]); o.w = pk2(s[6 * 33], s[7 * 33]);
        *(GAS v4u*)(WT + (size_t)(nd0 + n) * K + k0 + 8 * c) = o; }
    LDS_WAIT(); asm volatile("" ::: "memory");
}

__device__ __forceinline__ void adaln_item(const float* __restrict__ w_ada, const float* __restrict__ b_ada, float* __restrict__ mod, LAS float* sil, LAS float* red, int item, int tid, int wave, int lane) {
    const int l = item / 192, n0 = (item % 192) * 64, g = lane >> 4, c4 = lane & 15;
    const float* wp = w_ada + ((size_t)l * DM + wave * 256 + g) * MODW + n0 + 4 * c4;
    f32x4 acc[5];
#pragma unroll
    for (int r = 0; r < 5; ++r) acc[r] = (f32x4){0.f, 0.f, 0.f, 0.f};
    const LAS float* sp = sil + wave * 256 + g;
#pragma unroll 1
    for (int i0 = 0; i0 < 64; i0 += 8) {
        const float* wq = wp + (size_t)(4 * i0) * MODW;
        f32x4 wv[8];
#pragma unroll
        for (int i = 0; i < 8; ++i) wv[i] = *(const f32x4*)(wq + (size_t)(4 * i) * MODW);
        asm volatile("" ::: "memory");
#pragma unroll
        for (int i = 0; i < 8; ++i)
#pragma unroll
            for (int r = 0; r < 5; ++r) { const float s = sp[r * DM + 4 * (i0 + i)]; acc[r] = acc[r] + wv[i] * s; }
    }
#pragma unroll
    for (int r = 0; r < 5; ++r)
#pragma unroll
        for (int e = 0; e < 4; ++e) { float v = acc[r][e]; v += __shfl_xor(v, 16); v += __shfl_xor(v, 32); acc[r][e] = v; }
    if (g == 0) {
#pragma unroll
        for (int r = 0; r < 5; ++r) *(LAS f32x4*)(red + (wave * 5 + r) * 64 + 4 * c4) = acc[r];
    }
    __syncthreads();
    if (tid < 320) { const int r = tid >> 6, cc = tid & 63; float s = b_ada[(size_t)l * MODW + n0 + cc];
#pragma unroll
        for (int w = 0; w < 8; ++w) s += red[(w * 5 + r) * 64 + cc];
        mod[((size_t)l * 5 + r) * MODW + n0 + cc] = s; }
    __syncthreads();
}

__device__ __forceinline__ void norm_mod_rows(const float* __restrict__ x, bf16* __restrict__ out, int nrows, const float* __restrict__ gain, const float* __restrict__ sh, const float* __restrict__ sc, int lane) {
    asm volatile("" : "+v"(lane));
    f32x4 a[8], bb[8];
    {
        f32x4 sv[8];
#pragma unroll
        for (int j = 0; j < 8; ++j) { a[j] = *(const f32x4*)(gain + 4 * lane + 256 * j); sv[j] = *(const f32x4*)(sc + 4 * lane + 256 * j); bb[j] = *(const f32x4*)(sh + 4 * lane + 256 * j); }
        asm volatile("" ::: "memory");
#pragma unroll
        for (int j = 0; j < 8; ++j) a[j] = a[j] * (sv[j] + 1.0f);
    }
    int i = 0;
    for (; i + 1 < nrows; i += 2) {
        const f32x4* xr0 = (const f32x4*)(x + (size_t)i * DM) + lane; const f32x4* xr1 = xr0 + DM / 4;
        f32x4 v0[8], v1[8]; float s0 = 0.f, s1 = 0.f;
#pragma unroll
        for (int j = 0; j < 8; ++j) { v0[j] = xr0[64 * j]; v1[j] = xr1[64 * j]; }
#pragma unroll
        for (int j = 0; j < 8; ++j) { s0 += (v0[j].x * v0[j].x + v0[j].y * v0[j].y) + (v0[j].z * v0[j].z + v0[j].w * v0[j].w); s1 += (v1[j].x * v1[j].x + v1[j].y * v1[j].y) + (v1[j].z * v1[j].z + v1[j].w * v1[j].w); }
        const float r0 = 1.0f / sqrtf(wave_sum(s0) * (1.f / DM) + EPS), r1 = 1.0f / sqrtf(wave_sum(s1) * (1.f / DM) + EPS);
        v2u* o0 = (v2u*)(out + (size_t)i * DM) + lane; v2u* o1 = o0 + DM / 4;
#pragma unroll
        for (int j = 0; j < 8; ++j) { const f32x4 y0 = v0[j] * r0 * a[j] + bb[j], y1 = v1[j] * r1 * a[j] + bb[j]; v2u w0, w1; w0.x = pk2(y0.x, y0.y); w0.y = pk2(y0.z, y0.w); w1.x = pk2(y1.x, y1.y); w1.y = pk2(y1.z, y1.w); o0[64 * j] = w0; o1[64 * j] = w1; }
    }
    for (; i < nrows; ++i) {
        const f32x4* xr = (const f32x4*)(x + (size_t)i * DM) + lane;
        f32x4 v[8]; float ss = 0.f;
#pragma unroll
        for (int j = 0; j < 8; ++j) { v[j] = xr[64 * j]; ss += (v[j].x * v[j].x + v[j].y * v[j].y) + (v[j].z * v[j].z + v[j].w * v[j].w); }
        const float rstd = 1.0f / sqrtf(wave_sum(ss) * (1.f / DM) + EPS);
        v2u* o8 = (v2u*)(out + (size_t)i * DM) + lane;
#pragma unroll
        for (int j = 0; j < 8; ++j) { const f32x4 y = v[j] * rstd * a[j] + bb[j]; v2u w; w.x = pk2(y.x, y.y); w.y = pk2(y.z, y.w); o8[64 * j] = w; }
    }
}
__device__ __forceinline__ void norm_mod_rows_b(const bf16* __restrict__ x, bf16* __restrict__ out, int nrows, const float* __restrict__ gain, const float* __restrict__ sh, const float* __restrict__ sc, int lane) {
    asm volatile("" : "+v"(lane));
    f32x4 a[4][2], bb[4][2];
    {
        f32x4 sv[4][2];
#pragma unroll
        for (int j = 0; j < 4; ++j)
#pragma unroll
            for (int h = 0; h < 2; ++h) { const int e = 8 * lane + 512 * j + 4 * h; a[j][h] = *(const f32x4*)(gain + e); sv[j][h] = *(const f32x4*)(sc + e); bb[j][h] = *(const f32x4*)(sh + e); }
        asm volatile("" ::: "memory");
#pragma unroll
        for (int j = 0; j < 4; ++j)
#pragma unroll
            for (int h = 0; h < 2; ++h) a[j][h] = a[j][h] * (sv[j][h] + 1.0f);
    }
    for (int i = 0; i < nrows; i += 4) {
        v4u raw[4][4]; float ss[4];
#pragma unroll
        for (int r = 0; r < 4; ++r)
#pragma unroll
            for (int j = 0; j < 4; ++j) raw[r][j] = *(const v4u*)(x + (size_t)(i + r) * DM + 8 * lane + 512 * j);
        asm volatile("" ::: "memory");
#pragma unroll
        for (int r = 0; r < 4; ++r) { float s = 0.f;
#pragma unroll
            for (int j = 0; j < 4; ++j) { const v4u w = raw[r][j];
                const float x0 = bflo(w.x), x1 = bfhi(w.x), x2 = bflo(w.y), x3 = bfhi(w.y), x4 = bflo(w.z), x5 = bfhi(w.z), x6 = bflo(w.w), x7 = bfhi(w.w);
                s += ((x0 * x0 + x1 * x1) + (x2 * x2 + x3 * x3)) + ((x4 * x4 + x5 * x5) + (x6 * x6 + x7 * x7)); }
            ss[r] = s; }
#pragma unroll
        for (int r = 0; r < 4; ++r) ss[r] = 1.0f / sqrtf(wave_sum(ss[r]) * (1.f / DM) + EPS);
#pragma unroll
        for (int r = 0; r < 4; ++r)
#pragma unroll
            for (int j = 0; j < 4; ++j) { const v4u w = raw[r][j];
                f32x4 x0, x1; x0.x = bflo(w.x); x0.y = bfhi(w.x); x0.z = bflo(w.y); x0.w = bfhi(w.y); x1.x = bflo(w.z); x1.y = bfhi(w.z); x1.z = bflo(w.w); x1.w = bfhi(w.w);
                const f32x4 y0 = x0 * ss[r] * a[j][0] + bb[j][0], y1 = x1 * ss[r] * a[j][1] + bb[j][1];
                v4u o; o.x = pk2(y0.x, y0.y); o.y = pk2(y0.z, y0.w); o.z = pk2(y1.x, y1.y); o.w = pk2(y1.z, y1.w);
                *(v4u*)(out + (size_t)(i + r) * DM + 8 * lane + 512 * j) = o; }
    }
}
__device__ __forceinline__ void ctx_fix_norm_row(const float* __restrict__ xin, const bf16* __restrict__ part, const float* __restrict__ gate, const float* __restrict__ rsa_row, float* __restrict__ xout, bf16* __restrict__ out,
                                                 const float* __restrict__ gain, const float* __restrict__ sh, const float* __restrict__ sc, int lane) {
    asm volatile("" : "+v"(lane));
    f32x4 v[4][2]; float ss = 0.f; float ra = 1.0f;
    if (rsa_row) { const f32x4 q0 = *(const f32x4*)rsa_row, q1 = *(const f32x4*)(rsa_row + 4); ra = 1.0f / sqrtf((((q0.x + q0.y) + (q0.z + q0.w)) + ((q1.x + q1.y) + (q1.z + q1.w))) * (1.f / AW) + EPS); }
    if (part) {
#pragma unroll
        for (int j0 = 0; j0 < 4; j0 += 2) {
            v4u pp[2][8];
#pragma unroll
            for (int jj = 0; jj < 2; ++jj) { const int e = 8 * lane + 512 * (j0 + jj); v[j0 + jj][0] = *(const f32x4*)(xin + e); v[j0 + jj][1] = *(const f32x4*)(xin + e + 4);
#pragma unroll
                for (int ks = 0; ks < 8; ++ks) pp[jj][ks] = *(const v4u*)(part + (size_t)ks * MC * DM + e); }
            asm volatile("" ::: "memory");
#pragma unroll
            for (int jj = 0; jj < 2; ++jj) { const int j = j0 + jj, e = 8 * lane + 512 * j;
                f32x4 q[8][2];
#pragma unroll
                for (int ks = 0; ks < 8; ++ks) { const v4u w = pp[jj][ks]; q[ks][0].x = bflo(w.x); q[ks][0].y = bfhi(w.x); q[ks][0].z = bflo(w.y); q[ks][0].w = bfhi(w.y); q[ks][1].x = bflo(w.z); q[ks][1].y = bfhi(w.z); q[ks][1].z = bflo(w.w); q[ks][1].w = bfhi(w.w); }
#pragma unroll
                for (int h = 0; h < 2; ++h) {
                    const f32x4 pa = (q[0][h] + q[1][h]) + (q[2][h] + q[3][h]), pc = (q[4][h] + q[5][h]) + (q[6][h] + q[7][h]);
                    v[j][h] = v[j][h] + *(const f32x4*)(gate + e + 4 * h) * (pa * ra + pc);
                    *(f32x4*)(xout + e + 4 * h) = v[j][h]; } }
            asm volatile("" ::: "memory");
        }
    } else {
#pragma unroll
        for (int j = 0; j < 4; ++j) { const int e = 8 * lane + 512 * j; v[j][0] = *(const f32x4*)(xin + e); v[j][1] = *(const f32x4*)(xin + e + 4); }
    }
#pragma unroll
    for (int j = 0; j < 4; ++j)
#pragma unroll
        for (int h = 0; h < 2; ++h) ss += (v[j][h].x * v[j][h].x + v[j][h].y * v[j][h].y) + (v[j][h].z * v[j][h].z + v[j][h].w * v[j][h].w);
    const float rstd = 1.0f / sqrtf(wave_sum(ss) * (1.f / DM) + EPS);
#pragma unroll
    for (int j = 0; j < 4; ++j) { const int e = 8 * lane + 512 * j; f32x4 y[2];
#pragma unroll
        for (int h = 0; h < 2; ++h) { const f32x4 g = *(const f32x4*)(gain + e + 4 * h), sv = *(const f32x4*)(sc + e + 4 * h), b = *(const f32x4*)(sh + e + 4 * h); y[h] = v[j][h] * rstd * (g * (sv + 1.0f)) + b; }
        v4u w; w.x = pk2(y[0].x, y[0].y); w.y = pk2(y[0].z, y[0].w); w.z = pk2(y[1].x, y[1].y); w.w = pk2(y[1].z, y[1].w);
        *(v4u*)(out + e) = w; }
}
__device__ __forceinline__ void norm_mod_phase(const float* xlat, const bf16* xlat_b, const float* xctx, float* xcout, const bf16* part, const float* cgate, const float* rsa_ctx, bool do_ctx, bf16* H, const float* gain, const float* modl, int shc, int scc, int bid, int G, int wave, int lane) {
    for (int c = bid; c < 256; c += G) {
        { const int r = c >> 6, row0 = 64 * c + 8 * wave;
          if (xlat_b) norm_mod_rows_b(xlat_b + (size_t)row0 * DM, H + (size_t)row0 * DM, 8, gain, modl + (size_t)r * MODW + shc * DM, modl + (size_t)r * MODW + scc * DM, lane);
          else norm_mod_rows(xlat + (size_t)row0 * DM, H + (size_t)row0 * DM, 8, gain, modl + (size_t)r * MODW + shc * DM, modl + (size_t)r * MODW + scc * DM, lane); }
        if (wave < 4 && do_ctx) { const int row = 4 * c + wave;
          ctx_fix_norm_row(xctx + (size_t)row * DM, part ? part + (size_t)row * DM : nullptr, cgate, rsa_ctx ? rsa_ctx + (size_t)row * 8 : nullptr, xcout + (size_t)row * DM, H + (size_t)(ML + row) * DM, gain, modl + (size_t)4 * MODW + shc * DM, modl + (size_t)4 * MODW + scc * DM, lane); }
    }
}

__device__ __forceinline__ void token_rows(const bf16* __restrict__ QKV, bf16* __restrict__ Ql, bf16* __restrict__ Qc, bf16* __restrict__ Kb, bf16* __restrict__ Vb, bf16* __restrict__ MRG,
                                           const float* __restrict__ qg_, const float* __restrict__ kg_, const float* __restrict__ cw, const float* __restrict__ cb, const float* __restrict__ cg_,
                                           const LAS f32x2* rope, int b, int t0, int n, bool latent, int lane) {
    const int seq_len = latent ? SEQ : CTX, rbase = latent ? b * SEQ : ML + b * CTX;
    const int j = lane & 7, h = lane >> 3;
    {
        float qg[16], kg[16];
        ld16f(qg_ + 16 * j, qg); ld16f(kg_ + 16 * j, kg);
#pragma unroll
        for (int e = 0; e < 16; ++e) qg[e] *= 0.12751743074602132f;
        const int l5 = lane & 31, isv = l5 >> 4, kvh = (l5 >> 3) & 1;
        const float sgn = (j & 2) ? 1.f : -1.f;
        const int qoff = C_Q + 128 * h + 16 * j, koff = C_K + 128 * kvh + 16 * j;
        Raw16 rq = ldraw16(QKV + (size_t)(rbase + t0) * INW + qoff), rk = ldraw16(QKV + (size_t)(rbase + t0) * INW + koff);
        for (int i = 0; i < n; ++i) {
            const int t = t0 + i;
            const Raw16 cq = rq, ck = rk;
            if (i + 1 < n) { const bf16* nsrc = QKV + (size_t)(rbase + t + 1) * INW; rq = ldraw16(nsrc + qoff); rk = ldraw16(nsrc + koff); }
            float cs[16], sn[16];
            if (latent) { const int pos = (j & 4) ? (t & 63) : (t >> 6); const LAS f32x2* tp = rope + pos * 32 + 16 * (j & 1);
#pragma unroll
                for (int e = 0; e < 16; ++e) { const f32x2 v = tp[e]; cs[e] = v.x; sn[e] = v.y; } }
            else {
#pragma unroll
                for (int e = 0; e < 16; ++e) { cs[e] = 1.f; sn[e] = 0.f; } }
            {
                float x[16]; unpack16(cq, x);
                float ss = 0.f;
#pragma unroll
                for (int e = 0; e < 16; ++e) ss += x[e] * x[e];
                ss += __shfl_xor(ss, 1); ss += __shfl_xor(ss, 2); ss += __shfl_xor(ss, 4);
                const float rstd = 1.0f / sqrtf(ss * (1.f / HD) + EPS);
#pragma unroll
                for (int e = 0; e < 16; ++e) x[e] = x[e] * rstd * qg[e];
                float y[16];
#pragma unroll
                for (int e = 0; e < 16; ++e) { const float p = __shfl_xor(x[e], 2); y[e] = x[e] * cs[e] + sgn * p * sn[e]; }
                bf16* dst = latent ? Ql + ((size_t)(b * NH + h) * SEQ + t) * HD + 16 * j : Qc + ((size_t)(b * NH + h) * CTX + t) * HD + 16 * j;
                st16(dst, y);
            }
            {
                float x[16]; unpack16(ck, x);
                float ss = 0.f;
#pragma unroll
                for (int e = 0; e < 16; ++e) ss += x[e] * x[e];
                ss += __shfl_xor(ss, 1); ss += __shfl_xor(ss, 2); ss += __shfl_xor(ss, 4);
                const float rstd = 1.0f / sqrtf(ss * (1.f / HD) + EPS);
                float y[16];
#pragma unroll
                for (int e = 0; e < 16; ++e) { const float xn = x[e] * rstd * kg[e]; const float p = __shfl_xor(xn, 2); const float kr = xn * cs[e] + sgn * p * sn[e]; y[e] = isv ? x[e] : kr; }
                const int pos = latent ? t : SEQ + t;
                bf16* dst = (isv ? Vb : Kb) + ((size_t)(b * NKV + kvh) * SKV + pos) * HD + 16 * j;
                if (lane < 16) st16(dst, y);
            }
        }
    }
    {
        const int ch = 16 * lane;
        float w0[16], w1[16], w2[16], bs[16], cg[16];
        ld16f(cw + ch, w0); ld16f(cw + CW + ch, w1); ld16f(cw + 2 * CW + ch, w2); ld16f(cb + ch, bs); ld16f(cg_ + ch, cg);
        float zp[16], zc[16], zn[16];
#define LOADZ(dst, tt) do { ld16(QKV + (size_t)(rbase + (tt)) * INW + C_Z + ch, dst); } while (0)
#define ZEROZ(dst) do { _Pragma("unroll") for (int e = 0; e < 16; ++e) dst[e] = 0.f; } while (0)
        if (t0 > 0) LOADZ(zp, t0 - 1); else ZEROZ(zp);
        LOADZ(zc, t0);
        const bf16* row0 = QKV + (size_t)(rbase + t0) * INW;
        Raw16 rgb = ldraw16(row0 + C_GB + ch), rz = rgb;
        if (t0 + 1 < seq_len) rz = ldraw16(row0 + INW + C_Z + ch);
        for (int i = 0; i < n; ++i) {
            const int t = t0 + i;
            const Raw16 cgb = rgb, cz = rz;
            if (i + 1 < n) { const bf16* nrow = QKV + (size_t)(rbase + t + 1) * INW; rgb = ldraw16(nrow + C_GB + ch);
                if (t + 2 < seq_len) rz = ldraw16(nrow + INW + C_Z + ch); }
            if (t + 1 < seq_len) unpack16(cz, zn);
            else ZEROZ(zn);
            float gb[16]; unpack16(cgb, gb);
            float y[16]; float ss = 0.f;
#pragma unroll
            for (int e = 0; e < 16; ++e) { const float cv = zp[e] * w0[e] + zc[e] * w1[e] + zn[e] * w2[e] + bs[e]; y[e] = gb[e] * cv; ss += y[e] * y[e]; }
            const float rstd = 1.0f / sqrtf(wave_sum(ss) * (1.f / CW) + EPS);
#pragma unroll
            for (int e = 0; e < 16; ++e) y[e] = y[e] * rstd * cg[e];
            st16(MRG + (size_t)(rbase + t) * DM + AW + ch, y);
#pragma unroll
            for (int e = 0; e < 16; ++e) { zp[e] = zc[e]; zc[e] = zn[e]; }
        }
#undef LOADZ
#undef ZEROZ
    }
}

__device__ __forceinline__ void attn_norm_rows(const float* __restrict__ ao, bf16* __restrict__ mrg, int nrows, const float* __restrict__ ag_, int lane) {
    f32x4 ag[4];
#pragma unroll
    for (int j = 0; j < 4; ++j) ag[j] = *(const f32x4*)(ag_ + 4 * lane + 256 * j);
    for (int i = 0; i < nrows; ++i) {
        const f32x4* xr = (const f32x4*)(ao + (size_t)i * AW) + lane;
        f32x4 v[4]; float ss = 0.f;
#pragma unroll
        for (int j = 0; j < 4; ++j) { v[j] = xr[64 * j]; ss += (v[j].x * v[j].x + v[j].y * v[j].y) + (v[j].z * v[j].z + v[j].w * v[j].w); }
        const float rstd = 1.0f / sqrtf(wave_sum(ss) * (1.f / AW) + EPS);
        v2u* o8 = (v2u*)(mrg + (size_t)i * DM) + lane;
#pragma unroll
        for (int j = 0; j < 4; ++j) { const f32x4 y = v[j] * rstd * ag[j]; v2u w; w.x = pk2(y.x, y.y); w.y = pk2(y.z, y.w); o8[64 * j] = w; }
    }
}

struct Args { const float* in[18]; float* out; unsigned char* ws; };
typedef const __attribute__((address_space(4))) Args* KArgs;
__device__ __forceinline__ int lane_id() { unsigned z = 0u; asm volatile("" : "+v"(z)); return (int)__builtin_amdgcn_mbcnt_hi(~0u, __builtin_amdgcn_mbcnt_lo(~0u, z)); }
__device__ __forceinline__ KArgs fresh_args() { KArgs p = (KArgs)__builtin_amdgcn_kernarg_segment_ptr(); asm volatile("" : "+s"(p)); return p; }
__device__ __forceinline__ int fresh_int(int v) { asm volatile("" : "+s"(v)); return v; }
#define BID() fresh_int((int)blockIdx.x)

struct Ptrs {
    const float *x_in, *c_in, *ctx_in, *cctx_in, *w_ada, *b_ada, *norm1_g, *w_in, *q_norm_g, *k_norm_g, *conv_w, *conv_b, *attn_out_g, *conv_out_g, *w_out, *norm2_g, *w_mlp_in, *w_mlp_out;
    float* out; float* MOD; float* XC; bf16* WT; bf16* H; bf16* HB; bf16* QKV; bf16* Qb; bf16* Qc; bf16* Kb; bf16* Vb; bf16* MRG; bf16* PART; float* RSA; unsigned* ctl; bf16* XB;
};
__device__ __forceinline__ Ptrs make_ptrs(KArgs a) {
    Ptrs p; unsigned char* ws = a->ws;
    p.x_in = a->in[0]; p.c_in = a->in[1]; p.ctx_in = a->in[2]; p.cctx_in = a->in[3]; p.w_ada = a->in[4]; p.b_ada = a->in[5]; p.norm1_g = a->in[6]; p.w_in = a->in[7];
    p.q_norm_g = a->in[8]; p.k_norm_g = a->in[9]; p.conv_w = a->in[10]; p.conv_b = a->in[11]; p.attn_out_g = a->in[12]; p.conv_out_g = a->in[13]; p.w_out = a->in[14]; p.norm2_g = a->in[15];
    p.w_mlp_in = a->in[16]; p.w_mlp_out = a->in[17]; p.out = a->out;
    p.MOD = (float*)(ws + WS_MOD); p.XC = (float*)(ws + WS_XC); p.WT = (bf16*)(ws + WS_W); p.H = (bf16*)(ws + WS_H);
    p.HB = (bf16*)(ws + WS_BIG); p.QKV = (bf16*)(ws + WS_BIG + BIG_QKV); p.Qb = (bf16*)(ws + WS_BIG + BIG_Q); p.Qc = p.Qb + (size_t)ML * AW;
    p.Kb = (bf16*)(ws + WS_BIG + BIG_K); p.Vb = (bf16*)(ws + WS_BIG + BIG_V); p.MRG = (bf16*)(ws + WS_MRG); p.PART = (bf16*)(ws + WS_PART); p.RSA = (float*)(ws + WS_RSA); p.ctl = (unsigned*)(ws + WS_CTL); p.XB = (bf16*)(ws + WS_AO);
    return p;
}

__device__ __forceinline__ void silu_table(const float* c_in, const float* cctx_in, LAS unsigned char* L, int tid) {
    LAS float* sil = (LAS float*)(L + RING_OFF);
    for (int idx = tid; idx < 5 * DM; idx += NWAVES * 64) { const int r = idx >> 11, k = idx & (DM - 1); const float v = (r < 4) ? c_in[r * DM + k] : cctx_in[k]; sil[idx] = v / (1.0f + __expf(-v)); }
    __syncthreads();
}
#define GRID_BAR() do { XcdBarrier b_; b_.bar = (unsigned*)(fresh_args()->ws + WS_CTL) + CW_BAR; b_.x = xb_xcc_id(); b_.st = (volatile LAS unsigned*)(L + MISC_OFF) + 8; xcd_barrier(b_, fresh_int(wave_s) == 0 && lane_id() == 0); } while (0)
__global__ void __launch_bounds__(NWAVES * 64, 2) fwd_kernel(Args args_unused) {
    extern __shared__ __attribute__((aligned(16))) unsigned char lds[];
    LAS unsigned char* L = (LAS unsigned char*)lds;
    const int wave_s = __builtin_amdgcn_readfirstlane((int)threadIdx.x >> 6);
    {
        volatile LAS unsigned* MISC = (volatile LAS unsigned*)(L + MISC_OFF);
        const int tid = (fresh_int(wave_s) * 64 + lane_id());
        for (int u = tid; u < 64; u += NWAVES * 64) MISC[u] = 0u;
        {
            LAS f32x2* rope = (LAS f32x2*)(L + ROPE_OFF);
            for (int idx = tid; idx < 2048; idx += NWAVES * 64) { const int pos = idx >> 5, i = idx & 31;
                const float f = exp2f(-(float)i * (13.287712379549449f / 32.f)); const float a = (float)pos * f;
                f32x2 v; v.x = __cosf(a); v.y = __sinf(a); rope[idx] = v; }
        }
        __syncthreads();
        const Ptrs P = make_ptrs(fresh_args());
        (void)xcd_barrier_post(P.ctl + CW_BAR, MISC + 8, tid == 0);
    }

    {
        const Ptrs P = make_ptrs(fresh_args()); const int tid = (fresh_int(wave_s) * 64 + lane_id()), lane = tid & 63, wave = __builtin_amdgcn_readfirstlane(tid >> 6), G = fresh_int((int)gridDim.x);
        LAS float* sil = (LAS float*)(L + RING_OFF); LAS float* red = sil + 5 * DM;
        silu_table(P.c_in, P.cctx_in, L, tid);
        if (G == 256) { for (int it = BID(); it < 192 + 8 * (NL - 1); it += G) adaln_item(P.w_ada, P.b_ada, P.MOD, sil, red, it < 192 ? it : (1 + (it - 192) / 8) * 192 + 184 + (it - 192) % 8, tid, wave, lane); }
        else { for (int it = BID(); it < NL * 192; it += G) adaln_item(P.w_ada, P.b_ada, P.MOD, sil, red, it, tid, wave, lane); }
        __syncthreads();
        LAS float* scr = (LAS float*)(L + RING_OFF + wave * 16384);
        constexpr int I_IN = (DM / 64) * (INW / 32), I_OUT = (DM / 64) * (DM / 32), I_1 = (DM / 64) * (FF / 32), I_2 = (FF / 64) * (DM / 32), I_LAYER = I_IN + I_OUT + I_1 + I_2;
        const int gw = BID() * NWAVES + wave, NGW = G * NWAVES;
        for (int it = gw; it < NL * I_LAYER; it += NGW) {
            const int l = it / I_LAYER; int r = it % I_LAYER; bf16* wl = P.WT + (size_t)l * W_LAYER_E;
            if (r < I_IN) { p0_transpose_item(P.w_in + (size_t)l * DM * INW, DM, INW, wl, scr, r, lane, true); continue; } r -= I_IN;
            if (r < I_OUT) { p0_transpose_item(P.w_out + (size_t)l * DM * DM, DM, DM, wl + W_IN_E, scr, r, lane); continue; } r -= I_OUT;
            if (r < I_1) { p0_transpose_item(P.w_mlp_in + (size_t)l * DM * FF, DM, FF, wl + W_IN_E + W_OUT_E, scr, r, lane); continue; } r -= I_1;
            p0_transpose_item(P.w_mlp_out + (size_t)l * FF * DM, FF, DM, wl + W_IN_E + W_OUT_E + W_1_E, scr, r, lane);
        }
    }
    GRID_BAR();

    for (int l = 0; l < NL; ++l) {
        {
            const Ptrs P = make_ptrs(fresh_args()); const int tid = (fresh_int(wave_s) * 64 + lane_id()), lane = tid & 63, wave = __builtin_amdgcn_readfirstlane(tid >> 6), G = fresh_int((int)gridDim.x);
            const float* xl_in = (l == 0) ? P.x_in : nullptr; const bf16* xl_b = (l == 0) ? nullptr : P.XB; const float* xc_in = (l == 0) ? P.ctx_in : P.XC;
            norm_mod_phase(xl_in, xl_b, xc_in, P.XC, (l == 0) ? nullptr : P.PART, P.MOD + (size_t)(l > 0 ? l - 1 : 0) * 5 * MODW + 4 * MODW + 5 * DM, nullptr, true, P.H, P.norm1_g + (size_t)l * DM, P.MOD + (size_t)l * 5 * MODW, 0, 1, BID(), G, wave, lane);
        }
        GRID_BAR();

        {
            const Ptrs P = make_ptrs(fresh_args()); const int G = fresh_int((int)gridDim.x);
            pg8::Gemm g{P.H, P.WT + (size_t)l * W_LAYER_E, MT, INW, DM}; pg8::StaticOrder S; S.init(MT, INW, DM, G, BID());
            pg8::EpiBf16<0, true> E{P.QKV, INW, P.Vb};
            pg8::gemm_phase<pg8::EpiBf16<0, true>, pg8::StaticOrder, true, true>(L + RING_OFF, g, S, E, fresh_int(wave_s));
            { const int rem = S.nwg % G, j = BID() - rem; if (l + 1 < NL && G == 256 && rem == 200 && j >= 0) { const int tid = (fresh_int(wave_s) * 64 + lane_id()), lane = tid & 63, wave = __builtin_amdgcn_readfirstlane(tid >> 6);
                silu_table(P.c_in, P.cctx_in, L, tid); adaln_item(P.w_ada, P.b_ada, P.MOD, (LAS float*)(L + RING_OFF), (LAS float*)(L + RING_OFF) + 5 * DM, (l + 1) * 192 + 128 + j, tid, wave, lane); } }
        }
        GRID_BAR();

        {
            const Ptrs P = make_ptrs(fresh_args()); const int tid = (fresh_int(wave_s) * 64 + lane_id()), lane = tid & 63, wave = __builtin_amdgcn_readfirstlane(tid >> 6), G = fresh_int((int)gridDim.x);
            const LAS f32x2* rope = (const LAS f32x2*)(L + ROPE_OFF);
            for (int c = BID(); c < 256; c += G) {
                const int b = c >> 6;
                token_rows(P.QKV, P.Qb, P.Qc, P.Kb, P.Vb, P.MRG, P.q_norm_g + l * HD, P.k_norm_g + l * HD, P.conv_w + (size_t)l * 3 * CW, P.conv_b + l * CW, P.conv_out_g + l * CW, rope, b, (c & 63) * 64 + 8 * wave, 8, true, lane);
                if (wave < 4) token_rows(P.QKV, P.Qb, P.Qc, P.Kb, P.Vb, P.MRG, P.q_norm_g + l * HD, P.k_norm_g + l * HD, P.conv_w + (size_t)l * 3 * CW, P.conv_b + l * CW, P.conv_out_g + l * CW, rope, b, (c & 63) * 4 + wave, 1, false, lane);
            }
        }
        GRID_BAR();

        {
            const Ptrs P = make_ptrs(fresh_args()); const int G = fresh_int((int)gridDim.x);
            const int nunits = (l == NL - 1) ? 512 : 544;
            for (int u = BID(); u < nunits; u += G) {
                const bf16 *q, *k, *v; bf16* o; float* rs; const float* gn; int seq;
                if (u < 512) { const int grp = u & 7, idx = u >> 3, b = grp >> 1, kv = grp & 1, h = kv * 4 + (idx >> 4), qb = idx & 15;
                    q = P.Qb + ((size_t)(b * NH + h) * SEQ + 256 * qb) * HD; k = P.Kb + (size_t)(b * NKV + kv) * SKV * HD; v = P.Vb + (size_t)(b * NKV + kv) * SKV * HD;
                    o = P.MRG + (size_t)(b * SEQ + 256 * qb) * DM + h * HD; rs = P.RSA + (size_t)(b * SEQ + 256 * qb) * 8 + h; gn = P.attn_out_g + l * AW + h * HD; seq = SKV; }
                else { const int cu = u - 512, b = cu >> 3, h = cu & 7, kv = h >> 2;
                    q = P.Qc + (size_t)(b * NH + h) * CTX * HD; k = P.Kb + ((size_t)(b * NKV + kv) * SKV + SEQ) * HD; v = P.Vb + ((size_t)(b * NKV + kv) * SKV + SEQ) * HD;
                    o = P.MRG + (size_t)(ML + b * CTX) * DM + h * HD; rs = P.RSA + (size_t)(ML + b * CTX) * 8 + h; gn = P.attn_out_g + l * AW + h * HD; seq = CTX; }
                attn::attn_dense_body(q, k, v, o, gn, rs, seq, (char*)lds + RING_OFF, (char*)lds + STASH_OFF, fresh_int(wave_s));
                __syncthreads();
            }
        }
        GRID_BAR();

        {
            const Ptrs P = make_ptrs(fresh_args()); const int G = fresh_int((int)gridDim.x); const int Mrows = (l == NL - 1) ? ML : MT;
            pg8::Gemm g{P.MRG, P.WT + (size_t)l * W_LAYER_E + W_IN_E, Mrows, DM, DM}; pg8::ResidOrder S; S.init(ML, DM, DM, G, BID(), l != NL - 1);
            pg8::EpiResid<true> E{(l == 0) ? P.x_in : nullptr, P.XB, nullptr, P.XB, P.MOD + (size_t)l * 5 * MODW + 2 * DM, MODW, P.PART, P.RSA, L + STASH_OFF};
            pg8::gemm_phase<pg8::EpiResid<true>, pg8::ResidOrder, true, true>(L + RING_OFF, g, S, E, fresh_int(wave_s));
        }
        GRID_BAR();

        {
            const Ptrs P = make_ptrs(fresh_args()); const int tid = (fresh_int(wave_s) * 64 + lane_id()), lane = tid & 63, wave = __builtin_amdgcn_readfirstlane(tid >> 6), G = fresh_int((int)gridDim.x);
            norm_mod_phase(nullptr, P.XB, (l == 0) ? P.ctx_in : P.XC, P.XC, P.PART, P.MOD + (size_t)l * 5 * MODW + 4 * MODW + 2 * DM, P.RSA + (size_t)ML * 8, l != NL - 1, P.H, P.norm2_g + (size_t)l * DM, P.MOD + (size_t)l * 5 * MODW, 3, 4, BID(), G, wave, lane);
        }
        GRID_BAR();

        {
            const Ptrs P = make_ptrs(fresh_args()); const int G = fresh_int((int)gridDim.x); const int Mrows = (l == NL - 1) ? ML : MT;
            pg8::Gemm g{P.H, P.WT + (size_t)l * W_LAYER_E + W_IN_E + W_OUT_E, Mrows, FF, DM}; pg8::StaticOrder S; S.init(Mrows, FF, DM, G, BID());
            pg8::EpiBf16<2> E{P.HB, FF, nullptr};
            pg8::gemm_phase<pg8::EpiBf16<2>, pg8::StaticOrder, true, true>(L + RING_OFF, g, S, E, fresh_int(wave_s));
            { const int rem = S.nwg % G, j = BID() - rem; if (l + 1 < NL && G == 256 && rem == 128 && j >= 0) { const int tid = (fresh_int(wave_s) * 64 + lane_id()), lane = tid & 63, wave = __builtin_amdgcn_readfirstlane(tid >> 6);
                silu_table(P.c_in, P.cctx_in, L, tid); adaln_item(P.w_ada, P.b_ada, P.MOD, (LAS float*)(L + RING_OFF), (LAS float*)(L + RING_OFF) + 5 * DM, (l + 1) * 192 + j, tid, wave, lane); } }
        }
        GRID_BAR();

        {
            const Ptrs P = make_ptrs(fresh_args()); const int G = fresh_int((int)gridDim.x); const int Mrows = (l == NL - 1) ? ML : MT;
            pg8::Gemm g{P.HB, P.WT + (size_t)l * W_LAYER_E + W_IN_E + W_OUT_E + W_1_E, Mrows, DM, FF}; pg8::ResidOrder S; S.init(ML, DM, FF, G, BID(), l != NL - 1);
            pg8::EpiResid<false> E{nullptr, P.XB, (l == NL - 1) ? P.out : nullptr, P.XB, P.MOD + (size_t)l * 5 * MODW + 5 * DM, MODW, P.PART, nullptr, L + STASH_OFF};
            pg8::gemm_phase<pg8::EpiResid<false>, pg8::ResidOrder, true, true>(L + RING_OFF, g, S, E, fresh_int(wave_s));
        }
        if (l != NL - 1) GRID_BAR();
    }
}

extern "C" void kernel_launch(void* const* d_in, const int* in_sizes, int n_in, void* d_out, int out_size, void* d_ws, size_t ws_size, hipStream_t stream) {
    static int grid = 0;
    if (grid == 0) {
        if (n_in != 18 || in_sizes[0] != ML * DM || out_size != ML * DM || ws_size < WS_END) {
            fprintf(stderr, "kernel_launch: shape mismatch: n_in %d in0 %d out %d ws %zu (need %zu)\n", n_in, n_in > 0 ? in_sizes[0] : -1, out_size, ws_size, (size_t)WS_END); grid = -1; return; }
        int dev = 0, cus = 0, per_cu = 0;
        if (hipGetDevice(&dev) != hipSuccess || hipDeviceGetAttribute(&cus, hipDeviceAttributeMultiprocessorCount, dev) != hipSuccess) { fprintf(stderr, "kernel_launch: device query failed\n"); grid = -1; return; }
        if (hipFuncSetAttribute((const void*)fwd_kernel, hipFuncAttributeMaxDynamicSharedMemorySize, LDS_BYTES) != hipSuccess) { fprintf(stderr, "kernel_launch: hipFuncSetAttribute failed\n"); grid = -1; return; }
        if (hipOccupancyMaxActiveBlocksPerMultiprocessor(&per_cu, (const void*)fwd_kernel, NWAVES * 64, LDS_BYTES) != hipSuccess || per_cu < 1)
            fprintf(stderr, "kernel_launch: note: occupancy query reports %d workgroups per CU\n", per_cu);
        (void)hipGetLastError();
        grid = cus < 256 ? (cus / 8) * 8 : 256;
        if (grid < 8) grid = cus;
    }
    if (grid < 0) return;
    if (hipMemsetAsync((char*)d_ws + WS_CTL, 0, CTL_ZERO_BYTES, stream) != hipSuccess) { fprintf(stderr, "kernel_launch: memset failed\n"); return; }
    Args a{};
    for (int i = 0; i < 18; ++i) a.in[i] = (const float*)d_in[i];
    a.out = (float*)d_out; a.ws = (unsigned char*)d_ws;
    hipLaunchKernelGGL(fwd_kernel, dim3(grid), dim3(NWAVES * 64), LDS_BYTES, stream, a);
    const hipError_t le = hipPeekAtLastError();
    if (le != hipSuccess) fprintf(stderr, "kernel_launch: launch failed: %s\n", hipGetErrorName(le));
}
```

```cpp
#include <hip/hip_runtime.h>
#include <cstdio>
#include <cstdint>
namespace pg8 {
#define PG8_LAS __attribute__((address_space(3)))
typedef unsigned short bf16_t;
typedef short bf16x8 __attribute__((ext_vector_type(8)));
typedef float f32x4 __attribute__((ext_vector_type(4)));
typedef unsigned u32x4 __attribute__((ext_vector_type(4)));
constexpr int BM = 256, BK = 64, HALF = 128, HTB = HALF * BK * 2  , STAGE_BYTES = 8 * HTB, NXCD = 8, WGM = 8;

__host__ __device__ __forceinline__ int lds_byte(int r, int c) { const int st = (r >> 4) * 2 + (c >> 5), rr = r & 15, cc = c & 31, ob = rr * 64 + cc * 2; return st * 1024 + (ob ^ (((ob >> 9) & 1) << 5)); }
__host__ __device__ __forceinline__ void stage_rc(int b, int& R, int& C) { const int st = b / 1024, sb = b % 1024, swz = sb ^ (((sb >> 9) & 1) << 5); R = (st >> 1) * 16 + swz / 64; C = (st & 1) * 32 + (swz % 64) / 2; }
__host__ __device__ __forceinline__ int perm32(int rho) { const int n = rho >> 4, i = rho & 15; return 8 * (i >> 2) + 4 * n + (i & 3); }

struct Unit { int pm, pn, k0, nt, kind; };
struct Gemm { const bf16_t* A; const bf16_t* Bt; int M, N, K; };

struct StaticOrder {
    int nM, nN, nwg, G, c, ntf, tr = 0;
    __host__ __device__ void init(int M, int N, int K, int G_, int c_) { nM = M / BM; nN = N / BM; nwg = nM * nN; G = G_; c = c_; ntf = K / BK; }
    __host__ __device__ bool next(int i, Unit& u) const {
        const long L = (long)i * G + c; if (L >= nwg) return false;
        int wgid = (int)L; { const int q = nwg / NXCD, r = nwg % NXCD, xcd = wgid % NXCD, off = wgid / NXCD; wgid = (xcd < r ? xcd * (q + 1) : r * (q + 1) + (xcd - r) * q) + off; }
        const int nig = WGM * nN, gid = wgid / nig, fm = gid * WGM, gsz = (nM - fm) < WGM ? (nM - fm) : WGM;
        const int idx = wgid % nig; if (tr) { u.pm = fm + idx / nN; u.pn = idx % nN; } else { u.pm = fm + (idx % gsz); u.pn = idx / gsz; } u.k0 = 0; u.nt = ntf; u.kind = 0; return true;
    }
    __device__ __forceinline__ void a_ready(const Unit&) const {}
    __device__ __forceinline__ void done(const Unit&) const {}
};

__device__ __forceinline__ unsigned cvt_pk_bf16(float lo, float hi) { unsigned r; asm volatile("v_cvt_pk_bf16_f32 %0, %1, %2" : "=v"(r) : "v"(lo), "v"(hi)); return r; }
typedef float f32x2 __attribute__((ext_vector_type(2)));


__device__ __forceinline__ float relu1(float x) { float r; asm("v_max_f32 %0, 0, %1" : "=v"(r) : "v"(x)); return r; }
#define PG8_PAIR_STORE(P, LDC, W0, W1) do { const u32x4 snd_ = hb ? (W0) : (W1); u32x4 rcv_; \
    rcv_.x = (unsigned)__builtin_amdgcn_mov_dpp((int)snd_.x, 0xB1, 0xF, 0xF, true); rcv_.y = (unsigned)__builtin_amdgcn_mov_dpp((int)snd_.y, 0xB1, 0xF, 0xF, true); \
    rcv_.z = (unsigned)__builtin_amdgcn_mov_dpp((int)snd_.z, 0xB1, 0xF, 0xF, true); rcv_.w = (unsigned)__builtin_amdgcn_mov_dpp((int)snd_.w, 0xB1, 0xF, 0xF, true); \
    *(u32x4*)(P) = hb ? rcv_ : (W0); *(u32x4*)((P) + (LDC)) = hb ? (W1) : rcv_; } while (0)
template <int ACT, bool ZF = false> struct EpiBf16 {
    static constexpr bool PERM = true, AFTER_DRAIN = false, MIDK = false; static constexpr int MIDK_TILE = 0;
    __device__ __forceinline__ void mid(f32x4 (&)[2][2][4][2], const Unit&, int) const {}
    __device__ __forceinline__ void pre(const Unit&, int, int, int) const {}
    bf16_t* O; int ldc; bf16_t* V;
    __device__ __forceinline__ void operator()(const f32x4 (&acc)[2][2][4][2], const Unit& u, int wr, int wc, int fr, int fq) const {
        const int row0 = u.pm * BM + wr * 64 + fr; const int col0 = u.pn * BM + wc * 64 + 8 * fq;
        if constexpr (ZF) {
            if (u.pn == 5) {
                const int hb = fr & 1, b = u.pm < 64 ? (u.pm >> 4) : (u.pm - 64), pos0 = (u.pm < 64 ? (u.pm & 15) * BM : 4096) + wr * 64 + fr - hb;
                bf16_t* vbase = V + ((size_t)(b * 2 + (wc >> 1)) * 4352 + pos0) * 128 + (wc & 1) * 64 + 8 * fq + 32 * hb;
#pragma unroll
                for (int ai = 0; ai < 2; ++ai)
#pragma unroll
                    for (int m = 0; m < 4; ++m) { u32x4 w[2];
#pragma unroll
                        for (int bj = 0; bj < 2; ++bj) { const f32x4 v0 = acc[ai][bj][m][0], v1 = acc[ai][bj][m][1];
                            w[bj].x = cvt_pk_bf16(v0[0], v0[1]); w[bj].y = cvt_pk_bf16(v0[2], v0[3]); w[bj].z = cvt_pk_bf16(v1[0], v1[1]); w[bj].w = cvt_pk_bf16(v1[2], v1[3]); }
                        bf16_t* rp = vbase + (size_t)(ai * HALF + m * 16) * 128;
                        PG8_PAIR_STORE(rp, 128, w[0], w[1]); }
                return;
            }
            if (u.pn >= 10) {
                const int zc0 = 2560 + (u.pn - 10) * HALF + wc * 32 + 8 * fq;
#pragma unroll
                for (int ai = 0; ai < 2; ++ai)
#pragma unroll
                    for (int m = 0; m < 4; ++m) { const f32x4 v0 = acc[ai][0][m][0] * acc[ai][1][m][0], v1 = acc[ai][0][m][1] * acc[ai][1][m][1];
                        u32x4 w; w.x = cvt_pk_bf16(v0[0], v0[1]); w.y = cvt_pk_bf16(v0[2], v0[3]); w.z = cvt_pk_bf16(v1[0], v1[1]); w.w = cvt_pk_bf16(v1[2], v1[3]);
                        *(u32x4*)(O + (size_t)(row0 + ai * HALF + m * 16) * ldc + zc0) = w; }
                return;
            }
        }
        const int hb = fr & 1; bf16_t* base = O + (size_t)(row0 - hb) * ldc + col0 + 32 * hb;
#pragma unroll
        for (int ai = 0; ai < 2; ++ai)
#pragma unroll
            for (int m = 0; m < 4; ++m) { u32x4 w[2];
#pragma unroll
                for (int bj = 0; bj < 2; ++bj) { f32x4 v0 = acc[ai][bj][m][0], v1 = acc[ai][bj][m][1];
                    if (ACT == 2) { _Pragma("unroll") for (int e_ = 0; e_ < 4; ++e_) { v0[e_] = relu1(v0[e_]); v1[e_] = relu1(v1[e_]); } v0 = v0 * v0; v1 = v1 * v1; }
                    w[bj].x = cvt_pk_bf16(v0[0], v0[1]); w[bj].y = cvt_pk_bf16(v0[2], v0[3]); w[bj].z = cvt_pk_bf16(v1[0], v1[1]); w[bj].w = cvt_pk_bf16(v1[2], v1[3]); }
                bf16_t* rp = base + (size_t)(ai * HALF + m * 16) * ldc;
                PG8_PAIR_STORE(rp, ldc, w[0], w[1]); }
    }
};

template <bool MIDK_> struct EpiResid {
    static constexpr bool PERM = true, AFTER_DRAIN = false, MIDK = MIDK_; static constexpr int MIDK_TILE = 16;
    const float* xin_f; const bf16_t* xin_b; float* xout_f; bf16_t* xout_b; const float* gate; int gstride; bf16_t* part; const float* rsa; PG8_LAS unsigned char* stash;
    __device__ __forceinline__ void pre(const Unit& u, int wr, int fr, int tid) const {
        if constexpr (MIDK_) {
            typedef __fp16 h2 __attribute__((ext_vector_type(2)));
            const int row0 = (u.kind == 0 ? u.pm * BM : 0) + wr * 64 + fr; float t[8], f[8];
            {
                f32x4 q[8][2];
#pragma unroll
                for (int i = 0; i < 8; ++i) { const float* rp = rsa + (size_t)(row0 + (i >> 2) * HALF + (i & 3) * 16) * 8; q[i][0] = *(const f32x4*)rp; q[i][1] = *(const f32x4*)(rp + 4); }
                asm volatile("" ::: "memory");
#pragma unroll
                for (int i = 0; i < 8; ++i) t[i] = ((q[i][0][0] + q[i][0][1]) + (q[i][0][2] + q[i][0][3])) + ((q[i][1][0] + q[i][1][1]) + (q[i][1][2] + q[i][1][3]));
            }
#pragma unroll
            for (int i = 0; i < 8; ++i) f[i] = 1.0f / sqrtf(t[i] * (1.f / 1024.f) + 1e-6f);
            u32x4 w;
            w.x = __builtin_bit_cast(unsigned, __builtin_amdgcn_cvt_pkrtz(f[0], f[1])); w.y = __builtin_bit_cast(unsigned, __builtin_amdgcn_cvt_pkrtz(f[2], f[3]));
            w.z = __builtin_bit_cast(unsigned, __builtin_amdgcn_cvt_pkrtz(f[4], f[5])); w.w = __builtin_bit_cast(unsigned, __builtin_amdgcn_cvt_pkrtz(f[6], f[7]));
            *(PG8_LAS u32x4*)(stash + tid * 16) = w;
        }
    }
    __device__ __forceinline__ void mid(f32x4 (&acc)[2][2][4][2], const Unit& u, int tid) const {
        if (u.kind != 0) return;
        typedef _Float16 hf2 __attribute__((ext_vector_type(2)));
        const u32x4 w = *(const PG8_LAS u32x4*)(stash + tid * 16);
        const unsigned wq[4] = {w.x, w.y, w.z, w.w}; float f[8];
#pragma unroll
        for (int i = 0; i < 4; ++i) { const hf2 p = __builtin_bit_cast(hf2, wq[i]); f[2 * i] = (float)p[0]; f[2 * i + 1] = (float)p[1]; }
#pragma unroll
        for (int ai = 0; ai < 2; ++ai)
#pragma unroll
            for (int m = 0; m < 4; ++m)
#pragma unroll
                for (int bj = 0; bj < 2; ++bj)
#pragma unroll
                    for (int n = 0; n < 2; ++n) acc[ai][bj][m][n] = acc[ai][bj][m][n] * f[ai * 4 + m];
    }
    __device__ __forceinline__ void operator()(const f32x4 (&acc)[2][2][4][2], const Unit& u, int wr, int wc, int fr, int fq) const {
        int prow = (u.pm < 64 ? u.pm : u.pm - 64) * BM + wr * 64 + fr, col0 = u.pn * BM + wc * 64 + 8 * fq;
        asm volatile("" : "+v"(prow), "+v"(col0));
        const int hb = prow & 1;
        if (u.kind == 0) {
            const float* gp = gate + (size_t)(u.pm >> 4) * gstride + col0;
            f32x4 gv[2][2];
#pragma unroll
            for (int bj = 0; bj < 2; ++bj)
#pragma unroll
                for (int n = 0; n < 2; ++n) gv[bj][n] = *(const f32x4*)(gp + bj * 32 + n * 4);
            if (xin_f) {
#pragma unroll
                for (int am = 0; am < 4; ++am) { const int ai = am >> 1, mh = am & 1;
                    f32x4 xv[2][2][2];
#pragma unroll
                    for (int mm = 0; mm < 2; ++mm) { const size_t off = (size_t)(prow + ai * HALF + (2 * mh + mm) * 16) * 2048 + col0;
#pragma unroll
                        for (int bj = 0; bj < 2; ++bj)
#pragma unroll
                            for (int n = 0; n < 2; ++n) xv[mm][bj][n] = *(const f32x4*)(xin_f + off + bj * 32 + n * 4); }
                    asm volatile("" ::: "memory");
#pragma unroll
                    for (int mm = 0; mm < 2; ++mm) { const int m = 2 * mh + mm; const size_t off = (size_t)(prow + ai * HALF + m * 16) * 2048 + col0;
                        u32x4 w[2];
#pragma unroll
                        for (int bj = 0; bj < 2; ++bj) { const f32x4 v0 = xv[mm][bj][0] + gv[bj][0] * acc[ai][bj][m][0], v1 = xv[mm][bj][1] + gv[bj][1] * acc[ai][bj][m][1];
                            w[bj].x = cvt_pk_bf16(v0[0], v0[1]); w[bj].y = cvt_pk_bf16(v0[2], v0[3]); w[bj].z = cvt_pk_bf16(v1[0], v1[1]); w[bj].w = cvt_pk_bf16(v1[2], v1[3]); }
                        PG8_PAIR_STORE(xout_b + off - (size_t)hb * 2048 + 32 * hb, 2048, w[0], w[1]); }
                    asm volatile("" ::: "memory");
                }
            } else {
                const bool of = xout_f != nullptr;
#pragma unroll
                for (int ai = 0; ai < 2; ++ai) {
                    u32x4 raw[4][2];
#pragma unroll
                    for (int m = 0; m < 4; ++m) { const size_t off = (size_t)(prow + ai * HALF + m * 16) * 2048 + col0;
#pragma unroll
                        for (int bj = 0; bj < 2; ++bj) raw[m][bj] = *(const u32x4*)(xin_b + off + bj * 32); }
                    asm volatile("" ::: "memory");
#pragma unroll
                    for (int m = 0; m < 4; ++m) { const size_t off = (size_t)(prow + ai * HALF + m * 16) * 2048 + col0;
                        u32x4 w[2];
#pragma unroll
                        for (int bj = 0; bj < 2; ++bj) { const u32x4 rw = raw[m][bj];
                            f32x4 x0, x1;
                            x0[0] = __builtin_bit_cast(float, rw.x << 16); x0[1] = __builtin_bit_cast(float, rw.x & 0xffff0000u); x0[2] = __builtin_bit_cast(float, rw.y << 16); x0[3] = __builtin_bit_cast(float, rw.y & 0xffff0000u);
                            x1[0] = __builtin_bit_cast(float, rw.z << 16); x1[1] = __builtin_bit_cast(float, rw.z & 0xffff0000u); x1[2] = __builtin_bit_cast(float, rw.w << 16); x1[3] = __builtin_bit_cast(float, rw.w & 0xffff0000u);
                            const f32x4 v0 = x0 + gv[bj][0] * acc[ai][bj][m][0], v1 = x1 + gv[bj][1] * acc[ai][bj][m][1];
                            if (of) { *(f32x4*)(xout_f + off + bj * 32) = v0; *(f32x4*)(xout_f + off + bj * 32 + 4) = v1; }
                            else { w[bj].x = cvt_pk_bf16(v0[0], v0[1]); w[bj].y = cvt_pk_bf16(v0[2], v0[3]); w[bj].z = cvt_pk_bf16(v1[0], v1[1]); w[bj].w = cvt_pk_bf16(v1[2], v1[3]); } }
                        if (!of) PG8_PAIR_STORE(xout_b + off - (size_t)hb * 2048 + 32 * hb, 2048, w[0], w[1]); }
                    asm volatile("" ::: "memory");
                }
            }
        } else {
            bf16_t* po = part + (size_t)(u.kind - 1) * 1024 * 2048;
#pragma unroll
            for (int ai = 0; ai < 2; ++ai)
#pragma unroll
                for (int m = 0; m < 4; ++m) { const size_t off = (size_t)(prow + ai * HALF + m * 16) * 2048 + col0;
                    u32x4 w[2];
#pragma unroll
                    for (int bj = 0; bj < 2; ++bj) { const f32x4 v0 = acc[ai][bj][m][0], v1 = acc[ai][bj][m][1];
                        w[bj].x = cvt_pk_bf16(v0[0], v0[1]); w[bj].y = cvt_pk_bf16(v0[2], v0[3]); w[bj].z = cvt_pk_bf16(v1[0], v1[1]); w[bj].w = cvt_pk_bf16(v1[2], v1[3]); }
                    PG8_PAIR_STORE(po + off - (size_t)hb * 2048 + 32 * hb, 2048, w[0], w[1]); }
        }
    }
};

struct ResidOrder {
    StaticOrder lat; int has_ctx, kc, ntc;
    __device__ void init(int Mlat, int N, int K, int G, int c, int has_ctx_) { lat.init(Mlat, N, K, G, c); lat.tr = 1; has_ctx = has_ctx_; kc = K / 8; ntc = kc / BK; }
    __device__ bool next(int i, Unit& u) const {
        if (lat.next(i, u)) return true;
        if (!has_ctx) return false;
        const long L = (long)i * lat.G + lat.c; const int j = (int)(L - lat.nwg); if (j >= 256) return false;
        const int ks = j & 7; u.pn = (j >> 3) & 7; u.pm = lat.nM + (j >> 6); u.k0 = ks * kc; u.nt = ntc; u.kind = 1 + ks; return true;
    }
    __device__ __forceinline__ void a_ready(const Unit&) const {}
    __device__ __forceinline__ void done(const Unit&) const {}
};

template <class Epi, class Sched, bool ALIGN_EPI = false, bool SP2 = false>
__device__ __forceinline__ void gemm_phase(PG8_LAS unsigned char* lds, const Gemm g, const Sched& S, const Epi& E, int wave_id) {
    unsigned z_ = 0u; asm volatile("" : "+v"(z_)); const int lane_ = (int)__builtin_amdgcn_mbcnt_hi(~0u, __builtin_amdgcn_mbcnt_lo(~0u, z_));
    const int wid = wave_id, lane = lane_, tid = wid * 64 + lane, wr = wid >> 2, wc = wid & 3, fr = lane & 15, fq = lane >> 4;
    const int K = g.K;
    unsigned voffA[2], voffB[2];
#pragma unroll
    for (int i = 0; i < 2; ++i) { int R, C; stage_rc(tid * 16 + i * 8192, R, C); const int Rb = Epi::PERM ? (64 * (R >> 5) + perm32(R & 31)) : R;
        voffA[i] = (unsigned)(R * K + C) * 2u; voffB[i] = (unsigned)(Rb * K + C) * 2u; }
    const size_t kstep = (size_t)(BK * 2);
    const size_t hstep = (size_t)HALF * K * 2;
    const size_t hstepB = Epi::PERM ? (size_t)32 * K * 2 : hstep;
    const size_t tstep = 2 * hstep;
    const unsigned ldsw = (unsigned)wid * 1024u;
    const int aoff = lds_byte(wr * 64 + fr, fq * 8), boff = lds_byte(wc * 32 + fr, fq * 8);
#define PG8_SA(b, h) (((b) * 2 + (h)) * HTB)
#define PG8_SB(b, h) ((4 + (b) * 2 + (h)) * HTB)
#define PG8_STAGE(bufoff, gbase, voff) do { _Pragma("unroll") for (int _i = 0; _i < 2; ++_i) \
        __builtin_amdgcn_global_load_lds((const unsigned*)((const char*)(gbase) + (voff)[_i]), (PG8_LAS unsigned*)(lds + (bufoff) + ldsw + _i * 8192), 16, 0, 0); } while (0)
#define PG8_LDA(dst, b, h) do { _Pragma("unroll") for (int m = 0; m < 4; ++m) _Pragma("unroll") for (int k = 0; k < 2; ++k) dst[m][k] = *(const PG8_LAS bf16x8*)(lds + PG8_SA(b, h) + aoff + m * 2048 + k * 1024); } while (0)
#define PG8_LDB(dst, b, h) do { _Pragma("unroll") for (int n = 0; n < 2; ++n) _Pragma("unroll") for (int k = 0; k < 2; ++k) dst[n][k] = *(const PG8_LAS bf16x8*)(lds + PG8_SB(b, h) + boff + n * 2048 + k * 1024); } while (0)
#define PG8_MMA(ai, bj, At, Bt) do { __builtin_amdgcn_s_setprio(1); _Pragma("unroll") for (int m = 0; m < 4; ++m) _Pragma("unroll") for (int n = 0; n < 2; ++n) _Pragma("unroll") for (int k = 0; k < 2; ++k) \
        acc[ai][bj][m][n] = __builtin_amdgcn_mfma_f32_16x16x32_bf16(Bt[n][k], At[m][k], acc[ai][bj][m][n], 0, 0, 0); __builtin_amdgcn_s_setprio(0); } while (0)
#define PG8_WAIT_V(n) asm volatile("s_waitcnt vmcnt(" #n ")" ::: "memory")
#define PG8_WAIT_L(n) asm volatile("s_waitcnt lgkmcnt(" #n ")" ::: "memory")
#define PG8_BAR __builtin_amdgcn_s_barrier()
#define PG8_SCHED __builtin_amdgcn_sched_barrier(0)
    Unit cur, nxt; int ui = 0;
    if (!S.next(0, cur)) return;
    f32x4 acc[2][2][4][2];
#pragma unroll
    for (int a = 0; a < 2; ++a)
#pragma unroll
        for (int b = 0; b < 2; ++b)
#pragma unroll
            for (int m = 0; m < 4; ++m)
#pragma unroll
                for (int n = 0; n < 2; ++n) acc[a][b][m][n] = (f32x4){0.f, 0.f, 0.f, 0.f};
    bf16x8 At[4][2], B0[2][2], B1[2][2];
    const char* cA = (const char*)g.A + (size_t)cur.pm * tstep + (size_t)cur.k0 * 2; const char* cB = (const char*)g.Bt + (size_t)cur.pn * tstep + (size_t)cur.k0 * 2;
    S.a_ready(cur);
    if constexpr (Epi::MIDK) E.pre(cur, wr, fr, tid);
    if constexpr (SP2) {
        PG8_STAGE(PG8_SB(0, 0), cB, voffB); PG8_STAGE(PG8_SB(0, 1), cB + hstepB, voffB); PG8_STAGE(PG8_SA(0, 0), cA, voffA); PG8_STAGE(PG8_SA(0, 1), cA + hstep, voffA);
        if (wr == 1) PG8_BAR;
        PG8_WAIT_V(2); PG8_BAR;
        PG8_STAGE(PG8_SB(1, 0), cB + kstep, voffB); PG8_STAGE(PG8_SA(1, 0), cA + kstep, voffA); PG8_STAGE(PG8_SB(1, 1), cB + hstepB + kstep, voffB);
        PG8_WAIT_V(6); PG8_BAR;
    } else {
        PG8_STAGE(PG8_SB(0, 0), cB, voffB); PG8_STAGE(PG8_SA(0, 0), cA, voffA); PG8_STAGE(PG8_SB(0, 1), cB + hstepB, voffB); PG8_STAGE(PG8_SA(0, 1), cA + hstep, voffA);
        if (wr == 1) PG8_BAR;
        PG8_WAIT_V(4); PG8_BAR;
        PG8_STAGE(PG8_SB(1, 0), cB + kstep, voffB); PG8_STAGE(PG8_SA(1, 0), cA + kstep, voffA); PG8_STAGE(PG8_SB(1, 1), cB + hstepB + kstep, voffB);
        PG8_WAIT_V(6); PG8_BAR;
    }
    for (;;) {
        const bool has_next = S.next(ui + 1, nxt);
        const char* nA = has_next ? (const char*)g.A + (size_t)nxt.pm * tstep + (size_t)nxt.k0 * 2 : cA; const char* nB = has_next ? (const char*)g.Bt + (size_t)nxt.pn * tstep + (size_t)nxt.k0 * 2 : cB;
        const int nt = cur.nt;
        for (int t = 0; t < nt; t += 2) {
            const bool last = (t == nt - 2);
            const char* a1 = cA + (size_t)(t + 1) * kstep;
            const char* a2 = last ? nA : cA + (size_t)(t + 2) * kstep; const char* b2 = last ? nB : cB + (size_t)(t + 2) * kstep;
            const char* a3 = a2 + kstep; const char* b3 = b2 + kstep;
            if (last && has_next) S.a_ready(nxt);
            if constexpr (Epi::MIDK) { if (t == Epi::MIDK_TILE) E.mid(acc, cur, tid); }
            if constexpr (SP2) {
            PG8_LDB(B0, 0, 0); PG8_LDB(B1, 0, 1); PG8_SCHED; PG8_LDA(At, 0, 0); PG8_STAGE(PG8_SA(1, 1), a1 + hstep, voffA);
            PG8_WAIT_V(8); PG8_WAIT_L(0); PG8_BAR; PG8_MMA(0, 0, At, B0); PG8_MMA(0, 1, At, B1); PG8_BAR; PG8_SCHED;
            PG8_LDA(At, 0, 1); PG8_STAGE(PG8_SB(0, 0), b2, voffB); PG8_STAGE(PG8_SB(0, 1), b2 + hstepB, voffB); PG8_STAGE(PG8_SA(0, 0), a2, voffA);
            PG8_WAIT_V(8); PG8_WAIT_L(0); PG8_BAR; PG8_MMA(1, 0, At, B0); PG8_MMA(1, 1, At, B1); PG8_BAR; PG8_SCHED;
            PG8_LDB(B0, 1, 0); PG8_LDB(B1, 1, 1); PG8_SCHED; PG8_LDA(At, 1, 0); PG8_STAGE(PG8_SA(0, 1), a2 + hstep, voffA);
            PG8_WAIT_V(8); PG8_WAIT_L(0); PG8_BAR; PG8_MMA(0, 0, At, B0); PG8_MMA(0, 1, At, B1); PG8_BAR; PG8_SCHED;
            PG8_LDA(At, 1, 1); PG8_STAGE(PG8_SB(1, 0), b3, voffB); PG8_STAGE(PG8_SB(1, 1), b3 + hstepB, voffB); PG8_STAGE(PG8_SA(1, 0), a3, voffA);
            PG8_WAIT_V(8); PG8_WAIT_L(0); PG8_BAR; PG8_MMA(1, 0, At, B0); PG8_MMA(1, 1, At, B1); PG8_BAR; PG8_SCHED;
            } else {
            PG8_LDB(B0, 0, 0); PG8_SCHED; PG8_LDA(At, 0, 0); PG8_STAGE(PG8_SA(1, 1), a1 + hstep, voffA);
            PG8_WAIT_L(8); PG8_BAR; PG8_WAIT_L(0); PG8_MMA(0, 0, At, B0); PG8_BAR; PG8_SCHED;
            PG8_LDB(B1, 0, 1); PG8_STAGE(PG8_SB(0, 0), b2, voffB);
            PG8_BAR; PG8_WAIT_L(0); PG8_MMA(0, 1, At, B1); PG8_BAR;
            PG8_LDA(At, 0, 1); PG8_STAGE(PG8_SA(0, 0), a2, voffA);
            PG8_BAR; PG8_WAIT_L(0); PG8_MMA(1, 0, At, B0); PG8_BAR; PG8_SCHED;
            PG8_STAGE(PG8_SB(0, 1), b2 + hstepB, voffB);
            PG8_WAIT_V(6); PG8_BAR; PG8_MMA(1, 1, At, B1); PG8_BAR;
            PG8_LDB(B0, 1, 0); PG8_SCHED; PG8_LDA(At, 1, 0); PG8_STAGE(PG8_SA(0, 1), a2 + hstep, voffA);
            PG8_WAIT_L(8); PG8_BAR; PG8_WAIT_L(0); PG8_MMA(0, 0, At, B0); PG8_BAR; PG8_SCHED;
            PG8_LDB(B1, 1, 1); PG8_STAGE(PG8_SB(1, 0), b3, voffB);
            PG8_BAR; PG8_WAIT_L(0); PG8_MMA(0, 1, At, B1); PG8_BAR;
            PG8_LDA(At, 1, 1); PG8_STAGE(PG8_SA(1, 0), a3, voffA);
            PG8_BAR; PG8_WAIT_L(0); PG8_MMA(1, 0, At, B0); PG8_BAR; PG8_SCHED;
            PG8_STAGE(PG8_SB(1, 1), b3 + hstepB, voffB);
            PG8_WAIT_V(6); PG8_BAR; PG8_MMA(1, 1, At, B1); PG8_BAR;
            }
        }
        if constexpr (ALIGN_EPI) { if (wr == 0) PG8_BAR; }
        if constexpr (!Epi::AFTER_DRAIN) { E(acc, cur, wr, wc, fr, fq); S.done(cur); }
        if (!has_next) break;
        if constexpr (Epi::MIDK) E.pre(nxt, wr, fr, tid);
#pragma unroll
        for (int a = 0; a < 2; ++a)
#pragma unroll
            for (int b = 0; b < 2; ++b)
#pragma unroll
                for (int m = 0; m < 4; ++m)
#pragma unroll
                    for (int n = 0; n < 2; ++n) acc[a][b][m][n] = (f32x4){0.f, 0.f, 0.f, 0.f};
        cur = nxt; cA = nA; cB = nB; ++ui;
        if constexpr (ALIGN_EPI) { if (wr == 1) PG8_BAR; }
    }
    PG8_WAIT_V(0);
    if constexpr (!ALIGN_EPI) { if (wr == 0) PG8_BAR; }
    PG8_BAR;
    if constexpr (Epi::AFTER_DRAIN) { E.fused(acc, cur, wr, wc, fr, fq, lds, wid, lane); S.done(cur); }
#undef PG8_SA
#undef PG8_SB
#undef PG8_STAGE
#undef PG8_LDA
#undef PG8_LDB
#undef PG8_MMA
#undef PG8_WAIT_V
#undef PG8_WAIT_L
#undef PG8_BAR
#undef PG8_SCHED
}
}

namespace attn {
typedef unsigned short bf16;
using bf16x8 = __attribute__((ext_vector_type(8))) short;
using s16x4  = __attribute__((ext_vector_type(4))) short;
using f32x16 = __attribute__((ext_vector_type(16))) float;
using u32x4  = __attribute__((ext_vector_type(4))) unsigned;
constexpr int   D = 128, NW = 8, QBLK = 32, KVBLK = 64;
constexpr float SCALE = 0.088388347648318440f;
constexpr float THR = 8.f;
constexpr int SDEPTH = 2;
constexpr int LDQ = 128, LDK = 128, LDO = 2048;
constexpr size_t SHM_V = KVBLK * D * 2, SHM_K = KVBLK * D * 2, SHM_ATTN = 4 * SHM_V + 4 * SHM_K;
#define LAS3 __attribute__((address_space(3)))
#define KSWZ(row, colB) ((row) * 256 + ((colB) ^ (((row) & 7) << 4)))
#define SBAR() __builtin_amdgcn_sched_barrier(0)
__device__ __forceinline__ int crow(int r, int hi) { return (r & 3) + 8 * (r >> 2) + 4 * hi; }
__device__ __forceinline__ unsigned cvtpk(float lo, float hi) {
  unsigned r; asm volatile("v_cvt_pk_bf16_f32 %0, %1, %2" : "=v"(r) : "v"(lo), "v"(hi)); return r;
}
__device__ __forceinline__ bf16x8 ld8(const bf16* p) { return *reinterpret_cast<const bf16x8*>(p); }

__device__ __forceinline__ void partialSM(f32x16& p0, f32x16& p1, float& m_reg, float& mn, float& alpha) {
  constexpr float C = SCALE * 1.4426950408889634f;
  float pmax = p0[0]; for (int r = 1; r < 16; ++r) pmax = fmaxf(pmax, p0[r]); for (int r = 0; r < 16; ++r) pmax = fmaxf(pmax, p1[r]);
  { auto rr = __builtin_amdgcn_permlane32_swap(__float_as_uint(pmax), __float_as_uint(pmax), false, false);
    pmax = fmaxf(__uint_as_float(rr[0]), __uint_as_float(rr[1])); }
  if (__builtin_expect(__all(pmax - m_reg <= THR / SCALE), 1)) { mn = m_reg; alpha = 1.f; }
  else { mn = fmaxf(m_reg, pmax); alpha = __builtin_amdgcn_exp2f((m_reg - mn) * C); m_reg = mn; }
  float mnC = -mn * C;
  for (int r = 0; r < 16; ++r) p0[r] = fmaf(p0[r], C, mnC); for (int r = 0; r < 16; ++r) p1[r] = fmaf(p1[r], C, mnC);
  for (int r = 0; r < 16; ++r) p0[r] = __builtin_amdgcn_exp2f(p0[r]);
}
__device__ __forceinline__ void finishSM(f32x16& p0, f32x16& p1, float alpha, float& l_reg, bf16x8& pa0, bf16x8& pa1, bf16x8& pa2, bf16x8& pa3) {
  for (int r = 0; r < 16; ++r) p1[r] = __builtin_amdgcn_exp2f(p1[r]);
  float ps = 0; for (int r = 0; r < 16; ++r) ps += p0[r]; for (int r = 0; r < 16; ++r) ps += p1[r];
  { auto rr = __builtin_amdgcn_permlane32_swap(__float_as_uint(ps), __float_as_uint(ps), false, false);
    ps = __uint_as_float(rr[0]) + __uint_as_float(rr[1]); }
  l_reg = l_reg * alpha + ps;
#define PK4(P, BASE, OUT) do { unsigned a0 = cvtpk(P[BASE + 0], P[BASE + 1]), a1 = cvtpk(P[BASE + 2], P[BASE + 3]);   \
    unsigned b0 = cvtpk(P[BASE + 4], P[BASE + 5]), b1 = cvtpk(P[BASE + 6], P[BASE + 7]);                              \
    auto r0 = __builtin_amdgcn_permlane32_swap(a0, b0, false, false); auto r1 = __builtin_amdgcn_permlane32_swap(a1, b1, false, false); \
    u32x4 w = {r0[0], r1[0], r0[1], r1[1]}; OUT = *reinterpret_cast<bf16x8*>(&w); } while (0)
  PK4(p0, 0, pa0); PK4(p0, 8, pa1); PK4(p1, 0, pa2); PK4(p1, 8, pa3);
#undef PK4
}
__device__ __forceinline__ float amax3(float a, float b, float c) { float r; asm("v_max3_f32 %0, %1, %2, %3" : "=v"(r) : "v"(a), "v"(b), "v"(c)); return r; }
__device__ __forceinline__ float amax2(float a, float b) { float r; asm("v_max_f32 %0, %1, %2" : "=v"(r) : "v"(a), "v"(b)); return r; }
constexpr float THR2 = 11.541560327111707f;
__device__ __forceinline__ void softmax_step(f32x16& p0, f32x16& p1, f32x16& mt, bool first, float& alpha, float& l_reg, bf16x8& pa0, bf16x8& pa1, bf16x8& pa2, bf16x8& pa3) {
  float mc[4];
#pragma unroll
  for (int k = 0; k < 4; ++k) { float m = amax3(p0[k], p0[k + 4], p0[k + 8]); m = amax3(m, p0[k + 12], p1[k]); m = amax3(m, p1[k + 4], p1[k + 8]); mc[k] = amax2(m, p1[k + 12]); }
  float pmax = amax2(amax3(mc[0], mc[1], mc[2]), mc[3]);
  { auto rr = __builtin_amdgcn_permlane32_swap(__float_as_uint(pmax), __float_as_uint(pmax), false, false);
    pmax = amax2(__uint_as_float(rr[0]), __uint_as_float(rr[1])); }
  alpha = 1.f;
  if (__builtin_expect(first || !__all(pmax <= THR2), 0)) {
    const float delta = first ? pmax : fmaxf(pmax, 0.f);
    alpha = first ? 1.f : __builtin_amdgcn_exp2f(-delta);
    for (int r = 0; r < 16; ++r) { p0[r] -= delta; p1[r] -= delta; mt[r] -= delta; }
  }
  for (int r = 0; r < 16; ++r) p0[r] = __builtin_amdgcn_exp2f(p0[r]);
  for (int r = 0; r < 16; ++r) p1[r] = __builtin_amdgcn_exp2f(p1[r]);
  float s0 = p0[0] + p0[4], s1 = p0[1] + p0[5], s2 = p0[2] + p0[6], s3 = p0[3] + p0[7];
  s0 += p0[8]; s1 += p0[9]; s2 += p0[10]; s3 += p0[11]; s0 += p0[12]; s1 += p0[13]; s2 += p0[14]; s3 += p0[15];
  s0 += p1[0]; s1 += p1[1]; s2 += p1[2]; s3 += p1[3]; s0 += p1[4]; s1 += p1[5]; s2 += p1[6]; s3 += p1[7];
  s0 += p1[8]; s1 += p1[9]; s2 += p1[10]; s3 += p1[11]; s0 += p1[12]; s1 += p1[13]; s2 += p1[14]; s3 += p1[15];
  float ps = (s0 + s1) + (s2 + s3);
  { auto rr = __builtin_amdgcn_permlane32_swap(__float_as_uint(ps), __float_as_uint(ps), false, false);
    ps = __uint_as_float(rr[0]) + __uint_as_float(rr[1]); }
  l_reg = l_reg * alpha + ps;
#define PK4(P, BASE, OUT) do { unsigned a0 = cvtpk(P[BASE + 0], P[BASE + 1]), a1 = cvtpk(P[BASE + 2], P[BASE + 3]);   \
    unsigned b0 = cvtpk(P[BASE + 4], P[BASE + 5]), b1 = cvtpk(P[BASE + 6], P[BASE + 7]);                              \
    auto r0 = __builtin_amdgcn_permlane32_swap(a0, b0, false, false); auto r1 = __builtin_amdgcn_permlane32_swap(a1, b1, false, false); \
    u32x4 w = {r0[0], r1[0], r0[1], r1[1]}; OUT = *reinterpret_cast<bf16x8*>(&w); } while (0)
  PK4(p0, 0, pa0); PK4(p0, 8, pa1); PK4(p1, 0, pa2); PK4(p1, 8, pa3);
#undef PK4
}
template <int OFF> __device__ __forceinline__ bf16x8 kread(int a) { bf16x8 r; asm volatile("ds_read_b128 %0, %1 offset:%2" : "=&v"(r) : "v"(a), "i"(OFF) : "memory"); return r; }
#define KWAIT(N, X, Y) asm volatile("s_waitcnt lgkmcnt(" #N ")" : "+v"(X), "+v"(Y) :: "memory")
#define QM(X, D0) do { p0 = __builtin_amdgcn_mfma_f32_32x32x16_bf16(X##0, qr[D0], p0, 0, 0, 0); p1 = __builtin_amdgcn_mfma_f32_32x32x16_bf16(X##1, qr[D0], p1, 0, 0, 0); } while (0)
#define QKT_ISSUE2() bf16x8 a0 = kread<0>(ka[0]), a1 = kread<8192>(ka[0]); bf16x8 b0 = kread<0>(ka[1]), b1 = kread<8192>(ka[1])
#define QKT_REST() do { \
  KWAIT(2, a0, a1); p0 = __builtin_amdgcn_mfma_f32_32x32x16_bf16(a0, qr[0], mt, 0, 0, 0); p1 = __builtin_amdgcn_mfma_f32_32x32x16_bf16(a1, qr[0], mt, 0, 0, 0); \
  bf16x8 c0 = kread<0>(ka[2]), c1 = kread<8192>(ka[2]); \
  KWAIT(2, b0, b1); QM(b, 1); \
  a0 = kread<0>(ka[3]); a1 = kread<8192>(ka[3]); \
  KWAIT(2, c0, c1); QM(c, 2); \
  b0 = kread<128>(ka[0]); b1 = kread<8320>(ka[0]); \
  KWAIT(2, a0, a1); QM(a, 3); \
  c0 = kread<128>(ka[1]); c1 = kread<8320>(ka[1]); \
  KWAIT(2, b0, b1); QM(b, 4); \
  a0 = kread<128>(ka[2]); a1 = kread<8320>(ka[2]); \
  KWAIT(2, c0, c1); QM(c, 5); \
  b0 = kread<128>(ka[3]); b1 = kread<8320>(ka[3]); \
  KWAIT(2, a0, a1); QM(a, 6); \
  KWAIT(0, b0, b1); QM(b, 7); } while (0)
__device__ __forceinline__ void qkt(f32x16& p0, f32x16& p1, const int (&ka)[4], const bf16x8* qr, const f32x16& mt) {
  QKT_ISSUE2(); QKT_REST();
}
__device__ __forceinline__ int v_st(int k, int c) { const int kk = (k & ~0xC) | ((k & 4) << 1) | ((k & 8) >> 1); return ((kk >> 3) * 4 + (c >> 5)) * 512 + ((kk & 7) * 32 + (c & 31)) * 2; }
__device__ __forceinline__ int v_rd_base(int lane) { return ((lane & 3) << 3) | (((lane >> 2) & 3) << 6) | (((lane >> 4) & 1) << 5) | (((lane >> 5) & 1) << 8); }
constexpr int v_rd_off(int d0, int ks, int half) { return d0 * 512 + ks * 4096 + half * 2048; }
template <int OFF> __device__ __forceinline__ s16x4 tr_read(int vb) {
  s16x4 r; asm volatile("ds_read_b64_tr_b16 %0, %1 offset:%2" : "=&v"(r) : "v"(vb), "i"(OFF) : "memory"); return r;
}
#define TRSET(S, D0) do { S##0 = tr_read<v_rd_off(D0, 0, 0)>(vb); S##1 = tr_read<v_rd_off(D0, 0, 1)>(vb); S##2 = tr_read<v_rd_off(D0, 1, 0)>(vb); S##3 = tr_read<v_rd_off(D0, 1, 1)>(vb); \
    S##4 = tr_read<v_rd_off(D0, 2, 0)>(vb); S##5 = tr_read<v_rd_off(D0, 2, 1)>(vb); S##6 = tr_read<v_rd_off(D0, 3, 0)>(vb); S##7 = tr_read<v_rd_off(D0, 3, 1)>(vb); } while (0)
#define TWAIT(N, S) asm volatile("s_waitcnt lgkmcnt(" #N ")" : "+v"(S##0), "+v"(S##1), "+v"(S##2), "+v"(S##3), "+v"(S##4), "+v"(S##5), "+v"(S##6), "+v"(S##7) :: "memory")
#define PK(L, H) (bf16x8){L[0], L[1], L[2], L[3], H[0], H[1], H[2], H[3]}
#define PVM(OD, S) do { OD = __builtin_amdgcn_mfma_f32_32x32x16_bf16(pa0, PK(S##0, S##1), OD, 0, 0, 0); OD = __builtin_amdgcn_mfma_f32_32x32x16_bf16(pa1, PK(S##2, S##3), OD, 0, 0, 0); \
    OD = __builtin_amdgcn_mfma_f32_32x32x16_bf16(pa2, PK(S##4, S##5), OD, 0, 0, 0); OD = __builtin_amdgcn_mfma_f32_32x32x16_bf16(pa3, PK(S##6, S##7), OD, 0, 0, 0); } while (0)
struct TrPre { s16x4 a0, a1, a2, a3, a4, a5, a6, a7, b0, b1, b2, b3, b4, b5, b6, b7; };
__device__ __forceinline__ TrPre pv_head(int vb) {
  s16x4 a0, a1, a2, a3, a4, a5, a6, a7, b0, b1, b2, b3, b4, b5, b6, b7;
  TRSET(a, 0); TRSET(b, 1);
  return TrPre{a0, a1, a2, a3, a4, a5, a6, a7, b0, b1, b2, b3, b4, b5, b6, b7};
}
__device__ __forceinline__ void pv_d0(f32x16* o, int vb, bf16x8 pa0, bf16x8 pa1, bf16x8 pa2, bf16x8 pa3, const TrPre& h) {
  s16x4 a0 = h.a0, a1 = h.a1, a2 = h.a2, a3 = h.a3, a4 = h.a4, a5 = h.a5, a6 = h.a6, a7 = h.a7, b0 = h.b0, b1 = h.b1, b2 = h.b2, b3 = h.b3, b4 = h.b4, b5 = h.b5, b6 = h.b6, b7 = h.b7;
  TWAIT(8, a); PVM(o[0], a);
  TRSET(a, 2);
  TWAIT(8, b); PVM(o[1], b);
  TRSET(b, 3);
  TWAIT(8, a); PVM(o[2], a);
  TWAIT(0, b); PVM(o[3], b);
}
__device__ __forceinline__ void mstep(f32x16* o, int vb, bf16x8 pa0, bf16x8 pa1, bf16x8 pa2, bf16x8 pa3, const TrPre& h, f32x16& p0, f32x16& p1, const int (&ka)[4], const bf16x8* qr, const f32x16& mt) {
  s16x4 u0 = h.a0, u1 = h.a1, u2 = h.a2, u3 = h.a3, u4 = h.a4, u5 = h.a5, u6 = h.a6, u7 = h.a7, w0 = h.b0, w1 = h.b1, w2 = h.b2, w3 = h.b3, w4 = h.b4, w5 = h.b5, w6 = h.b6, w7 = h.b7;
#define TDONE(S) asm volatile("" : "+v"(S##0), "+v"(S##1), "+v"(S##2), "+v"(S##3), "+v"(S##4), "+v"(S##5), "+v"(S##6), "+v"(S##7) :: "memory")
  bf16x8 a0 = kread<0>(ka[0]), a1 = kread<8192>(ka[0]);
  bf16x8 b0 = kread<0>(ka[1]), b1 = kread<8192>(ka[1]);
  TWAIT(12, u); PVM(o[0], u);
  TRSET(u, 2);
  KWAIT(10, a0, a1); TDONE(w);
  p0 = __builtin_amdgcn_mfma_f32_32x32x16_bf16(a0, qr[0], mt, 0, 0, 0); p1 = __builtin_amdgcn_mfma_f32_32x32x16_bf16(a1, qr[0], mt, 0, 0, 0);
  bf16x8 c0 = kread<0>(ka[2]), c1 = kread<8192>(ka[2]);
  KWAIT(10, b0, b1); QM(b, 1);
  a0 = kread<0>(ka[3]); a1 = kread<8192>(ka[3]);
  PVM(o[1], w);
  TRSET(w, 3);
  KWAIT(10, c0, c1); TDONE(u);
  QM(c, 2);
  b0 = kread<128>(ka[0]); b1 = kread<8320>(ka[0]);
  KWAIT(10, a0, a1); QM(a, 3);
  c0 = kread<128>(ka[1]); c1 = kread<8320>(ka[1]);
  PVM(o[2], u);
  KWAIT(2, b0, b1); TDONE(w);
  QM(b, 4);
  a0 = kread<128>(ka[2]); a1 = kread<8320>(ka[2]);
  KWAIT(2, c0, c1); QM(c, 5);
  b0 = kread<128>(ka[3]); b1 = kread<8320>(ka[3]);
  PVM(o[3], w);
  KWAIT(2, a0, a1); QM(a, 6);
  KWAIT(0, b0, b1); QM(b, 7);
#undef TDONE
}
#undef TRSET
#undef TWAIT
#undef PK
#undef PVM

__device__ __forceinline__ void attn_dense_body(const bf16* __restrict__ Qb, const bf16* __restrict__ Kh, const bf16* __restrict__ Vh,
                                                bf16* __restrict__ Ob, const float* __restrict__ gain, float* __restrict__ rsa, int seq, char* lds, char* scratch, int wave_id) {
  unsigned z_ = 0u; asm volatile("" : "+v"(z_)); const int lane_ = (int)__builtin_amdgcn_mbcnt_hi(~0u, __builtin_amdgcn_mbcnt_lo(~0u, z_));
    const int wid = wave_id, lane = lane_, tid = wid * 64 + lane, r32 = lane & 31, hi = lane >> 5;
  bf16* V_lds = (bf16*)lds; bf16* K_lds = (bf16*)(lds + 4 * SHM_V);
  float* ws = (float*)scratch + wid * 64; float* li_l = ws; float* al_l = ws + 32;
  float l_reg = 0; f32x16 o[4] = {}; f32x16 mt = {}; bf16x8 qr[8];
  const bf16* Qw = Qb + (long)(wid * QBLK + r32) * LDQ + hi * 8;
#pragma unroll
  for (int d0 = 0; d0 < 8; ++d0) qr[d0] = ld8(Qw + d0 * 16);
  const int vb0 = (int)(uintptr_t)V_lds + v_rd_base(lane);
  int kb4[4];
#pragma unroll
  for (int q = 0; q < 4; ++q) kb4[q] = (int)(uintptr_t)K_lds + r32 * 256 + ((32 * q + 16 * hi) ^ ((r32 & 7) << 4));
#define KADDR(b) do { _Pragma("unroll") for (int q_ = 0; q_ < 4; ++q_) ka[q_] = kb4[q_] + (b) * (int)SHM_K; } while (0)
  int ka[4];
  unsigned gk[2], gv[2];
#pragma unroll
  for (int i = 0; i < 2; ++i) { const int blk = 2 * wid + i, row = blk * 4 + (lane >> 4); gk[i] = (unsigned)(row * 256 + (((lane & 15) ^ (row & 7)) << 4));
    const int st = blk * 2 + (lane >> 5), kk = (st >> 2) * 8 + ((lane >> 2) & 7), key = (kk & ~0xC) | ((kk & 4) << 1) | ((kk & 8) >> 1); gv[i] = (unsigned)(key * 256 + ((st & 3) * 32 + (lane & 3) * 8) * 2); }
  const unsigned ldsV = (unsigned)(uintptr_t)V_lds + (unsigned)wid * 2048u, ldsK = (unsigned)(uintptr_t)K_lds + (unsigned)wid * 2048u;
#define DMA(b, t) do { const char* kg_ = (const char*)Kh + (size_t)(t) * (KVBLK * LDK * 2); const char* vg_ = (const char*)Vh + (size_t)(t) * (KVBLK * LDK * 2); \
    _Pragma("unroll") for (int i_ = 0; i_ < 2; ++i_) { \
      __builtin_amdgcn_global_load_lds((const unsigned*)(kg_ + gk[i_]), (LAS3 unsigned*)(uintptr_t)(ldsK + (unsigned)(b) * (unsigned)SHM_K + i_ * 1024u), 16, 0, 0); \
      __builtin_amdgcn_global_load_lds((const unsigned*)(vg_ + gv[i_]), (LAS3 unsigned*)(uintptr_t)(ldsV + (unsigned)(b) * (unsigned)SHM_V + i_ * 1024u), 16, 0, 0); } } while (0)
#define LANDED() do { asm volatile("s_waitcnt vmcnt(0)" ::: "memory"); __builtin_amdgcn_s_barrier(); asm volatile("" ::: "memory"); } while (0)
#define RESC(a) do { if (__any((a) < 1.f)) { if (hi == 0) al_l[r32] = (a); asm volatile("s_waitcnt lgkmcnt(0)" ::: "memory"); \
    for (int d = 0; d < 4; ++d) for (int r = 0; r < 16; ++r) o[d][r] *= al_l[crow(r, hi)]; } } while (0)
  f32x16 p0, p1; float al; bf16x8 pa0, pa1, pa2, pa3; const int NT = seq / KVBLK;
  DMA(0, 0); DMA(1, 1); DMA(2, 2); DMA(3, 3);
  asm volatile("s_waitcnt vmcnt(12)" ::: "memory"); SBAR(); __builtin_amdgcn_s_barrier(); SBAR();
#define BARP() do { SBAR(); asm volatile("" ::: "memory"); __builtin_amdgcn_s_barrier(); asm volatile("" ::: "memory"); SBAR(); } while (0)
#define BARD(t) do { SBAR(); if ((t) == 0) asm volatile("s_waitcnt vmcnt(8)" ::: "memory"); else if ((t) + 2 < NT) asm volatile("s_waitcnt vmcnt(4)" ::: "memory"); else asm volatile("s_waitcnt vmcnt(0)" ::: "memory"); \
    __builtin_amdgcn_s_barrier(); asm volatile("" ::: "memory"); SBAR(); } while (0)
#define SSTEP(first) do { softmax_step(p0, p1, mt, first, al, l_reg, pa0, pa1, pa2, pa3); RESC(al); } while (0)
  if (wid < 4) {
    KADDR(0); qkt(p0, p1, ka, qr, mt);
    BARP();
    for (int t = 0; t + 1 < NT; ++t) {
      if (t >= 2 && t + 2 < NT) DMA((t + 2) & 3, t + 2);
      SSTEP(t == 0);
      const TrPre h = pv_head(vb0 + (t & 3) * (int)SHM_V);
      BARD(t);
      KADDR((t + 1) & 3); mstep(o, vb0 + (t & 3) * (int)SHM_V, pa0, pa1, pa2, pa3, h, p0, p1, ka, qr, mt);
      BARP();
    }
    SSTEP(false); { const TrPre h = pv_head(vb0 + ((NT - 1) & 3) * (int)SHM_V); BARD(NT - 1);
    pv_d0(o, vb0 + ((NT - 1) & 3) * (int)SHM_V, pa0, pa1, pa2, pa3, h); }
  } else {
    BARP();
    TrPre h = pv_head(vb0);
    for (int t = 0; t < NT; ++t) {
      KADDR(t & 3);
      if (t > 0) mstep(o, vb0 + ((t - 1) & 3) * (int)SHM_V, pa0, pa1, pa2, pa3, h, p0, p1, ka, qr, mt); else qkt(p0, p1, ka, qr, mt);
      BARD(t);
      if (t >= 1 && t + 3 < NT) DMA((t + 3) & 3, t + 3);
      SSTEP(t == 0);
      h = pv_head(vb0 + (t & 3) * (int)SHM_V);
      if (t + 1 < NT) BARP();
    }
    pv_d0(o, vb0 + ((NT - 1) & 3) * (int)SHM_V, pa0, pa1, pa2, pa3, h);
  }
#undef BARP
#undef BARD
#undef SSTEP
  if (hi == 0) li_l[r32] = l_reg; asm volatile("s_waitcnt lgkmcnt(0)" ::: "memory");
  float rli[16];
#pragma unroll
  for (int r = 0; r < 16; ++r) rli[r] = __builtin_amdgcn_rcpf(li_l[crow(r, hi)]);
  bf16* Ow = Ob + (long)(wid * QBLK) * LDO; float* rw = rsa + wid * QBLK * 8;
  float gq[4];
#pragma unroll
  for (int d0 = 0; d0 < 4; ++d0) gq[d0] = gain[d0 * 32 + r32];
  const bool odd = (lane & 1) != 0; float srow = 0.f;
#pragma unroll
  for (int r = 0; r < 16; r += 2) { float ss0 = 0.f, ss1 = 0.f;
#pragma unroll
    for (int d0 = 0; d0 < 4; ++d0) { const float v0 = o[d0][r] * rli[r], v1 = o[d0][r + 1] * rli[r + 1]; ss0 += v0 * v0; ss1 += v1 * v1;
      const float g0 = v0 * gq[d0], g1 = v1 * gq[d0]; const float recv = __shfl_xor(odd ? g0 : g1, 1);
      const unsigned w = odd ? cvtpk(recv, g1) : cvtpk(g0, recv);
      *(unsigned*)(Ow + (long)crow(odd ? r + 1 : r, hi) * LDO + d0 * 32 + (r32 & ~1)) = w; }
#pragma unroll
    for (int sft = 1; sft < 32; sft <<= 1) { ss0 += __shfl_xor(ss0, sft); ss1 += __shfl_xor(ss1, sft); }
    srow = (r32 == r) ? ss0 : srow; srow = (r32 == r + 1) ? ss1 : srow; }
  if (r32 < 16) rw[crow(r32, hi) * 8] = srow;
#undef DMA
#undef LANDED
#undef RESC
#undef KADDR
}
#undef KSWZ
#undef SBAR
}

constexpr int NWAVES = 8;
constexpr int DM = 2048, NB = 4, SEQ = 4096, CTX = 256, NL = 4;
constexpr int HD = 128, NH = 8, NKV = 2, AW = 1024, KVW = 256, CW = 1024, INW = 4608, FF = 8192;
constexpr int ML = NB * SEQ, MC = NB * CTX, MT = ML + MC;
constexpr int SKV = SEQ + CTX;
constexpr int MODW = 6 * DM;
constexpr float EPS = 1e-6f;
constexpr int C_Q = 0, C_K = 1024, C_V = 1280, C_GB = 1536, C_GC = 2560, C_U = 3584, C_Z = 2560;

constexpr size_t MiB = 1u << 20;
constexpr size_t WS_CTL = 0, CTL_ZERO_BYTES = 64 * 1024;
constexpr size_t WS_MOD = 1 * MiB;
constexpr size_t WS_XC = 2 * MiB;
constexpr size_t WS_W = 16 * MiB;
constexpr size_t W_IN_E = (size_t)INW * DM, W_OUT_E = (size_t)DM * DM, W_1_E = (size_t)FF * DM, W_2_E = (size_t)DM * FF, W_LAYER_E = W_IN_E + W_OUT_E + W_1_E + W_2_E;
constexpr size_t WS_H = WS_W + NL * W_LAYER_E * 2 + 8 * MiB;
constexpr size_t WS_BIG = WS_H + (size_t)MT * DM * 2 + 4 * MiB;
constexpr size_t BIG_QKV = 0, BIG_Q = 156 * MiB, BIG_K = 192 * MiB, BIG_V = 202 * MiB;
constexpr size_t WS_MRG = WS_BIG + (size_t)MT * FF * 2 + 4 * MiB;
constexpr size_t WS_AO = WS_MRG + (size_t)MT * DM * 2 + 4 * MiB;
constexpr size_t WS_PART = WS_AO + (size_t)MT * AW * 4 + 4 * MiB;
constexpr size_t WS_END = WS_PART + (size_t)8 * MC * DM * 4 + 4 * MiB;
static_assert((size_t)MT * INW * 2 <= BIG_Q && BIG_Q + (size_t)MT * AW * 2 <= BIG_K && BIG_K + (size_t)NB * NKV * SKV * HD * 2 <= BIG_V && BIG_V + (size_t)NB * NKV * SKV * HD * 2 <= (size_t)MT * FF * 2, "overlay map");
static_assert((size_t)NL * 5 * MODW * 4 <= 1 * MiB && WS_XC + (size_t)MC * DM * 4 <= WS_W, "small map");
constexpr int CW_BAR = 4096;
constexpr size_t WS_RSA = 11 * MiB;
static_assert(WS_RSA >= WS_XC + (size_t)MC * DM * 4 && WS_RSA + (size_t)MT * 8 * 4 <= WS_W && (CW_BAR + 3456) * 4 <= (int)CTL_ZERO_BYTES, "CTL / RSA map");

constexpr int RING_OFF = 0, RING_BYTES = 131072;
constexpr int ROPE_OFF = RING_BYTES;
constexpr int MISC_OFF = ROPE_OFF + 16384;
constexpr int STASH_OFF = MISC_OFF + 256;
constexpr int LDS_BYTES = STASH_OFF + NWAVES * 64 * 16;

#define GAS __attribute__((address_space(1)))
#define LAS __attribute__((address_space(3)))
typedef unsigned short bf16;
typedef unsigned v4u __attribute__((ext_vector_type(4)));
typedef unsigned v2u __attribute__((ext_vector_type(2)));
typedef float f32x4 __attribute__((ext_vector_type(4)));
typedef float f32x2 __attribute__((ext_vector_type(2)));
#define LDS_WAIT() asm volatile("s_waitcnt lgkmcnt(0)" ::: "memory")
__device__ __forceinline__ unsigned pk2(float lo, float hi) { unsigned r; asm volatile("v_cvt_pk_bf16_f32 %0, %1, %2" : "=v"(r) : "v"(lo), "v"(hi)); return r; }
__device__ __forceinline__ float bflo(unsigned w) { return __builtin_bit_cast(float, w << 16); }
__device__ __forceinline__ float bfhi(unsigned w) { return __builtin_bit_cast(float, w & 0xffff0000u); }
__device__ __forceinline__ float wave_sum(float v) {
#pragma unroll
    for (int o = 1; o < 64; o <<= 1) v += __shfl_xor(v, o);
    return v;
}
__device__ __forceinline__ void ld16(const bf16* p, float (&x)[16]) {
    const v4u a = *(const v4u*)p, b = *(const v4u*)(p + 8);
    x[0] = bflo(a.x); x[1] = bfhi(a.x); x[2] = bflo(a.y); x[3] = bfhi(a.y); x[4] = bflo(a.z); x[5] = bfhi(a.z); x[6] = bflo(a.w); x[7] = bfhi(a.w);
    x[8] = bflo(b.x); x[9] = bfhi(b.x); x[10] = bflo(b.y); x[11] = bfhi(b.y); x[12] = bflo(b.z); x[13] = bfhi(b.z); x[14] = bflo(b.w); x[15] = bfhi(b.w);
}
struct Raw16 { v4u a, b; };
__device__ __forceinline__ Raw16 ldraw16(const bf16* p) { Raw16 r; r.a = *(const v4u*)p; r.b = *(const v4u*)(p + 8); return r; }
__device__ __forceinline__ void unpack16(const Raw16& r, float (&x)[16]) {
    x[0] = bflo(r.a.x); x[1] = bfhi(r.a.x); x[2] = bflo(r.a.y); x[3] = bfhi(r.a.y); x[4] = bflo(r.a.z); x[5] = bfhi(r.a.z); x[6] = bflo(r.a.w); x[7] = bfhi(r.a.w);
    x[8] = bflo(r.b.x); x[9] = bfhi(r.b.x); x[10] = bflo(r.b.y); x[11] = bfhi(r.b.y); x[12] = bflo(r.b.z); x[13] = bfhi(r.b.z); x[14] = bflo(r.b.w); x[15] = bfhi(r.b.w);
}
__device__ __forceinline__ void st16(bf16* p, const float (&x)[16]) {
    v4u a, b; a.x = pk2(x[0], x[1]); a.y = pk2(x[2], x[3]); a.z = pk2(x[4], x[5]); a.w = pk2(x[6], x[7]);
    b.x = pk2(x[8], x[9]); b.y = pk2(x[10], x[11]); b.z = pk2(x[12], x[13]); b.w = pk2(x[14], x[15]);
    *(v4u*)p = a; *(v4u*)(p + 8) = b;
}
__device__ __forceinline__ void ld16f(const float* p, float (&x)[16]) {
#pragma unroll
    for (int i = 0; i < 4; ++i) { const f32x4 v = *(const f32x4*)(p + 4 * i); x[4 * i] = v.x; x[4 * i + 1] = v.y; x[4 * i + 2] = v.z; x[4 * i + 3] = v.w; }
}
#define XB_TMO      128
#define XB_XCNT(j)  (256  + 64 * (j))
#define XB_XSUB(j)  (1280 + 64 * (j))
#define XB_XGEN(j)  (2304 + 64 * (j))
#define XB_TOP      3328
#define XB_TOPGEN   3392
#define XCD_BAR_WORDS 3456
#define XB_SPIN_CAP (1u << 18)

__device__ __forceinline__ unsigned xb_ld(unsigned* p)              { return __hip_atomic_load(p, __ATOMIC_RELAXED, __HIP_MEMORY_SCOPE_AGENT); }
__device__ __forceinline__ unsigned xb_add(unsigned* p, unsigned v) { return __hip_atomic_fetch_add(p, v, __ATOMIC_RELAXED, __HIP_MEMORY_SCOPE_AGENT); }
__device__ __forceinline__ unsigned xb_xcc_id() { return (unsigned)__builtin_amdgcn_s_getreg((3 << 11) | 20) & 0xFu; }
#define XB_SPIN(cond, bar) do { unsigned _sp = 0; while (cond) { __builtin_amdgcn_s_sleep(1); \
    if ((++_sp & 255u) == 0u) { if (xb_ld(&(bar)[XB_TMO])) break; if (_sp > XB_SPIN_CAP) { atomicAdd(&(bar)[XB_TMO], 1u); break; } } } } while (0)

struct XcdBarrier {
    unsigned* bar; unsigned x;
    volatile LAS unsigned* st;
};

__device__ __forceinline__ XcdBarrier xcd_barrier_post(unsigned* bar, volatile LAS unsigned* st, bool leader) {
    XcdBarrier b; b.bar = bar; b.x = xb_xcc_id(); b.st = st;
    if (leader) (void)xb_add(&bar[XB_XCNT(b.x)], 1u);
    return b;
}
__device__ __forceinline__ void xcd_barrier_complete(unsigned* bar, unsigned x, unsigned& nloc, unsigned& nx) {
    const unsigned G = gridDim.x * gridDim.y * gridDim.z;
    unsigned sum, cnt, mine, sp = 0u;
    for (;;) {
        sum = 0u; cnt = 0u; mine = 0u;
#pragma unroll
        for (unsigned j = 0; j < 16; ++j) { const unsigned c = xb_ld(&bar[XB_XCNT(j)]); sum += c; cnt += (c > 0u) ? 1u : 0u; mine = (j == x) ? c : mine; }
        if (sum == G) break;
        __builtin_amdgcn_s_sleep(1);
        if ((++sp & 255u) == 0u) { if (xb_ld(&bar[XB_TMO])) break; if (sp > XB_SPIN_CAP) { atomicAdd(&bar[XB_TMO], 1u); break; } }
    }
    nloc = mine > 0u ? mine : 1u; nx = cnt > 0u ? cnt : 1u;
}

__device__ __forceinline__ void xcd_barrier(const XcdBarrier& b, bool leader) {
    asm volatile("s_waitcnt vmcnt(0)" ::: "memory");
    __syncthreads();
    if (leader) {
        unsigned* bar = b.bar;
        __builtin_amdgcn_s_waitcnt(0);
        unsigned nloc = b.st[0], nx = b.st[1];
        if (nloc == 0u) { xcd_barrier_complete(bar, b.x, nloc, nx); b.st[0] = nloc; b.st[1] = nx; }
        const unsigned old = xb_add(&bar[XB_XSUB(b.x)], 1u);
        const unsigned gen = old / nloc;
        if (old + 1u == (gen + 1u) * nloc) {
            __builtin_amdgcn_fence(__ATOMIC_RELEASE, "agent");
            asm volatile("s_waitcnt vmcnt(0)" ::: "memory");
            const unsigned og = xb_add(&bar[XB_TOP], 1u);
            const unsigned tg = og / nx;
            if (og + 1u == (tg + 1u) * nx) xb_add(&bar[XB_TOPGEN], 1u);
            else XB_SPIN(xb_ld(&bar[XB_TOPGEN]) == tg, bar);
            __builtin_amdgcn_fence(__ATOMIC_ACQUIRE, "agent");
            xb_add(&bar[XB_XGEN(b.x)], 1u);
            asm volatile("s_waitcnt vmcnt(0)" ::: "memory");
        } else {
            XB_SPIN(xb_ld(&bar[XB_XGEN(b.x)]) == gen, bar);
            __builtin_amdgcn_fence(__ATOMIC_ACQUIRE, "agent");
            asm volatile("s_waitcnt vmcnt(0)" ::: "memory");
        }
    }
    __syncthreads();
}


__device__ __forceinline__ void p0_transpose_item(const float* W, int K, int N, bf16* WT, LAS float* scr, int item, int lane, bool zperm = false) {
    const int nblk = N / 32, kb = item / nblk, nb = item % nblk, k0 = 64 * kb, n0 = 32 * nb;
    int nd0 = n0; if (zperm && n0 >= C_GC) { const int isu = n0 >= C_U, g = n0 - (isu ? C_U : C_GC); nd0 = C_GC + 256 * (g >> 7) + 64 * ((g >> 5) & 3) + 32 * isu + (g & 31); }
    {
        f32x4 t[8]; const int rr = lane >> 3, c4 = 4 * (lane & 7);
#pragma unroll
        for (int i = 0; i < 8; ++i) t[i] = *(const f32x4*)(W + (size_t)(k0 + rr + 8 * i) * N + n0 + c4);
        asm volatile("" ::: "memory");
#pragma unroll
        for (int i = 0; i < 8; ++i) { LAS float* d = scr + (rr + 8 * i) * 33 + c4; d[0] = t[i].x; d[1] = t[i].y; d[2] = t[i].z; d[3] = t[i].w; }
    }
    LDS_WAIT(); asm volatile("" ::: "memory");
    const int c = lane & 7;
#pragma unroll
    for (int j = 0; j < 4; ++j) { const int n = (lane >> 3) + 8 * j; const LAS float* s = scr + (8 * c) * 33 + n;
        v4u o; o.x = pk2(s[0 * 33], s[1 * 33]); o.y = pk2(s[2 * 33], s[3 * 33]); o.z = pk2(s[4 * 33], s[5 * 33]); o.w = pk2(s[6 * 33], s[7 * 33]);
        *(GAS v4u*)(WT + (size_t)(nd0 + n) * K + k0 + 8 * c) = o; }
    LDS_WAIT(); asm volatile("" ::: "memory");
}

__device__ __forceinline__ void adaln_item(const float* __restrict__ w_ada, const float* __restrict__ b_ada, float* __restrict__ mod, LAS float* sil, LAS float* red, int item, int tid, int wave, int lane) {
    const int l = item / 192, n0 = (item % 192) * 64, g = lane >> 4, c4 = lane & 15;
    const float* wp = w_ada + ((size_t)l * DM + wave * 256 + g) * MODW + n0 + 4 * c4;
    f32x4 acc[5];
#pragma unroll
    for (int r = 0; r < 5; ++r) acc[r] = (f32x4){0.f, 0.f, 0.f, 0.f};
    const LAS float* sp = sil + wave * 256 + g;
#pragma unroll 1
    for (int i0 = 0; i0 < 64; i0 += 8) {
        const float* wq = wp + (size_t)(4 * i0) * MODW;
        f32x4 wv[8];
#pragma unroll
        for (int i = 0; i < 8; ++i) wv[i] = *(const f32x4*)(wq + (size_t)(4 * i) * MODW);
        asm volatile("" ::: "memory");
#pragma unroll
        for (int i = 0; i < 8; ++i)
#pragma unroll
            for (int r = 0; r < 5; ++r) { const float s = sp[r * DM + 4 * (i0 + i)]; acc[r] = acc[r] + wv[i] * s; }
    }
#pragma unroll
    for (int r = 0; r < 5; ++r)
#pragma unroll
        for (int e = 0; e < 4; ++e) { float v = acc[r][e]; v += __shfl_xor(v, 16); v += __shfl_xor(v, 32); acc[r][e] = v; }
    if (g == 0) {
#pragma unroll
        for (int r = 0; r < 5; ++r) *(LAS f32x4*)(red + (wave * 5 + r) * 64 + 4 * c4) = acc[r];
    }
    __syncthreads();
    if (tid < 320) { const int r = tid >> 6, cc = tid & 63; float s = b_ada[(size_t)l * MODW + n0 + cc];
#pragma unroll
        for (int w = 0; w < 8; ++w) s += red[(w * 5 + r) * 64 + cc];
        mod[((size_t)l * 5 + r) * MODW + n0 + cc] = s; }
    __syncthreads();
}

__device__ __forceinline__ void norm_mod_rows(const float* __restrict__ x, bf16* __restrict__ out, int nrows, const float* __restrict__ gain, const float* __restrict__ sh, const float* __restrict__ sc, int lane) {
    asm volatile("" : "+v"(lane));
    f32x4 a[8], bb[8];
    {
        f32x4 sv[8];
#pragma unroll
        for (int j = 0; j < 8; ++j) { a[j] = *(const f32x4*)(gain + 4 * lane + 256 * j); sv[j] = *(const f32x4*)(sc + 4 * lane + 256 * j); bb[j] = *(const f32x4*)(sh + 4 * lane + 256 * j); }
        asm volatile("" ::: "memory");
#pragma unroll
        for (int j = 0; j < 8; ++j) a[j] = a[j] * (sv[j] + 1.0f);
    }
    int i = 0;
    for (; i + 1 < nrows; i += 2) {
        const f32x4* xr0 = (const f32x4*)(x + (size_t)i * DM) + lane; const f32x4* xr1 = xr0 + DM / 4;
        f32x4 v0[8], v1[8]; float s0 = 0.f, s1 = 0.f;
#pragma unroll
        for (int j = 0; j < 8; ++j) { v0[j] = xr0[64 * j]; v1[j] = xr1[64 * j]; }
#pragma unroll
        for (int j = 0; j < 8; ++j) { s0 += (v0[j].x * v0[j].x + v0[j].y * v0[j].y) + (v0[j].z * v0[j].z + v0[j].w * v0[j].w); s1 += (v1[j].x * v1[j].x + v1[j].y * v1[j].y) + (v1[j].z * v1[j].z + v1[j].w * v1[j].w); }
        const float r0 = 1.0f / sqrtf(wave_sum(s0) * (1.f / DM) + EPS), r1 = 1.0f / sqrtf(wave_sum(s1) * (1.f / DM) + EPS);
        v2u* o0 = (v2u*)(out + (size_t)i * DM) + lane; v2u* o1 = o0 + DM / 4;
#pragma unroll
        for (int j = 0; j < 8; ++j) { const f32x4 y0 = v0[j] * r0 * a[j] + bb[j], y1 = v1[j] * r1 * a[j] + bb[j]; v2u w0, w1; w0.x = pk2(y0.x, y0.y); w0.y = pk2(y0.z, y0.w); w1.x = pk2(y1.x, y1.y); w1.y = pk2(y1.z, y1.w); o0[64 * j] = w0; o1[64 * j] = w1; }
    }
    for (; i < nrows; ++i) {
        const f32x4* xr = (const f32x4*)(x + (size_t)i * DM) + lane;
        f32x4 v[8]; float ss = 0.f;
#pragma unroll
        for (int j = 0; j < 8; ++j) { v[j] = xr[64 * j]; ss += (v[j].x * v[j].x + v[j].y * v[j].y) + (v[j].z * v[j].z + v[j].w * v[j].w); }
        const float rstd = 1.0f / sqrtf(wave_sum(ss) * (1.f / DM) + EPS);
        v2u* o8 = (v2u*)(out + (size_t)i * DM) + lane;
#pragma unroll
        for (int j = 0; j < 8; ++j) { const f32x4 y = v[j] * rstd * a[j] + bb[j]; v2u w; w.x = pk2(y.x, y.y); w.y = pk2(y.z, y.w); o8[64 * j] = w; }
    }
}
__device__ __forceinline__ void norm_mod_rows_b(const bf16* __restrict__ x, bf16* __restrict__ out, int nrows, const float* __restrict__ gain, const float* __restrict__ sh, const float* __restrict__ sc, int lane) {
    asm volatile("" : "+v"(lane));
    f32x4 a[4][2], bb[4][2];
    {
        f32x4 sv[4][2];
#pragma unroll
        for (int j = 0; j < 4; ++j)
#pragma unroll
            for (int h = 0; h < 2; ++h) { const int e = 8 * lane + 512 * j + 4 * h; a[j][h] = *(const f32x4*)(gain + e); sv[j][h] = *(const f32x4*)(sc + e); bb[j][h] = *(const f32x4*)(sh + e); }
        asm volatile("" ::: "memory");
#pragma unroll
        for (int j = 0; j < 4; ++j)
#pragma unroll
            for (int h = 0; h < 2; ++h) a[j][h] = a[j][h] * (sv[j][h] + 1.0f);
    }
    for (int i = 0; i < nrows; i += 4) {
        v4u raw[4][4]; float ss[4];
#pragma unroll
        for (int r = 0; r < 4; ++r)
#pragma unroll
            for (int j = 0; j < 4; ++j) raw[r][j] = *(const v4u*)(x + (size_t)(i + r) * DM + 8 * lane + 512 * j);
        asm volatile("" ::: "memory");
#pragma unroll
        for (int r = 0; r < 4; ++r) { float s = 0.f;
#pragma unroll
            for (int j = 0; j < 4; ++j) { const v4u w = raw[r][j];
                const float x0 = bflo(w.x), x1 = bfhi(w.x), x2 = bflo(w.y), x3 = bfhi(w.y), x4 = bflo(w.z), x5 = bfhi(w.z), x6 = bflo(w.w), x7 = bfhi(w.w);
                s += ((x0 * x0 + x1 * x1) + (x2 * x2 + x3 * x3)) + ((x4 * x4 + x5 * x5) + (x6 * x6 + x7 * x7)); }
            ss[r] = s; }
#pragma unroll
        for (int r = 0; r < 4; ++r) ss[r] = 1.0f / sqrtf(wave_sum(ss[r]) * (1.f / DM) + EPS);
#pragma unroll
        for (int r = 0; r < 4; ++r)
#pragma unroll
            for (int j = 0; j < 4; ++j) { const v4u w = raw[r][j];
                f32x4 x0, x1; x0.x = bflo(w.x); x0.y = bfhi(w.x); x0.z = bflo(w.y); x0.w = bfhi(w.y); x1.x = bflo(w.z); x1.y = bfhi(w.z); x1.z = bflo(w.w); x1.w = bfhi(w.w);
                const f32x4 y0 = x0 * ss[r] * a[j][0] + bb[j][0], y1 = x1 * ss[r] * a[j][1] + bb[j][1];
                v4u o; o.x = pk2(y0.x, y0.y); o.y = pk2(y0.z, y0.w); o.z = pk2(y1.x, y1.y); o.w = pk2(y1.z, y1.w);
                *(v4u*)(out + (size_t)(i + r) * DM + 8 * lane + 512 * j) = o; }
    }
}
__device__ __forceinline__ void ctx_fix_norm_row(const float* __restrict__ xin, const bf16* __restrict__ part, const float* __restrict__ gate, const float* __restrict__ rsa_row, float* __restrict__ xout, bf16* __restrict__ out,
                                                 const float* __restrict__ gain, const float* __restrict__ sh, const float* __restrict__ sc, int lane) {
    asm volatile("" : "+v"(lane));
    f32x4 v[4][2]; float ss = 0.f; float ra = 1.0f;
    if (rsa_row) { const f32x4 q0 = *(const f32x4*)rsa_row, q1 = *(const f32x4*)(rsa_row + 4); ra = 1.0f / sqrtf((((q0.x + q0.y) + (q0.z + q0.w)) + ((q1.x + q1.y) + (q1.z + q1.w))) * (1.f / AW) + EPS); }
    if (part) {
#pragma unroll
        for (int j0 = 0; j0 < 4; j0 += 2) {
            v4u pp[2][8];
#pragma unroll
            for (int jj = 0; jj < 2; ++jj) { const int e = 8 * lane + 512 * (j0 + jj); v[j0 + jj][0] = *(const f32x4*)(xin + e); v[j0 + jj][1] = *(const f32x4*)(xin + e + 4);
#pragma unroll
                for (int ks = 0; ks < 8; ++ks) pp[jj][ks] = *(const v4u*)(part + (size_t)ks * MC * DM + e); }
            asm volatile("" ::: "memory");
#pragma unroll
            for (int jj = 0; jj < 2; ++jj) { const int j = j0 + jj, e = 8 * lane + 512 * j;
                f32x4 q[8][2];
#pragma unroll
                for (int ks = 0; ks < 8; ++ks) { const v4u w = pp[jj][ks]; q[ks][0].x = bflo(w.x); q[ks][0].y = bfhi(w.x); q[ks][0].z = bflo(w.y); q[ks][0].w = bfhi(w.y); q[ks][1].x = bflo(w.z); q[ks][1].y = bfhi(w.z); q[ks][1].z = bflo(w.w); q[ks][1].w = bfhi(w.w); }
#pragma unroll
                for (int h = 0; h < 2; ++h) {
                    const f32x4 pa = (q[0][h] + q[1][h]) + (q[2][h] + q[3][h]), pc = (q[4][h] + q[5][h]) + (q[6][h] + q[7][h]);
                    v[j][h] = v[j][h] + *(const f32x4*)(gate + e + 4 * h) * (pa * ra + pc);
                    *(f32x4*)(xout + e + 4 * h) = v[j][h]; } }
            asm volatile("" ::: "memory");
        }
    } else {
#pragma unroll
        for (int j = 0; j < 4; ++j) { const int e = 8 * lane + 512 * j; v[j][0] = *(const f32x4*)(xin + e); v[j][1] = *(const f32x4*)(xin + e + 4); }
    }
#pragma unroll
    for (int j = 0; j < 4; ++j)
#pragma unroll
        for (int h = 0; h < 2; ++h) ss += (v[j][h].x * v[j][h].x + v[j][h].y * v[j][h].y) + (v[j][h].z * v[j][h].z + v[j][h].w * v[j][h].w);
    const float rstd = 1.0f / sqrtf(wave_sum(ss) * (1.f / DM) + EPS);
#pragma unroll
    for (int j = 0; j < 4; ++j) { const int e = 8 * lane + 512 * j; f32x4 y[2];
#pragma unroll
        for (int h = 0; h < 2; ++h) { const f32x4 g = *(const f32x4*)(gain + e + 4 * h), sv = *(const f32x4*)(sc + e + 4 * h), b = *(const f32x4*)(sh + e + 4 * h); y[h] = v[j][h] * rstd * (g * (sv + 1.0f)) + b; }
        v4u w; w.x = pk2(y[0].x, y[0].y); w.y = pk2(y[0].z, y[0].w); w.z = pk2(y[1].x, y[1].y); w.w = pk2(y[1].z, y[1].w);
        *(v4u*)(out + e) = w; }
}
__device__ __forceinline__ void norm_mod_phase(const float* xlat, const bf16* xlat_b, const float* xctx, float* xcout, const bf16* part, const float* cgate, const float* rsa_ctx, bool do_ctx, bf16* H, const float* gain, const float* modl, int shc, int scc, int bid, int G, int wave, int lane) {
    for (int c = bid; c < 256; c += G) {
        { const int r = c >> 6, row0 = 64 * c + 8 * wave;
          if (xlat_b) norm_mod_rows_b(xlat_b + (size_t)row0 * DM, H + (size_t)row0 * DM, 8, gain, modl + (size_t)r * MODW + shc * DM, modl + (size_t)r * MODW + scc * DM, lane);
          else norm_mod_rows(xlat + (size_t)row0 * DM, H + (size_t)row0 * DM, 8, gain, modl + (size_t)r * MODW + shc * DM, modl + (size_t)r * MODW + scc * DM, lane); }
        if (wave < 4 && do_ctx) { const int row = 4 * c + wave;
          ctx_fix_norm_row(xctx + (size_t)row * DM, part ? part + (size_t)row * DM : nullptr, cgate, rsa_ctx ? rsa_ctx + (size_t)row * 8 : nullptr, xcout + (size_t)row * DM, H + (size_t)(ML + row) * DM, gain, modl + (size_t)4 * MODW + shc * DM, modl + (size_t)4 * MODW + scc * DM, lane); }
    }
}

__device__ __forceinline__ void token_rows(const bf16* __restrict__ QKV, bf16* __restrict__ Ql, bf16* __restrict__ Qc, bf16* __restrict__ Kb, bf16* __restrict__ Vb, bf16* __restrict__ MRG,
                                           const float* __restrict__ qg_, const float* __restrict__ kg_, const float* __restrict__ cw, const float* __restrict__ cb, const float* __restrict__ cg_,
                                           const LAS f32x2* rope, int b, int t0, int n, bool latent, int lane) {
    const int seq_len = latent ? SEQ : CTX, rbase = latent ? b * SEQ : ML + b * CTX;
    const int j = lane & 7, h = lane >> 3;
    {
        float qg[16], kg[16];
        ld16f(qg_ + 16 * j, qg); ld16f(kg_ + 16 * j, kg);
#pragma unroll
        for (int e = 0; e < 16; ++e) qg[e] *= 0.12751743074602132f;
        const int l5 = lane & 31, isv = l5 >> 4, kvh = (l5 >> 3) & 1;
        const float sgn = (j & 2) ? 1.f : -1.f;
        const int qoff = C_Q + 128 * h + 16 * j, koff = C_K + 128 * kvh + 16 * j;
        Raw16 rq = ldraw16(QKV + (size_t)(rbase + t0) * INW + qoff), rk = ldraw16(QKV + (size_t)(rbase + t0) * INW + koff);
        for (int i = 0; i < n; ++i) {
            const int t = t0 + i;
            const Raw16 cq = rq, ck = rk;
            if (i + 1 < n) { const bf16* nsrc = QKV + (size_t)(rbase + t + 1) * INW; rq = ldraw16(nsrc + qoff); rk = ldraw16(nsrc + koff); }
            float cs[16], sn[16];
            if (latent) { const int pos = (j & 4) ? (t & 63) : (t >> 6); const LAS f32x2* tp = rope + pos * 32 + 16 * (j & 1);
#pragma unroll
                for (int e = 0; e < 16; ++e) { const f32x2 v = tp[e]; cs[e] = v.x; sn[e] = v.y; } }
            else {
#pragma unroll
                for (int e = 0; e < 16; ++e) { cs[e] = 1.f; sn[e] = 0.f; } }
            {
                float x[16]; unpack16(cq, x);
                float ss = 0.f;
#pragma unroll
                for (int e = 0; e < 16; ++e) ss += x[e] * x[e];
                ss += __shfl_xor(ss, 1); ss += __shfl_xor(ss, 2); ss += __shfl_xor(ss, 4);
                const float rstd = 1.0f / sqrtf(ss * (1.f / HD) + EPS);
#pragma unroll
                for (int e = 0; e < 16; ++e) x[e] = x[e] * rstd * qg[e];
                float y[16];
#pragma unroll
                for (int e = 0; e < 16; ++e) { const float p = __shfl_xor(x[e], 2); y[e] = x[e] * cs[e] + sgn * p * sn[e]; }
                bf16* dst = latent ? Ql + ((size_t)(b * NH + h) * SEQ + t) * HD + 16 * j : Qc + ((size_t)(b * NH + h) * CTX + t) * HD + 16 * j;
                st16(dst, y);
            }
            {
                float x[16]; unpack16(ck, x);
                float ss = 0.f;
#pragma unroll
                for (int e = 0; e < 16; ++e) ss += x[e] * x[e];
                ss += __shfl_xor(ss, 1); ss += __shfl_xor(ss, 2); ss += __shfl_xor(ss, 4);
                const float rstd = 1.0f / sqrtf(ss * (1.f / HD) + EPS);
                float y[16];
#pragma unroll
                for (int e = 0; e < 16; ++e) { const float xn = x[e] * rstd * kg[e]; const float p = __shfl_xor(xn, 2); const float kr = xn * cs[e] + sgn * p * sn[e]; y[e] = isv ? x[e] : kr; }
                const int pos = latent ? t : SEQ + t;
                bf16* dst = (isv ? Vb : Kb) + ((size_t)(b * NKV + kvh) * SKV + pos) * HD + 16 * j;
                if (lane < 16) st16(dst, y);
            }
        }
    }
    {
        const int ch = 16 * lane;
        float w0[16], w1[16], w2[16], bs[16], cg[16];
        ld16f(cw + ch, w0); ld16f(cw + CW + ch, w1); ld16f(cw + 2 * CW + ch, w2); ld16f(cb + ch, bs); ld16f(cg_ + ch, cg);
        float zp[16], zc[16], zn[16];
#define LOADZ(dst, tt) do { ld16(QKV + (size_t)(rbase + (tt)) * INW + C_Z + ch, dst); } while (0)
#define ZEROZ(dst) do { _Pragma("unroll") for (int e = 0; e < 16; ++e) dst[e] = 0.f; } while (0)
        if (t0 > 0) LOADZ(zp, t0 - 1); else ZEROZ(zp);
        LOADZ(zc, t0);
        const bf16* row0 = QKV + (size_t)(rbase + t0) * INW;
        Raw16 rgb = ldraw16(row0 + C_GB + ch), rz = rgb;
        if (t0 + 1 < seq_len) rz = ldraw16(row0 + INW + C_Z + ch);
        for (int i = 0; i < n; ++i) {
            const int t = t0 + i;
            const Raw16 cgb = rgb, cz = rz;
            if (i + 1 < n) { const bf16* nrow = QKV + (size_t)(rbase + t + 1) * INW; rgb = ldraw16(nrow + C_GB + ch);
                if (t + 2 < seq_len) rz = ldraw16(nrow + INW + C_Z + ch); }
            if (t + 1 < seq_len) unpack16(cz, zn);
            else ZEROZ(zn);
            float gb[16]; unpack16(cgb, gb);
            float y[16]; float ss = 0.f;
#pragma unroll
            for (int e = 0; e < 16; ++e) { const float cv = zp[e] * w0[e] + zc[e] * w1[e] + zn[e] * w2[e] + bs[e]; y[e] = gb[e] * cv; ss += y[e] * y[e]; }
            const float rstd = 1.0f / sqrtf(wave_sum(ss) * (1.f / CW) + EPS);
#pragma unroll
            for (int e = 0; e < 16; ++e) y[e] = y[e] * rstd * cg[e];
            st16(MRG + (size_t)(rbase + t) * DM + AW + ch, y);
#pragma unroll
            for (int e = 0; e < 16; ++e) { zp[e] = zc[e]; zc[e] = zn[e]; }
        }
#undef LOADZ
#undef ZEROZ
    }
}

__device__ __forceinline__ void attn_norm_rows(const float* __restrict__ ao, bf16* __restrict__ mrg, int nrows, const float* __restrict__ ag_, int lane) {
    f32x4 ag[4];
#pragma unroll
    for (int j = 0; j < 4; ++j) ag[j] = *(const f32x4*)(ag_ + 4 * lane + 256 * j);
    for (int i = 0; i < nrows; ++i) {
        const f32x4* xr = (const f32x4*)(ao + (size_t)i * AW) + lane;
        f32x4 v[4]; float ss = 0.f;
#pragma unroll
        for (int j = 0; j < 4; ++j) { v[j] = xr[64 * j]; ss += (v[j].x * v[j].x + v[j].y * v[j].y) + (v[j].z * v[j].z + v[j].w * v[j].w); }
        const float rstd = 1.0f / sqrtf(wave_sum(ss) * (1.f / AW) + EPS);
        v2u* o8 = (v2u*)(mrg + (size_t)i * DM) + lane;
#pragma unroll
        for (int j = 0; j < 4; ++j) { const f32x4 y = v[j] * rstd * ag[j]; v2u w; w.x = pk2(y.x, y.y); w.y = pk2(y.z, y.w); o8[64 * j] = w; }
    }
}

struct Args { const float* in[18]; float* out; unsigned char* ws; };
typedef const __attribute__((address_space(4))) Args* KArgs;
__device__ __forceinline__ int lane_id() { unsigned z = 0u; asm volatile("" : "+v"(z)); return (int)__builtin_amdgcn_mbcnt_hi(~0u, __builtin_amdgcn_mbcnt_lo(~0u, z)); }
__device__ __forceinline__ KArgs fresh_args() { KArgs p = (KArgs)__builtin_amdgcn_kernarg_segment_ptr(); asm volatile("" : "+s"(p)); return p; }
__device__ __forceinline__ int fresh_int(int v) { asm volatile("" : "+s"(v)); return v; }
#define BID() fresh_int((int)blockIdx.x)

struct Ptrs {
    const float *x_in, *c_in, *ctx_in, *cctx_in, *w_ada, *b_ada, *norm1_g, *w_in, *q_norm_g, *k_norm_g, *conv_w, *conv_b, *attn_out_g, *conv_out_g, *w_out, *norm2_g, *w_mlp_in, *w_mlp_out;
    float* out; float* MOD; float* XC; bf16* WT; bf16* H; bf16* HB; bf16* QKV; bf16* Qb; bf16* Qc; bf16* Kb; bf16* Vb; bf16* MRG; bf16* PART; float* RSA; unsigned* ctl; bf16* XB;
};
__device__ __forceinline__ Ptrs make_ptrs(KArgs a) {
    Ptrs p; unsigned char* ws = a->ws;
    p.x_in = a->in[0]; p.c_in = a->in[1]; p.ctx_in = a->in[2]; p.cctx_in = a->in[3]; p.w_ada = a->in[4]; p.b_ada = a->in[5]; p.norm1_g = a->in[6]; p.w_in = a->in[7];
    p.q_norm_g = a->in[8]; p.k_norm_g = a->in[9]; p.conv_w = a->in[10]; p.conv_b = a->in[11]; p.attn_out_g = a->in[12]; p.conv_out_g = a->in[13]; p.w_out = a->in[14]; p.norm2_g = a->in[15];
    p.w_mlp_in = a->in[16]; p.w_mlp_out = a->in[17]; p.out = a->out;
    p.MOD = (float*)(ws + WS_MOD); p.XC = (float*)(ws + WS_XC); p.WT = (bf16*)(ws + WS_W); p.H = (bf16*)(ws + WS_H);
    p.HB = (bf16*)(ws + WS_BIG); p.QKV = (bf16*)(ws + WS_BIG + BIG_QKV); p.Qb = (bf16*)(ws + WS_BIG + BIG_Q); p.Qc = p.Qb + (size_t)ML * AW;
    p.Kb = (bf16*)(ws + WS_BIG + BIG_K); p.Vb = (bf16*)(ws + WS_BIG + BIG_V); p.MRG = (bf16*)(ws + WS_MRG); p.PART = (bf16*)(ws + WS_PART); p.RSA = (float*)(ws + WS_RSA); p.ctl = (unsigned*)(ws + WS_CTL); p.XB = (bf16*)(ws + WS_AO);
    return p;
}

__device__ __forceinline__ void silu_table(const float* c_in, const float* cctx_in, LAS unsigned char* L, int tid) {
    LAS float* sil = (LAS float*)(L + RING_OFF);
    for (int idx = tid; idx < 5 * DM; idx += NWAVES * 64) { const int r = idx >> 11, k = idx & (DM - 1); const float v = (r < 4) ? c_in[r * DM + k] : cctx_in[k]; sil[idx] = v / (1.0f + __expf(-v)); }
    __syncthreads();
}
#define GRID_BAR() do { XcdBarrier b_; b_.bar = (unsigned*)(fresh_args()->ws + WS_CTL) + CW_BAR; b_.x = xb_xcc_id(); b_.st = (volatile LAS unsigned*)(L + MISC_OFF) + 8; xcd_barrier(b_, fresh_int(wave_s) == 0 && lane_id() == 0); } while (0)
__global__ void __launch_bounds__(NWAVES * 64, 2) fwd_kernel(Args args_unused) {
    extern __shared__ __attribute__((aligned(16))) unsigned char lds[];
    LAS unsigned char* L = (LAS unsigned char*)lds;
    const int wave_s = __builtin_amdgcn_readfirstlane((int)threadIdx.x >> 6);
    {
        volatile LAS unsigned* MISC = (volatile LAS unsigned*)(L + MISC_OFF);
        const int tid = (fresh_int(wave_s) * 64 + lane_id());
        for (int u = tid; u < 64; u += NWAVES * 64) MISC[u] = 0u;
        {
            LAS f32x2* rope = (LAS f32x2*)(L + ROPE_OFF);
            for (int idx = tid; idx < 2048; idx += NWAVES * 64) { const int pos = idx >> 5, i = idx & 31;
                const float f = exp2f(-(float)i * (13.287712379549449f / 32.f)); const float a = (float)pos * f;
                f32x2 v; v.x = __cosf(a); v.y = __sinf(a); rope[idx] = v; }
        }
        __syncthreads();
        const Ptrs P = make_ptrs(fresh_args());
        (void)xcd_barrier_post(P.ctl + CW_BAR, MISC + 8, tid == 0);
    }

    {
        const Ptrs P = make_ptrs(fresh_args()); const int tid = (fresh_int(wave_s) * 64 + lane_id()), lane = tid & 63, wave = __builtin_amdgcn_readfirstlane(tid >> 6), G = fresh_int((int)gridDim.x);
        LAS float* sil = (LAS float*)(L + RING_OFF); LAS float* red = sil + 5 * DM;
        silu_table(P.c_in, P.cctx_in, L, tid);
        if (G == 256) { for (int it = BID(); it < 192 + 8 * (NL - 1); it += G) adaln_item(P.w_ada, P.b_ada, P.MOD, sil, red, it < 192 ? it : (1 + (it - 192) / 8) * 192 + 184 + (it - 192) % 8, tid, wave, lane); }
        else { for (int it = BID(); it < NL * 192; it += G) adaln_item(P.w_ada, P.b_ada, P.MOD, sil, red, it, tid, wave, lane); }
        __syncthreads();
        LAS float* scr = (LAS float*)(L + RING_OFF + wave * 16384);
        constexpr int I_IN = (DM / 64) * (INW / 32), I_OUT = (DM / 64) * (DM / 32), I_1 = (DM / 64) * (FF / 32), I_2 = (FF / 64) * (DM / 32), I_LAYER = I_IN + I_OUT + I_1 + I_2;
        const int gw = BID() * NWAVES + wave, NGW = G * NWAVES;
        for (int it = gw; it < NL * I_LAYER; it += NGW) {
            const int l = it / I_LAYER; int r = it % I_LAYER; bf16* wl = P.WT + (size_t)l * W_LAYER_E;
            if (r < I_IN) { p0_transpose_item(P.w_in + (size_t)l * DM * INW, DM, INW, wl, scr, r, lane, true); continue; } r -= I_IN;
            if (r < I_OUT) { p0_transpose_item(P.w_out + (size_t)l * DM * DM, DM, DM, wl + W_IN_E, scr, r, lane); continue; } r -= I_OUT;
            if (r < I_1) { p0_transpose_item(P.w_mlp_in + (size_t)l * DM * FF, DM, FF, wl + W_IN_E + W_OUT_E, scr, r, lane); continue; } r -= I_1;
            p0_transpose_item(P.w_mlp_out + (size_t)l * FF * DM, FF, DM, wl + W_IN_E + W_OUT_E + W_1_E, scr, r, lane);
        }
    }
    GRID_BAR();

    for (int l = 0; l < NL; ++l) {
        {
            const Ptrs P = make_ptrs(fresh_args()); const int tid = (fresh_int(wave_s) * 64 + lane_id()), lane = tid & 63, wave = __builtin_amdgcn_readfirstlane(tid >> 6), G = fresh_int((int)gridDim.x);
            const float* xl_in = (l == 0) ? P.x_in : nullptr; const bf16* xl_b = (l == 0) ? nullptr : P.XB; const float* xc_in = (l == 0) ? P.ctx_in : P.XC;
            norm_mod_phase(xl_in, xl_b, xc_in, P.XC, (l == 0) ? nullptr : P.PART, P.MOD + (size_t)(l > 0 ? l - 1 : 0) * 5 * MODW + 4 * MODW + 5 * DM, nullptr, true, P.H, P.norm1_g + (size_t)l * DM, P.MOD + (size_t)l * 5 * MODW, 0, 1, BID(), G, wave, lane);
        }
        GRID_BAR();

        {
            const Ptrs P = make_ptrs(fresh_args()); const int G = fresh_int((int)gridDim.x);
            pg8::Gemm g{P.H, P.WT + (size_t)l * W_LAYER_E, MT, INW, DM}; pg8::StaticOrder S; S.init(MT, INW, DM, G, BID());
            pg8::EpiBf16<0, true> E{P.QKV, INW, P.Vb};
            pg8::gemm_phase<pg8::EpiBf16<0, true>, pg8::StaticOrder, true, true>(L + RING_OFF, g, S, E, fresh_int(wave_s));
            { const int rem = S.nwg % G, j = BID() - rem; if (l + 1 < NL && G == 256 && rem == 200 && j >= 0) { const int tid = (fresh_int(wave_s) * 64 + lane_id()), lane = tid & 63, wave = __builtin_amdgcn_readfirstlane(tid >> 6);
                silu_table(P.c_in, P.cctx_in, L, tid); adaln_item(P.w_ada, P.b_ada, P.MOD, (LAS float*)(L + RING_OFF), (LAS float*)(L + RING_OFF) + 5 * DM, (l + 1) * 192 + 128 + j, tid, wave, lane); } }
        }
        GRID_BAR();

        {
            const Ptrs P = make_ptrs(fresh_args()); const int tid = (fresh_int(wave_s) * 64 + lane_id()), lane = tid & 63, wave = __builtin_amdgcn_readfirstlane(tid >> 6), G = fresh_int((int)gridDim.x);
            const LAS f32x2* rope = (const LAS f32x2*)(L + ROPE_OFF);
            for (int c = BID(); c < 256; c += G) {
                const int b = c >> 6;
                token_rows(P.QKV, P.Qb, P.Qc, P.Kb, P.Vb, P.MRG, P.q_norm_g + l * HD, P.k_norm_g + l * HD, P.conv_w + (size_t)l * 3 * CW, P.conv_b + l * CW, P.conv_out_g + l * CW, rope, b, (c & 63) * 64 + 8 * wave, 8, true, lane);
                if (wave < 4) token_rows(P.QKV, P.Qb, P.Qc, P.Kb, P.Vb, P.MRG, P.q_norm_g + l * HD, P.k_norm_g + l * HD, P.conv_w + (size_t)l * 3 * CW, P.conv_b + l * CW, P.conv_out_g + l * CW, rope, b, (c & 63) * 4 + wave, 1, false, lane);
            }
        }
        GRID_BAR();

        {
            const Ptrs P = make_ptrs(fresh_args()); const int G = fresh_int((int)gridDim.x);
            const int nunits = (l == NL - 1) ? 512 : 544;
            for (int u = BID(); u < nunits; u += G) {
                const bf16 *q, *k, *v; bf16* o; float* rs; const float* gn; int seq;
                if (u < 512) { const int grp = u & 7, idx = u >> 3, b = grp >> 1, kv = grp & 1, h = kv * 4 + (idx >> 4), qb = idx & 15;
                    q = P.Qb + ((size_t)(b * NH + h) * SEQ + 256 * qb) * HD; k = P.Kb + (size_t)(b * NKV + kv) * SKV * HD; v = P.Vb + (size_t)(b * NKV + kv) * SKV * HD;
                    o = P.MRG + (size_t)(b * SEQ + 256 * qb) * DM + h * HD; rs = P.RSA + (size_t)(b * SEQ + 256 * qb) * 8 + h; gn = P.attn_out_g + l * AW + h * HD; seq = SKV; }
                else { const int cu = u - 512, b = cu >> 3, h = cu & 7, kv = h >> 2;
                    q = P.Qc + (size_t)(b * NH + h) * CTX * HD; k = P.Kb + ((size_t)(b * NKV + kv) * SKV + SEQ) * HD; v = P.Vb + ((size_t)(b * NKV + kv) * SKV + SEQ) * HD;
                    o = P.MRG + (size_t)(ML + b * CTX) * DM + h * HD; rs = P.RSA + (size_t)(ML + b * CTX) * 8 + h; gn = P.attn_out_g + l * AW + h * HD; seq = CTX; }
                attn::attn_dense_body(q, k, v, o, gn, rs, seq, (char*)lds + RING_OFF, (char*)lds + STASH_OFF, fresh_int(wave_s));
                __syncthreads();
            }
        }
        GRID_BAR();

        {
            const Ptrs P = make_ptrs(fresh_args()); const int G = fresh_int((int)gridDim.x); const int Mrows = (l == NL - 1) ? ML : MT;
            pg8::Gemm g{P.MRG, P.WT + (size_t)l * W_LAYER_E + W_IN_E, Mrows, DM, DM}; pg8::ResidOrder S; S.init(ML, DM, DM, G, BID(), l != NL - 1);
            pg8::EpiResid<true> E{(l == 0) ? P.x_in : nullptr, P.XB, nullptr, P.XB, P.MOD + (size_t)l * 5 * MODW + 2 * DM, MODW, P.PART, P.RSA, L + STASH_OFF};
            pg8::gemm_phase<pg8::EpiResid<true>, pg8::ResidOrder, true, true>(L + RING_OFF, g, S, E, fresh_int(wave_s));
        }
        GRID_BAR();

        {
            const Ptrs P = make_ptrs(fresh_args()); const int tid = (fresh_int(wave_s) * 64 + lane_id()), lane = tid & 63, wave = __builtin_amdgcn_readfirstlane(tid >> 6), G = fresh_int((int)gridDim.x);
            norm_mod_phase(nullptr, P.XB, (l == 0) ? P.ctx_in : P.XC, P.XC, P.PART, P.MOD + (size_t)l * 5 * MODW + 4 * MODW + 2 * DM, P.RSA + (size_t)ML * 8, l != NL - 1, P.H, P.norm2_g + (size_t)l * DM, P.MOD + (size_t)l * 5 * MODW, 3, 4, BID(), G, wave, lane);
        }
        GRID_BAR();

        {
            const Ptrs P = make_ptrs(fresh_args()); const int G = fresh_int((int)gridDim.x); const int Mrows = (l == NL - 1) ? ML : MT;
            pg8::Gemm g{P.H, P.WT + (size_t)l * W_LAYER_E + W_IN_E + W_OUT_E, Mrows, FF, DM}; pg8::StaticOrder S; S.init(Mrows, FF, DM, G, BID());
            pg8::EpiBf16<2> E{P.HB, FF, nullptr};
            pg8::gemm_phase<pg8::EpiBf16<2>, pg8::StaticOrder, true, true>(L + RING_OFF, g, S, E, fresh_int(wave_s));
            { const int rem = S.nwg % G, j = BID() - rem; if (l + 1 < NL && G == 256 && rem == 128 && j >= 0) { const int tid = (fresh_int(wave_s) * 64 + lane_id()), lane = tid & 63, wave = __builtin_amdgcn_readfirstlane(tid >> 6);
                silu_table(P.c_in, P.cctx_in, L, tid); adaln_item(P.w_ada, P.b_ada, P.MOD, (LAS float*)(L + RING_OFF), (LAS float*)(L + RING_OFF) + 5 * DM, (l + 1) * 192 + j, tid, wave, lane); } }
        }
        GRID_BAR();

        {
            const Ptrs P = make_ptrs(fresh_args()); const int G = fresh_int((int)gridDim.x); const int Mrows = (l == NL - 1) ? ML : MT;
            pg8::Gemm g{P.HB, P.WT + (size_t)l * W_LAYER_E + W_IN_E + W_OUT_E + W_1_E, Mrows, DM, FF}; pg8::ResidOrder S; S.init(ML, DM, FF, G, BID(), l != NL - 1);
            pg8::EpiResid<false> E{nullptr, P.XB, (l == NL - 1) ? P.out : nullptr, P.XB, P.MOD + (size_t)l * 5 * MODW + 5 * DM, MODW, P.PART, nullptr, L + STASH_OFF};
            pg8::gemm_phase<pg8::EpiResid<false>, pg8::ResidOrder, true, true>(L + RING_OFF, g, S, E, fresh_int(wave_s));
        }
        if (l != NL - 1) GRID_BAR();
    }
}

extern "C" void kernel_launch(void* const* d_in, const int* in_sizes, int n_in, void* d_out, int out_size, void* d_ws, size_t ws_size, hipStream_t stream) {
    static int grid = 0;
    if (grid == 0) {
        if (n_in != 18 || in_sizes[0] != ML * DM || out_size != ML * DM || ws_size < WS_END) {
            fprintf(stderr, "kernel_launch: shape mismatch: n_in %d in0 %d out %d ws %zu (need %zu)\n", n_in, n_in > 0 ? in_sizes[0] : -1, out_size, ws_size, (size_t)WS_END); grid = -1; return; }
        int dev = 0, cus = 0, per_cu = 0;
        if (hipGetDevice(&dev) != hipSuccess || hipDeviceGetAttribute(&cus, hipDeviceAttributeMultiprocessorCount, dev) != hipSuccess) { fprintf(stderr, "kernel_launch: device query failed\n"); grid = -1; return; }
        if (hipFuncSetAttribute((const void*)fwd_kernel, hipFuncAttributeMaxDynamicSharedMemorySize, LDS_BYTES) != hipSuccess) { fprintf(stderr, "kernel_launch: hipFuncSetAttribute failed\n"); grid = -1; return; }
        if (hipOccupancyMaxActiveBlocksPerMultiprocessor(&per_cu, (const void*)fwd_kernel, NWAVES * 64, LDS_BYTES) != hipSuccess || per_cu < 1)
            fprintf(stderr, "kernel_launch: note: occupancy query reports %d workgroups per CU\n", per_cu);
        (void)hipGetLastError();
        grid = cus < 256 ? (cus / 8) * 8 : 256;
        if (grid < 8) grid = cus;
    }
    if (grid < 0) return;
    if (hipMemsetAsync((char*)d_ws + WS_CTL, 0, CTL_ZERO_BYTES, stream) != hipSuccess) { fprintf(stderr, "kernel_launch: memset failed\n"); return; }
    Args a{};
    for (int i = 0; i < 18; ++i) a.in[i] = (const float*)d_in[i];
    a.out = (float*)d_out; a.ws = (unsigned char*)d_ws;
    hipLaunchKernelGGL(fwd_kernel, dim3(grid), dim3(NWAVES * 64), LDS_BYTES, stream, a);
    const hipError_t le = hipPeekAtLastError();
    if (le != hipSuccess) fprintf(stderr, "kernel_launch: launch failed: %s\n", hipGetErrorName(le));
}
```

```cpp
#include <hip/hip_runtime.h>
#include <cstdio>
#include <cstdint>
namespace pg8 {
#define PG8_LAS __attribute__((address_space(3)))
typedef unsigned short bf16_t;
typedef short bf16x8 __attribute__((ext_vector_type(8)));
typedef float f32x4 __attribute__((ext_vector_type(4)));
typedef unsigned u32x4 __attribute__((ext_vector_type(4)));
constexpr int BM = 256, BK = 64, HALF = 128, HTB = HALF * BK * 2  , STAGE_BYTES = 8 * HTB, NXCD = 8, WGM = 8;

__host__ __device__ __forceinline__ int lds_byte(int r, int c) { const int st = (r >> 4) * 2 + (c >> 5), rr = r & 15, cc = c & 31, ob = rr * 64 + cc * 2; return st * 1024 + (ob ^ (((ob >> 9) & 1) << 5)); }
__host__ __device__ __forceinline__ void stage_rc(int b, int& R, int& C) { const int st = b / 1024, sb = b % 1024, swz = sb ^ (((sb >> 9) & 1) << 5); R = (st >> 1) * 16 + swz / 64; C = (st & 1) * 32 + (swz % 64) / 2; }
__host__ __device__ __forceinline__ int perm32(int rho) { const int n = rho >> 4, i = rho & 15; return 8 * (i >> 2) + 4 * n + (i & 3); }

struct Unit { int pm, pn, k0, nt, kind; };
struct Gemm { const bf16_t* A; const bf16_t* Bt; int M, N, K; };

struct StaticOrder {
    int nM, nN, nwg, G, c, ntf, tr = 0;
    __host__ __device__ void init(int M, int N, int K, int G_, int c_) { nM = M / BM; nN = N / BM; nwg = nM * nN; G = G_; c = c_; ntf = K / BK; }
    __host__ __device__ bool next(int i, Unit& u) const {
        const long L = (long)i * G + c; if (L >= nwg) return false;
        int wgid = (int)L; { const int q = nwg / NXCD, r = nwg % NXCD, xcd = wgid % NXCD, off = wgid / NXCD; wgid = (xcd < r ? xcd * (q + 1) : r * (q + 1) + (xcd - r) * q) + off; }
        const int nig = WGM * nN, gid = wgid / nig, fm = gid * WGM, gsz = (nM - fm) < WGM ? (nM - fm) : WGM;
        const int idx = wgid % nig; if (tr) { u.pm = fm + idx / nN; u.pn = idx % nN; } else { u.pm = fm + (idx % gsz); u.pn = idx / gsz; } u.k0 = 0; u.nt = ntf; u.kind = 0; return true;
    }
    __device__ __forceinline__ void a_ready(const Unit&) const {}
    __device__ __forceinline__ void done(const Unit&) const {}
};

__device__ __forceinline__ unsigned cvt_pk_bf16(float lo, float hi) { unsigned r; asm volatile("v_cvt_pk_bf16_f32 %0, %1, %2" : "=v"(r) : "v"(lo), "v"(hi)); return r; }
typedef float f32x2 __attribute__((ext_vector_type(2)));


__device__ __forceinline__ float relu1(float x) { float r; asm("v_max_f32 %0, 0, %1" : "=v"(r) : "v"(x)); return r; }
#define PG8_PAIR_STORE(P, LDC, W0, W1) do { const u32x4 snd_ = hb ? (W0) : (W1); u32x4 rcv_; \
    rcv_.x = (unsigned)__builtin_amdgcn_mov_dpp((int)snd_.x, 0xB1, 0xF, 0xF, true); rcv_.y = (unsigned)__builtin_amdgcn_mov_dpp((int)snd_.y, 0xB1, 0xF, 0xF, true); \
    rcv_.z = (unsigned)__builtin_amdgcn_mov_dpp((int)snd_.z, 0xB1, 0xF, 0xF, true); rcv_.w = (unsigned)__builtin_amdgcn_mov_dpp((int)snd_.w, 0xB1, 0xF, 0xF, true); \
    *(u32x4*)(P) = hb ? rcv_ : (W0); *(u32x4*)((P) + (LDC)) = hb ? (W1) : rcv_; } while (0)
typedef unsigned v4u32_t __attribute__((__vector_size__(16)));
#define PG8_PAIR_STORE_BUF(RS, VOFF, SOFF, ROWB, W0, W1) do { const u32x4 snd_ = hb ? (W0) : (W1); u32x4 rcv_; \
    rcv_.x = (unsigned)__builtin_amdgcn_mov_dpp((int)snd_.x, 0xB1, 0xF, 0xF, true); rcv_.y = (unsigned)__builtin_amdgcn_mov_dpp((int)snd_.y, 0xB1, 0xF, 0xF, true); \
    rcv_.z = (unsigned)__builtin_amdgcn_mov_dpp((int)snd_.z, 0xB1, 0xF, 0xF, true); rcv_.w = (unsigned)__builtin_amdgcn_mov_dpp((int)snd_.w, 0xB1, 0xF, 0xF, true); \
    const u32x4 s1_ = hb ? rcv_ : (W0), s2_ = hb ? (W1) : rcv_; \
    __builtin_amdgcn_raw_buffer_store_b128(__builtin_bit_cast(v4u32_t, s1_), (RS), (VOFF), (SOFF), 0); \
    __builtin_amdgcn_raw_buffer_store_b128(__builtin_bit_cast(v4u32_t, s2_), (RS), (VOFF), (SOFF) + (ROWB), 0); } while (0)
template <int ACT, bool ZF = false> struct EpiBf16 {
    static constexpr bool PERM = true, AFTER_DRAIN = false, MIDK = false; static constexpr int MIDK_TILE = 0;
    __device__ __forceinline__ void mid(f32x4 (&)[2][2][4][2], const Unit&, int) const {}
    __device__ __forceinline__ void pre(const Unit&, int, int, int) const {}
    bf16_t* O; int ldc; bf16_t* V;
    __device__ __forceinline__ void operator()(const f32x4 (&acc)[2][2][4][2], const Unit& u, int wr, int wc, int fr, int fq) const {
        const int row0 = u.pm * BM + wr * 64 + fr; const int col0 = u.pn * BM + wc * 64 + 8 * fq;
        if constexpr (ZF) {
            if (u.pn == 5) {
                const int hb = fr & 1, b = u.pm < 64 ? (u.pm >> 4) : (u.pm - 64), pos0 = (u.pm < 64 ? (u.pm & 15) * BM : 4096) + wr * 64 + fr - hb;
                bf16_t* vbase = V + ((size_t)(b * 2 + (wc >> 1)) * 4352 + pos0) * 128 + (wc & 1) * 64 + 8 * fq + 32 * hb;
#pragma unroll
                for (int ai = 0; ai < 2; ++ai)
#pragma unroll
                    for (int m = 0; m < 4; ++m) { u32x4 w[2];
#pragma unroll
                        for (int bj = 0; bj < 2; ++bj) { const f32x4 v0 = acc[ai][bj][m][0], v1 = acc[ai][bj][m][1];
                            w[bj].x = cvt_pk_bf16(v0[0], v0[1]); w[bj].y = cvt_pk_bf16(v0[2], v0[3]); w[bj].z = cvt_pk_bf16(v1[0], v1[1]); w[bj].w = cvt_pk_bf16(v1[2], v1[3]); }
                        bf16_t* rp = vbase + (size_t)(ai * HALF + m * 16) * 128;
                        PG8_PAIR_STORE(rp, 128, w[0], w[1]); }
                return;
            }
            if (u.pn >= 10) {
                const int zc0 = 2560 + (u.pn - 10) * HALF + wc * 32 + 8 * fq;
#pragma unroll
                for (int ai = 0; ai < 2; ++ai)
#pragma unroll
                    for (int m = 0; m < 4; ++m) { const f32x4 v0 = acc[ai][0][m][0] * acc[ai][1][m][0], v1 = acc[ai][0][m][1] * acc[ai][1][m][1];
                        u32x4 w; w.x = cvt_pk_bf16(v0[0], v0[1]); w.y = cvt_pk_bf16(v0[2], v0[3]); w.z = cvt_pk_bf16(v1[0], v1[1]); w.w = cvt_pk_bf16(v1[2], v1[3]);
                        *(u32x4*)(O + (size_t)(row0 + ai * HALF + m * 16) * ldc + zc0) = w; }
                return;
            }
        }
        const int hb = fr & 1;
        const __amdgpu_buffer_rsrc_t rs = __builtin_amdgcn_make_buffer_rsrc((void*)O, 0, 0x7ffff000, 0x00020000);
        const int rowb = ldc * 2;
        const int voff = ((row0 - hb) * ldc + col0 + 32 * hb) * 2;
#pragma unroll
        for (int ai = 0; ai < 2; ++ai)
#pragma unroll
            for (int m = 0; m < 4; ++m) { u32x4 w[2];
#pragma unroll
                for (int bj = 0; bj < 2; ++bj) { f32x4 v0 = acc[ai][bj][m][0], v1 = acc[ai][bj][m][1];
                    if (ACT == 2) { _Pragma("unroll") for (int e_ = 0; e_ < 4; ++e_) { v0[e_] = relu1(v0[e_]); v1[e_] = relu1(v1[e_]); } v0 = v0 * v0; v1 = v1 * v1; }
                    w[bj].x = cvt_pk_bf16(v0[0], v0[1]); w[bj].y = cvt_pk_bf16(v0[2], v0[3]); w[bj].z = cvt_pk_bf16(v1[0], v1[1]); w[bj].w = cvt_pk_bf16(v1[2], v1[3]); }
                PG8_PAIR_STORE_BUF(rs, voff, (ai * HALF + m * 16) * rowb, rowb, w[0], w[1]); }
    }
};

template <bool MIDK_> struct EpiResid {
    static constexpr bool PERM = true, AFTER_DRAIN = false, MIDK = MIDK_; static constexpr int MIDK_TILE = 16;
    const float* xin_f; const bf16_t* xin_b; float* xout_f; bf16_t* xout_b; const float* gate; int gstride; bf16_t* part; const float* rsa; PG8_LAS unsigned char* stash;
    __device__ __forceinline__ void pre(const Unit& u, int wr, int fr, int tid) const {
        if constexpr (MIDK_) {
            typedef __fp16 h2 __attribute__((ext_vector_type(2)));
            const int row0 = (u.kind == 0 ? u.pm * BM : 0) + wr * 64 + fr; float t[8], f[8];
            {
                f32x4 q[8][2];
#pragma unroll
                for (int i = 0; i < 8; ++i) { const float* rp = rsa + (size_t)(row0 + (i >> 2) * HALF + (i & 3) * 16) * 8; q[i][0] = *(const f32x4*)rp; q[i][1] = *(const f32x4*)(rp + 4); }
                asm volatile("" ::: "memory");
#pragma unroll
                for (int i = 0; i < 8; ++i) t[i] = ((q[i][0][0] + q[i][0][1]) + (q[i][0][2] + q[i][0][3])) + ((q[i][1][0] + q[i][1][1]) + (q[i][1][2] + q[i][1][3]));
            }
#pragma unroll
            for (int i = 0; i < 8; ++i) f[i] = 1.0f / sqrtf(t[i] * (1.f / 1024.f) + 1e-6f);
            u32x4 w;
            w.x = __builtin_bit_cast(unsigned, __builtin_amdgcn_cvt_pkrtz(f[0], f[1])); w.y = __builtin_bit_cast(unsigned, __builtin_amdgcn_cvt_pkrtz(f[2], f[3]));
            w.z = __builtin_bit_cast(unsigned, __builtin_amdgcn_cvt_pkrtz(f[4], f[5])); w.w = __builtin_bit_cast(unsigned, __builtin_amdgcn_cvt_pkrtz(f[6], f[7]));
            *(PG8_LAS u32x4*)(stash + tid * 16) = w;
        }
    }
    __device__ __forceinline__ void mid(f32x4 (&acc)[2][2][4][2], const Unit& u, int tid) const {
        if (u.kind != 0) return;
        typedef _Float16 hf2 __attribute__((ext_vector_type(2)));
        const u32x4 w = *(const PG8_LAS u32x4*)(stash + tid * 16);
        const unsigned wq[4] = {w.x, w.y, w.z, w.w}; float f[8];
#pragma unroll
        for (int i = 0; i < 4; ++i) { const hf2 p = __builtin_bit_cast(hf2, wq[i]); f[2 * i] = (float)p[0]; f[2 * i + 1] = (float)p[1]; }
#pragma unroll
        for (int ai = 0; ai < 2; ++ai)
#pragma unroll
            for (int m = 0; m < 4; ++m)
#pragma unroll
                for (int bj = 0; bj < 2; ++bj)
#pragma unroll
                    for (int n = 0; n < 2; ++n) acc[ai][bj][m][n] = acc[ai][bj][m][n] * f[ai * 4 + m];
    }
    __device__ __forceinline__ void operator()(const f32x4 (&acc)[2][2][4][2], const Unit& u, int wr, int wc, int fr, int fq) const {
        int prow = (u.pm < 64 ? u.pm : u.pm - 64) * BM + wr * 64 + fr, col0 = u.pn * BM + wc * 64 + 8 * fq;
        asm volatile("" : "+v"(prow), "+v"(col0));
        const int hb = prow & 1;
        if (u.kind == 0) {
            const float* gp = gate + (size_t)(u.pm >> 4) * gstride + col0;
            f32x4 gv[2][2];
#pragma unroll
            for (int bj = 0; bj < 2; ++bj)
#pragma unroll
                for (int n = 0; n < 2; ++n) gv[bj][n] = *(const f32x4*)(gp + bj * 32 + n * 4);
            if (xin_f) {
#pragma unroll
                for (int am = 0; am < 4; ++am) { const int ai = am >> 1, mh = am & 1;
                    f32x4 xv[2][2][2];
#pragma unroll
                    for (int mm = 0; mm < 2; ++mm) { const size_t off = (size_t)(prow + ai * HALF + (2 * mh + mm) * 16) * 2048 + col0;
#pragma unroll
                        for (int bj = 0; bj < 2; ++bj)
#pragma unroll
                            for (int n = 0; n < 2; ++n) xv[mm][bj][n] = *(const f32x4*)(xin_f + off + bj * 32 + n * 4); }
                    asm volatile("" ::: "memory");
#pragma unroll
                    for (int mm = 0; mm < 2; ++mm) { const int m = 2 * mh + mm; const size_t off = (size_t)(prow + ai * HALF + m * 16) * 2048 + col0;
                        u32x4 w[2];
#pragma unroll
                        for (int bj = 0; bj < 2; ++bj) { const f32x4 v0 = xv[mm][bj][0] + gv[bj][0] * acc[ai][bj][m][0], v1 = xv[mm][bj][1] + gv[bj][1] * acc[ai][bj][m][1];
                            w[bj].x = cvt_pk_bf16(v0[0], v0[1]); w[bj].y = cvt_pk_bf16(v0[2], v0[3]); w[bj].z = cvt_pk_bf16(v1[0], v1[1]); w[bj].w = cvt_pk_bf16(v1[2], v1[3]); }
                        PG8_PAIR_STORE(xout_b + off - (size_t)hb * 2048 + 32 * hb, 2048, w[0], w[1]); }
                    asm volatile("" ::: "memory");
                }
            } else {
                const bool of = xout_f != nullptr;
#pragma unroll
                for (int ai = 0; ai < 2; ++ai) {
                    u32x4 raw[4][2];
#pragma unroll
                    for (int m = 0; m < 4; ++m) { const size_t off = (size_t)(prow + ai * HALF + m * 16) * 2048 + col0;
#pragma unroll
                        for (int bj = 0; bj < 2; ++bj) raw[m][bj] = *(const u32x4*)(xin_b + off + bj * 32); }
                    asm volatile("" ::: "memory");
#pragma unroll
                    for (int m = 0; m < 4; ++m) { const size_t off = (size_t)(prow + ai * HALF + m * 16) * 2048 + col0;
                        u32x4 w[2];
#pragma unroll
                        for (int bj = 0; bj < 2; ++bj) { const u32x4 rw = raw[m][bj];
                            f32x4 x0, x1;
                            x0[0] = __builtin_bit_cast(float, rw.x << 16); x0[1] = __builtin_bit_cast(float, rw.x & 0xffff0000u); x0[2] = __builtin_bit_cast(float, rw.y << 16); x0[3] = __builtin_bit_cast(float, rw.y & 0xffff0000u);
                            x1[0] = __builtin_bit_cast(float, rw.z << 16); x1[1] = __builtin_bit_cast(float, rw.z & 0xffff0000u); x1[2] = __builtin_bit_cast(float, rw.w << 16); x1[3] = __builtin_bit_cast(float, rw.w & 0xffff0000u);
                            const f32x4 v0 = x0 + gv[bj][0] * acc[ai][bj][m][0], v1 = x1 + gv[bj][1] * acc[ai][bj][m][1];
                            if (of) { *(f32x4*)(xout_f + off + bj * 32) = v0; *(f32x4*)(xout_f + off + bj * 32 + 4) = v1; }
                            else { w[bj].x = cvt_pk_bf16(v0[0], v0[1]); w[bj].y = cvt_pk_bf16(v0[2], v0[3]); w[bj].z = cvt_pk_bf16(v1[0], v1[1]); w[bj].w = cvt_pk_bf16(v1[2], v1[3]); } }
                        if (!of) PG8_PAIR_STORE(xout_b + off - (size_t)hb * 2048 + 32 * hb, 2048, w[0], w[1]); }
                    asm volatile("" ::: "memory");
                }
            }
        } else {
            bf16_t* po = part + (size_t)(u.kind - 1) * 1024 * 2048;
#pragma unroll
            for (int ai = 0; ai < 2; ++ai)
#pragma unroll
                for (int m = 0; m < 4; ++m) { const size_t off = (size_t)(prow + ai * HALF + m * 16) * 2048 + col0;
                    u32x4 w[2];
#pragma unroll
                    for (int bj = 0; bj < 2; ++bj) { const f32x4 v0 = acc[ai][bj][m][0], v1 = acc[ai][bj][m][1];
                        w[bj].x = cvt_pk_bf16(v0[0], v0[1]); w[bj].y = cvt_pk_bf16(v0[2], v0[3]); w[bj].z = cvt_pk_bf16(v1[0], v1[1]); w[bj].w = cvt_pk_bf16(v1[2], v1[3]); }
                    PG8_PAIR_STORE(po + off - (size_t)hb * 2048 + 32 * hb, 2048, w[0], w[1]); }
        }
    }
};

struct ResidOrder {
    StaticOrder lat; int has_ctx, kc, ntc;
    __device__ void init(int Mlat, int N, int K, int G, int c, int has_ctx_) { lat.init(Mlat, N, K, G, c); lat.tr = 1; has_ctx = has_ctx_; kc = K / 8; ntc = kc / BK; }
    __device__ bool next(int i, Unit& u) const {
        if (lat.next(i, u)) return true;
        if (!has_ctx) return false;
        const long L = (long)i * lat.G + lat.c; const int j = (int)(L - lat.nwg); if (j >= 256) return false;
        const int ks = j & 7; u.pn = (j >> 3) & 7; u.pm = lat.nM + (j >> 6); u.k0 = ks * kc; u.nt = ntc; u.kind = 1 + ks; return true;
    }
    __device__ __forceinline__ void a_ready(const Unit&) const {}
    __device__ __forceinline__ void done(const Unit&) const {}
};

template <class Epi, class Sched, bool ALIGN_EPI = false, bool SP2 = false>
__device__ __forceinline__ void gemm_phase(PG8_LAS unsigned char* lds, const Gemm g, const Sched& S, const Epi& E, int wave_id) {
    unsigned z_ = 0u; asm volatile("" : "+v"(z_)); const int lane_ = (int)__builtin_amdgcn_mbcnt_hi(~0u, __builtin_amdgcn_mbcnt_lo(~0u, z_));
    const int wid = wave_id, lane = lane_, tid = wid * 64 + lane, wr = wid >> 2, wc = wid & 3, fr = lane & 15, fq = lane >> 4;
    const int K = g.K;
    unsigned voffA[2], voffB[2];
#pragma unroll
    for (int i = 0; i < 2; ++i) { int R, C; stage_rc(tid * 16 + i * 8192, R, C); const int Rb = Epi::PERM ? (64 * (R >> 5) + perm32(R & 31)) : R;
        voffA[i] = (unsigned)(R * K + C) * 2u; voffB[i] = (unsigned)(Rb * K + C) * 2u; }
    const size_t kstep = (size_t)(BK * 2);
    const size_t hstep = (size_t)HALF * K * 2;
    const size_t hstepB = Epi::PERM ? (size_t)32 * K * 2 : hstep;
    const size_t tstep = 2 * hstep;
    const unsigned ldsw = (unsigned)wid * 1024u;
    const int aoff = lds_byte(wr * 64 + fr, fq * 8), boff = lds_byte(wc * 32 + fr, fq * 8);
#define PG8_SA(b, h) (((b) * 2 + (h)) * HTB)
#define PG8_SB(b, h) ((4 + (b) * 2 + (h)) * HTB)
#define PG8_STAGE(bufoff, gbase, voff) do { _Pragma("unroll") for (int _i = 0; _i < 2; ++_i) \
        __builtin_amdgcn_global_load_lds((const unsigned*)((const char*)(gbase) + (voff)[_i]), (PG8_LAS unsigned*)(lds + (bufoff) + ldsw + _i * 8192), 16, 0, 0); } while (0)
#define PG8_LDA(dst, b, h) do { _Pragma("unroll") for (int m = 0; m < 4; ++m) _Pragma("unroll") for (int k = 0; k < 2; ++k) dst[m][k] = *(const PG8_LAS bf16x8*)(lds + PG8_SA(b, h) + aoff + m * 2048 + k * 1024); } while (0)
#define PG8_LDB(dst, b, h) do { _Pragma("unroll") for (int n = 0; n < 2; ++n) _Pragma("unroll") for (int k = 0; k < 2; ++k) dst[n][k] = *(const PG8_LAS bf16x8*)(lds + PG8_SB(b, h) + boff + n * 2048 + k * 1024); } while (0)
#define PG8_MMA(ai, bj, At, Bt) do { __builtin_amdgcn_s_setprio(1); _Pragma("unroll") for (int m = 0; m < 4; ++m) _Pragma("unroll") for (int n = 0; n < 2; ++n) _Pragma("unroll") for (int k = 0; k < 2; ++k) \
        acc[ai][bj][m][n] = __builtin_amdgcn_mfma_f32_16x16x32_bf16(Bt[n][k], At[m][k], acc[ai][bj][m][n], 0, 0, 0); __builtin_amdgcn_s_setprio(0); } while (0)
#define PG8_WAIT_V(n) asm volatile("s_waitcnt vmcnt(" #n ")" ::: "memory")
#define PG8_WAIT_L(n) asm volatile("s_waitcnt lgkmcnt(" #n ")" ::: "memory")
#define PG8_BAR __builtin_amdgcn_s_barrier()
#define PG8_SCHED __builtin_amdgcn_sched_barrier(0)
    Unit cur, nxt; int ui = 0;
    if (!S.next(0, cur)) return;
    f32x4 acc[2][2][4][2];
#pragma unroll
    for (int a = 0; a < 2; ++a)
#pragma unroll
        for (int b = 0; b < 2; ++b)
#pragma unroll
            for (int m = 0; m < 4; ++m)
#pragma unroll
                for (int n = 0; n < 2; ++n) acc[a][b][m][n] = (f32x4){0.f, 0.f, 0.f, 0.f};
    bf16x8 At[4][2], B0[2][2], B1[2][2];
    const char* cA = (const char*)g.A + (size_t)cur.pm * tstep + (size_t)cur.k0 * 2; const char* cB = (const char*)g.Bt + (size_t)cur.pn * tstep + (size_t)cur.k0 * 2;
    S.a_ready(cur);
    if constexpr (Epi::MIDK) E.pre(cur, wr, fr, tid);
    if constexpr (SP2) {
        PG8_STAGE(PG8_SB(0, 0), cB, voffB); PG8_STAGE(PG8_SB(0, 1), cB + hstepB, voffB); PG8_STAGE(PG8_SA(0, 0), cA, voffA); PG8_STAGE(PG8_SA(0, 1), cA + hstep, voffA);
        if (wr == 1) PG8_BAR;
        PG8_WAIT_V(2); PG8_BAR;
        PG8_STAGE(PG8_SB(1, 0), cB + kstep, voffB); PG8_STAGE(PG8_SA(1, 0), cA + kstep, voffA); PG8_STAGE(PG8_SB(1, 1), cB + hstepB + kstep, voffB);
        PG8_WAIT_V(6); PG8_BAR;
    } else {
        PG8_STAGE(PG8_SB(0, 0), cB, voffB); PG8_STAGE(PG8_SA(0, 0), cA, voffA); PG8_STAGE(PG8_SB(0, 1), cB + hstepB, voffB); PG8_STAGE(PG8_SA(0, 1), cA + hstep, voffA);
        if (wr == 1) PG8_BAR;
        PG8_WAIT_V(4); PG8_BAR;
        PG8_STAGE(PG8_SB(1, 0), cB + kstep, voffB); PG8_STAGE(PG8_SA(1, 0), cA + kstep, voffA); PG8_STAGE(PG8_SB(1, 1), cB + hstepB + kstep, voffB);
        PG8_WAIT_V(6); PG8_BAR;
    }
    for (;;) {
        const bool has_next = S.next(ui + 1, nxt);
        const char* nA = has_next ? (const char*)g.A + (size_t)nxt.pm * tstep + (size_t)nxt.k0 * 2 : cA; const char* nB = has_next ? (const char*)g.Bt + (size_t)nxt.pn * tstep + (size_t)nxt.k0 * 2 : cB;
        const int nt = cur.nt;
        for (int t = 0; t < nt; t += 2) {
            const bool last = (t == nt - 2);
            const char* a1 = cA + (size_t)(t + 1) * kstep;
            const char* a2 = last ? nA : cA + (size_t)(t + 2) * kstep; const char* b2 = last ? nB : cB + (size_t)(t + 2) * kstep;
            const char* a3 = a2 + kstep; const char* b3 = b2 + kstep;
            if (last && has_next) S.a_ready(nxt);
            if constexpr (Epi::MIDK) { if (t == Epi::MIDK_TILE) E.mid(acc, cur, tid); }
            if constexpr (SP2) {
            PG8_LDB(B0, 0, 0); PG8_LDB(B1, 0, 1); PG8_SCHED; PG8_LDA(At, 0, 0); PG8_STAGE(PG8_SA(1, 1), a1 + hstep, voffA);
            PG8_WAIT_V(8); PG8_WAIT_L(0); PG8_BAR; PG8_MMA(0, 0, At, B0); PG8_MMA(0, 1, At, B1); PG8_BAR; PG8_SCHED;
            PG8_LDA(At, 0, 1); PG8_STAGE(PG8_SB(0, 0), b2, voffB); PG8_STAGE(PG8_SB(0, 1), b2 + hstepB, voffB); PG8_STAGE(PG8_SA(0, 0), a2, voffA);
            PG8_WAIT_V(8); PG8_WAIT_L(0); PG8_BAR; PG8_MMA(1, 0, At, B0); PG8_MMA(1, 1, At, B1); PG8_BAR; PG8_SCHED;
            PG8_LDB(B0, 1, 0); PG8_LDB(B1, 1, 1); PG8_SCHED; PG8_LDA(At, 1, 0); PG8_STAGE(PG8_SA(0, 1), a2 + hstep, voffA);
            PG8_WAIT_V(8); PG8_WAIT_L(0); PG8_BAR; PG8_MMA(0, 0, At, B0); PG8_MMA(0, 1, At, B1); PG8_BAR; PG8_SCHED;
            PG8_LDA(At, 1, 1); PG8_STAGE(PG8_SB(1, 0), b3, voffB); PG8_STAGE(PG8_SB(1, 1), b3 + hstepB, voffB); PG8_STAGE(PG8_SA(1, 0), a3, voffA);
            PG8_WAIT_V(8); PG8_WAIT_L(0); PG8_BAR; PG8_MMA(1, 0, At, B0); PG8_MMA(1, 1, At, B1); PG8_BAR; PG8_SCHED;
            } else {
            PG8_LDB(B0, 0, 0); PG8_SCHED; PG8_LDA(At, 0, 0); PG8_STAGE(PG8_SA(1, 1), a1 + hstep, voffA);
            PG8_WAIT_L(8); PG8_BAR; PG8_WAIT_L(0); PG8_MMA(0, 0, At, B0); PG8_BAR; PG8_SCHED;
            PG8_LDB(B1, 0, 1); PG8_STAGE(PG8_SB(0, 0), b2, voffB);
            PG8_BAR; PG8_WAIT_L(0); PG8_MMA(0, 1, At, B1); PG8_BAR;
            PG8_LDA(At, 0, 1); PG8_STAGE(PG8_SA(0, 0), a2, voffA);
            PG8_BAR; PG8_WAIT_L(0); PG8_MMA(1, 0, At, B0); PG8_BAR; PG8_SCHED;
            PG8_STAGE(PG8_SB(0, 1), b2 + hstepB, voffB);
            PG8_WAIT_V(6); PG8_BAR; PG8_MMA(1, 1, At, B1); PG8_BAR;
            PG8_LDB(B0, 1, 0); PG8_SCHED; PG8_LDA(At, 1, 0); PG8_STAGE(PG8_SA(0, 1), a2 + hstep, voffA);
            PG8_WAIT_L(8); PG8_BAR; PG8_WAIT_L(0); PG8_MMA(0, 0, At, B0); PG8_BAR; PG8_SCHED;
            PG8_LDB(B1, 1, 1); PG8_STAGE(PG8_SB(1, 0), b3, voffB);
            PG8_BAR; PG8_WAIT_L(0); PG8_MMA(0, 1, At, B1); PG8_BAR;
            PG8_LDA(At, 1, 1); PG8_STAGE(PG8_SA(1, 0), a3, voffA);
            PG8_BAR; PG8_WAIT_L(0); PG8_MMA(1, 0, At, B0); PG8_BAR; PG8_SCHED;
            PG8_STAGE(PG8_SB(1, 1), b3 + hstepB, voffB);
            PG8_WAIT_V(6); PG8_BAR; PG8_MMA(1, 1, At, B1); PG8_BAR;
            }
        }
        if constexpr (ALIGN_EPI) { if (wr == 0) PG8_BAR; }
        if constexpr (!Epi::AFTER_DRAIN) { E(acc, cur, wr, wc, fr, fq); S.done(cur); }
        if (!has_next) break;
        if constexpr (Epi::MIDK) E.pre(nxt, wr, fr, tid);
#pragma unroll
        for (int a = 0; a < 2; ++a)
#pragma unroll
            for (int b = 0; b < 2; ++b)
#pragma unroll
                for (int m = 0; m < 4; ++m)
#pragma unroll
                    for (int n = 0; n < 2; ++n) acc[a][b][m][n] = (f32x4){0.f, 0.f, 0.f, 0.f};
        cur = nxt; cA = nA; cB = nB; ++ui;
        if constexpr (ALIGN_EPI) { if (wr == 1) PG8_BAR; }
    }
    PG8_WAIT_V(0);
    if constexpr (!ALIGN_EPI) { if (wr == 0) PG8_BAR; }
    PG8_BAR;
    if constexpr (Epi::AFTER_DRAIN) { E.fused(acc, cur, wr, wc, fr, fq, lds, wid, lane); S.done(cur); }
#undef PG8_SA
#undef PG8_SB
#undef PG8_STAGE
#undef PG8_LDA
#undef PG8_LDB
#undef PG8_MMA
#undef PG8_WAIT_V
#undef PG8_WAIT_L
#undef PG8_BAR
#undef PG8_SCHED
}
}

namespace attn {
typedef unsigned short bf16;
using bf16x8 = __attribute__((ext_vector_type(8))) short;
using s16x4  = __attribute__((ext_vector_type(4))) short;
using f32x16 = __attribute__((ext_vector_type(16))) float;
using u32x4  = __attribute__((ext_vector_type(4))) unsigned;
constexpr int   D = 128, NW = 8, QBLK = 32, KVBLK = 64;
constexpr float SCALE = 0.088388347648318440f;
constexpr float THR = 8.f;
constexpr int SDEPTH = 2;
constexpr int LDQ = 128, LDK = 128, LDO = 2048;
constexpr size_t SHM_V = KVBLK * D * 2, SHM_K = KVBLK * D * 2, SHM_ATTN = 4 * SHM_V + 4 * SHM_K;
#define LAS3 __attribute__((address_space(3)))
#define KSWZ(row, colB) ((row) * 256 + ((colB) ^ (((row) & 7) << 4)))
#define SBAR() __builtin_amdgcn_sched_barrier(0)
__device__ __forceinline__ int crow(int r, int hi) { return (r & 3) + 8 * (r >> 2) + 4 * hi; }
__device__ __forceinline__ unsigned cvtpk(float lo, float hi) {
  unsigned r; asm volatile("v_cvt_pk_bf16_f32 %0, %1, %2" : "=v"(r) : "v"(lo), "v"(hi)); return r;
}
__device__ __forceinline__ bf16x8 ld8(const bf16* p) { return *reinterpret_cast<const bf16x8*>(p); }

__device__ __forceinline__ void partialSM(f32x16& p0, f32x16& p1, float& m_reg, float& mn, float& alpha) {
  constexpr float C = SCALE * 1.4426950408889634f;
  float pmax = p0[0]; for (int r = 1; r < 16; ++r) pmax = fmaxf(pmax, p0[r]); for (int r = 0; r < 16; ++r) pmax = fmaxf(pmax, p1[r]);
  { auto rr = __builtin_amdgcn_permlane32_swap(__float_as_uint(pmax), __float_as_uint(pmax), false, false);
    pmax = fmaxf(__uint_as_float(rr[0]), __uint_as_float(rr[1])); }
  if (__builtin_expect(__all(pmax - m_reg <= THR / SCALE), 1)) { mn = m_reg; alpha = 1.f; }
  else { mn = fmaxf(m_reg, pmax); alpha = __builtin_amdgcn_exp2f((m_reg - mn) * C); m_reg = mn; }
  float mnC = -mn * C;
  for (int r = 0; r < 16; ++r) p0[r] = fmaf(p0[r], C, mnC); for (int r = 0; r < 16; ++r) p1[r] = fmaf(p1[r], C, mnC);
  for (int r = 0; r < 16; ++r) p0[r] = __builtin_amdgcn_exp2f(p0[r]);
}
__device__ __forceinline__ void finishSM(f32x16& p0, f32x16& p1, float alpha, float& l_reg, bf16x8& pa0, bf16x8& pa1, bf16x8& pa2, bf16x8& pa3) {
  for (int r = 0; r < 16; ++r) p1[r] = __builtin_amdgcn_exp2f(p1[r]);
  float ps = 0; for (int r = 0; r < 16; ++r) ps += p0[r]; for (int r = 0; r < 16; ++r) ps += p1[r];
  { auto rr = __builtin_amdgcn_permlane32_swap(__float_as_uint(ps), __float_as_uint(ps), false, false);
    ps = __uint_as_float(rr[0]) + __uint_as_float(rr[1]); }
  l_reg = l_reg * alpha + ps;
#define PK4(P, BASE, OUT) do { unsigned a0 = cvtpk(P[BASE + 0], P[BASE + 1]), a1 = cvtpk(P[BASE + 2], P[BASE + 3]);   \
    unsigned b0 = cvtpk(P[BASE + 4], P[BASE + 5]), b1 = cvtpk(P[BASE + 6], P[BASE + 7]);                              \
    auto r0 = __builtin_amdgcn_permlane32_swap(a0, b0, false, false); auto r1 = __builtin_amdgcn_permlane32_swap(a1, b1, false, false); \
    u32x4 w = {r0[0], r1[0], r0[1], r1[1]}; OUT = *reinterpret_cast<bf16x8*>(&w); } while (0)
  PK4(p0, 0, pa0); PK4(p0, 8, pa1); PK4(p1, 0, pa2); PK4(p1, 8, pa3);
#undef PK4
}
__device__ __forceinline__ float amax3(float a, float b, float c) { float r; asm("v_max3_f32 %0, %1, %2, %3" : "=v"(r) : "v"(a), "v"(b), "v"(c)); return r; }
__device__ __forceinline__ float amax2(float a, float b) { float r; asm("v_max_f32 %0, %1, %2" : "=v"(r) : "v"(a), "v"(b)); return r; }
constexpr float THR2 = 11.541560327111707f;
__device__ __forceinline__ void softmax_step(f32x16& p0, f32x16& p1, f32x16& mt, bool first, float& alpha, float& l_reg, bf16x8& pa0, bf16x8& pa1, bf16x8& pa2, bf16x8& pa3) {
  float mc[4];
#pragma unroll
  for (int k = 0; k < 4; ++k) { float m = amax3(p0[k], p0[k + 4], p0[k + 8]); m = amax3(m, p0[k + 12], p1[k]); m = amax3(m, p1[k + 4], p1[k + 8]); mc[k] = amax2(m, p1[k + 12]); }
  float pmax = amax2(amax3(mc[0], mc[1], mc[2]), mc[3]);
  { auto rr = __builtin_amdgcn_permlane32_swap(__float_as_uint(pmax), __float_as_uint(pmax), false, false);
    pmax = amax2(__uint_as_float(rr[0]), __uint_as_float(rr[1])); }
  alpha = 1.f;
  if (__builtin_expect(first || !__all(pmax <= THR2), 0)) {
    const float delta = first ? pmax : fmaxf(pmax, 0.f);
    alpha = first ? 1.f : __builtin_amdgcn_exp2f(-delta);
    for (int r = 0; r < 16; ++r) { p0[r] -= delta; p1[r] -= delta; mt[r] -= delta; }
  }
  for (int r = 0; r < 16; ++r) p0[r] = __builtin_amdgcn_exp2f(p0[r]);
  for (int r = 0; r < 16; ++r) p1[r] = __builtin_amdgcn_exp2f(p1[r]);
  float s0 = p0[0] + p0[4], s1 = p0[1] + p0[5], s2 = p0[2] + p0[6], s3 = p0[3] + p0[7];
  s0 += p0[8]; s1 += p0[9]; s2 += p0[10]; s3 += p0[11]; s0 += p0[12]; s1 += p0[13]; s2 += p0[14]; s3 += p0[15];
  s0 += p1[0]; s1 += p1[1]; s2 += p1[2]; s3 += p1[3]; s0 += p1[4]; s1 += p1[5]; s2 += p1[6]; s3 += p1[7];
  s0 += p1[8]; s1 += p1[9]; s2 += p1[10]; s3 += p1[11]; s0 += p1[12]; s1 += p1[13]; s2 += p1[14]; s3 += p1[15];
  float ps = (s0 + s1) + (s2 + s3);
  { auto rr = __builtin_amdgcn_permlane32_swap(__float_as_uint(ps), __float_as_uint(ps), false, false);
    ps = __uint_as_float(rr[0]) + __uint_as_float(rr[1]); }
  l_reg = l_reg * alpha + ps;
#define PK4(P, BASE, OUT) do { unsigned a0 = cvtpk(P[BASE + 0], P[BASE + 1]), a1 = cvtpk(P[BASE + 2], P[BASE + 3]);   \
    unsigned b0 = cvtpk(P[BASE + 4], P[BASE + 5]), b1 = cvtpk(P[BASE + 6], P[BASE + 7]);                              \
    auto r0 = __builtin_amdgcn_permlane32_swap(a0, b0, false, false); auto r1 = __builtin_amdgcn_permlane32_swap(a1, b1, false, false); \
    u32x4 w = {r0[0], r1[0], r0[1], r1[1]}; OUT = *reinterpret_cast<bf16x8*>(&w); } while (0)
  PK4(p0, 0, pa0); PK4(p0, 8, pa1); PK4(p1, 0, pa2); PK4(p1, 8, pa3);
#undef PK4
}
template <int OFF> __device__ __forceinline__ bf16x8 kread(int a) { bf16x8 r; asm volatile("ds_read_b128 %0, %1 offset:%2" : "=&v"(r) : "v"(a), "i"(OFF) : "memory"); return r; }
#define KWAIT(N, X, Y) asm volatile("s_waitcnt lgkmcnt(" #N ")" : "+v"(X), "+v"(Y) :: "memory")
#define QM(X, D0) do { p0 = __builtin_amdgcn_mfma_f32_32x32x16_bf16(X##0, qr[D0], p0, 0, 0, 0); p1 = __builtin_amdgcn_mfma_f32_32x32x16_bf16(X##1, qr[D0], p1, 0, 0, 0); } while (0)
#define QKT_ISSUE2() bf16x8 a0 = kread<0>(ka[0]), a1 = kread<8192>(ka[0]); bf16x8 b0 = kread<0>(ka[1]), b1 = kread<8192>(ka[1])
#define QKT_REST() do { \
  KWAIT(2, a0, a1); p0 = __builtin_amdgcn_mfma_f32_32x32x16_bf16(a0, qr[0], mt, 0, 0, 0); p1 = __builtin_amdgcn_mfma_f32_32x32x16_bf16(a1, qr[0], mt, 0, 0, 0); \
  bf16x8 c0 = kread<0>(ka[2]), c1 = kread<8192>(ka[2]); \
  KWAIT(2, b0, b1); QM(b, 1); \
  a0 = kread<0>(ka[3]); a1 = kread<8192>(ka[3]); \
  KWAIT(2, c0, c1); QM(c, 2); \
  b0 = kread<128>(ka[0]); b1 = kread<8320>(ka[0]); \
  KWAIT(2, a0, a1); QM(a, 3); \
  c0 = kread<128>(ka[1]); c1 = kread<8320>(ka[1]); \
  KWAIT(2, b0, b1); QM(b, 4); \
  a0 = kread<128>(ka[2]); a1 = kread<8320>(ka[2]); \
  KWAIT(2, c0, c1); QM(c, 5); \
  b0 = kread<128>(ka[3]); b1 = kread<8320>(ka[3]); \
  KWAIT(2, a0, a1); QM(a, 6); \
  KWAIT(0, b0, b1); QM(b, 7); } while (0)
__device__ __forceinline__ void qkt(f32x16& p0, f32x16& p1, const int (&ka)[4], const bf16x8* qr, const f32x16& mt) {
  QKT_ISSUE2(); QKT_REST();
}
__device__ __forceinline__ int v_st(int k, int c) { const int kk = (k & ~0xC) | ((k & 4) << 1) | ((k & 8) >> 1); return ((kk >> 3) * 4 + (c >> 5)) * 512 + ((kk & 7) * 32 + (c & 31)) * 2; }
__device__ __forceinline__ int v_rd_base(int lane) { return ((lane & 3) << 3) | (((lane >> 2) & 3) << 6) | (((lane >> 4) & 1) << 5) | (((lane >> 5) & 1) << 8); }
constexpr int v_rd_off(int d0, int ks, int half) { return d0 * 512 + ks * 4096 + half * 2048; }
template <int OFF> __device__ __forceinline__ s16x4 tr_read(int vb) {
  s16x4 r; asm volatile("ds_read_b64_tr_b16 %0, %1 offset:%2" : "=&v"(r) : "v"(vb), "i"(OFF) : "memory"); return r;
}
#define TRSET(S, D0) do { S##0 = tr_read<v_rd_off(D0, 0, 0)>(vb); S##1 = tr_read<v_rd_off(D0, 0, 1)>(vb); S##2 = tr_read<v_rd_off(D0, 1, 0)>(vb); S##3 = tr_read<v_rd_off(D0, 1, 1)>(vb); \
    S##4 = tr_read<v_rd_off(D0, 2, 0)>(vb); S##5 = tr_read<v_rd_off(D0, 2, 1)>(vb); S##6 = tr_read<v_rd_off(D0, 3, 0)>(vb); S##7 = tr_read<v_rd_off(D0, 3, 1)>(vb); } while (0)
#define TWAIT(N, S) asm volatile("s_waitcnt lgkmcnt(" #N ")" : "+v"(S##0), "+v"(S##1), "+v"(S##2), "+v"(S##3), "+v"(S##4), "+v"(S##5), "+v"(S##6), "+v"(S##7) :: "memory")
#define PK(L, H) (bf16x8){L[0], L[1], L[2], L[3], H[0], H[1], H[2], H[3]}
#define PVM(OD, S) do { OD = __builtin_amdgcn_mfma_f32_32x32x16_bf16(pa0, PK(S##0, S##1), OD, 0, 0, 0); OD = __builtin_amdgcn_mfma_f32_32x32x16_bf16(pa1, PK(S##2, S##3), OD, 0, 0, 0); \
    OD = __builtin_amdgcn_mfma_f32_32x32x16_bf16(pa2, PK(S##4, S##5), OD, 0, 0, 0); OD = __builtin_amdgcn_mfma_f32_32x32x16_bf16(pa3, PK(S##6, S##7), OD, 0, 0, 0); } while (0)
struct TrPre { s16x4 a0, a1, a2, a3, a4, a5, a6, a7, b0, b1, b2, b3, b4, b5, b6, b7; };
__device__ __forceinline__ TrPre pv_head(int vb) {
  s16x4 a0, a1, a2, a3, a4, a5, a6, a7, b0, b1, b2, b3, b4, b5, b6, b7;
  TRSET(a, 0); TRSET(b, 1);
  return TrPre{a0, a1, a2, a3, a4, a5, a6, a7, b0, b1, b2, b3, b4, b5, b6, b7};
}
__device__ __forceinline__ void pv_d0(f32x16* o, int vb, bf16x8 pa0, bf16x8 pa1, bf16x8 pa2, bf16x8 pa3, const TrPre& h) {
  s16x4 a0 = h.a0, a1 = h.a1, a2 = h.a2, a3 = h.a3, a4 = h.a4, a5 = h.a5, a6 = h.a6, a7 = h.a7, b0 = h.b0, b1 = h.b1, b2 = h.b2, b3 = h.b3, b4 = h.b4, b5 = h.b5, b6 = h.b6, b7 = h.b7;
  TWAIT(8, a); PVM(o[0], a);
  TRSET(a, 2);
  TWAIT(8, b); PVM(o[1], b);
  TRSET(b, 3);
  TWAIT(8, a); PVM(o[2], a);
  TWAIT(0, b); PVM(o[3], b);
}
__device__ __forceinline__ void mstep(f32x16* o, int vb, bf16x8 pa0, bf16x8 pa1, bf16x8 pa2, bf16x8 pa3, const TrPre& h, f32x16& p0, f32x16& p1, const int (&ka)[4], const bf16x8* qr, const f32x16& mt) {
  s16x4 u0 = h.a0, u1 = h.a1, u2 = h.a2, u3 = h.a3, u4 = h.a4, u5 = h.a5, u6 = h.a6, u7 = h.a7, w0 = h.b0, w1 = h.b1, w2 = h.b2, w3 = h.b3, w4 = h.b4, w5 = h.b5, w6 = h.b6, w7 = h.b7;
#define TDONE(S) asm volatile("" : "+v"(S##0), "+v"(S##1), "+v"(S##2), "+v"(S##3), "+v"(S##4), "+v"(S##5), "+v"(S##6), "+v"(S##7) :: "memory")
  bf16x8 a0 = kread<0>(ka[0]), a1 = kread<8192>(ka[0]);
  bf16x8 b0 = kread<0>(ka[1]), b1 = kread<8192>(ka[1]);
  TWAIT(12, u); PVM(o[0], u);
  TRSET(u, 2);
  KWAIT(10, a0, a1); TDONE(w);
  p0 = __builtin_amdgcn_mfma_f32_32x32x16_bf16(a0, qr[0], mt, 0, 0, 0); p1 = __builtin_amdgcn_mfma_f32_32x32x16_bf16(a1, qr[0], mt, 0, 0, 0);
  bf16x8 c0 = kread<0>(ka[2]), c1 = kread<8192>(ka[2]);
  KWAIT(10, b0, b1); QM(b, 1);
  a0 = kread<0>(ka[3]); a1 = kread<8192>(ka[3]);
  PVM(o[1], w);
  TRSET(w, 3);
  KWAIT(10, c0, c1); TDONE(u);
  QM(c, 2);
  b0 = kread<128>(ka[0]); b1 = kread<8320>(ka[0]);
  KWAIT(10, a0, a1); QM(a, 3);
  c0 = kread<128>(ka[1]); c1 = kread<8320>(ka[1]);
  PVM(o[2], u);
  KWAIT(2, b0, b1); TDONE(w);
  QM(b, 4);
  a0 = kread<128>(ka[2]); a1 = kread<8320>(ka[2]);
  KWAIT(2, c0, c1); QM(c, 5);
  b0 = kread<128>(ka[3]); b1 = kread<8320>(ka[3]);
  PVM(o[3], w);
  KWAIT(2, a0, a1); QM(a, 6);
  KWAIT(0, b0, b1); QM(b, 7);
#undef TDONE
}
#undef TRSET
#undef TWAIT
#undef PK
#undef PVM

__device__ __forceinline__ void attn_dense_body(const bf16* __restrict__ Qb, const bf16* __restrict__ Kh, const bf16* __restrict__ Vh,
                                                bf16* __restrict__ Ob, const float* __restrict__ gain, float* __restrict__ rsa, int seq, char* lds, char* scratch, int wave_id) {
  unsigned z_ = 0u; asm volatile("" : "+v"(z_)); const int lane_ = (int)__builtin_amdgcn_mbcnt_hi(~0u, __builtin_amdgcn_mbcnt_lo(~0u, z_));
    const int wid = wave_id, lane = lane_, tid = wid * 64 + lane, r32 = lane & 31, hi = lane >> 5;
  bf16* V_lds = (bf16*)lds; bf16* K_lds = (bf16*)(lds + 4 * SHM_V);
  float* ws = (float*)scratch + wid * 64; float* li_l = ws; float* al_l = ws + 32;
  float l_reg = 0; f32x16 o[4] = {}; f32x16 mt = {}; bf16x8 qr[8];
  const bf16* Qw = Qb + (long)(wid * QBLK + r32) * LDQ + hi * 8;
#pragma unroll
  for (int d0 = 0; d0 < 8; ++d0) qr[d0] = ld8(Qw + d0 * 16);
  const int vb0 = (int)(uintptr_t)V_lds + v_rd_base(lane);
  int kb4[4];
#pragma unroll
  for (int q = 0; q < 4; ++q) kb4[q] = (int)(uintptr_t)K_lds + r32 * 256 + ((32 * q + 16 * hi) ^ ((r32 & 7) << 4));
#define KADDR(b) do { _Pragma("unroll") for (int q_ = 0; q_ < 4; ++q_) ka[q_] = kb4[q_] + (b) * (int)SHM_K; } while (0)
  int ka[4];
  unsigned gk[2], gv[2];
#pragma unroll
  for (int i = 0; i < 2; ++i) { const int blk = 2 * wid + i, row = blk * 4 + (lane >> 4); gk[i] = (unsigned)(row * 256 + (((lane & 15) ^ (row & 7)) << 4));
    const int st = blk * 2 + (lane >> 5), kk = (st >> 2) * 8 + ((lane >> 2) & 7), key = (kk & ~0xC) | ((kk & 4) << 1) | ((kk & 8) >> 1); gv[i] = (unsigned)(key * 256 + ((st & 3) * 32 + (lane & 3) * 8) * 2); }
  const unsigned ldsV = (unsigned)(uintptr_t)V_lds + (unsigned)wid * 2048u, ldsK = (unsigned)(uintptr_t)K_lds + (unsigned)wid * 2048u;
#define DMA(b, t) do { const char* kg_ = (const char*)Kh + (size_t)(t) * (KVBLK * LDK * 2); const char* vg_ = (const char*)Vh + (size_t)(t) * (KVBLK * LDK * 2); \
    _Pragma("unroll") for (int i_ = 0; i_ < 2; ++i_) { \
      __builtin_amdgcn_global_load_lds((const unsigned*)(kg_ + gk[i_]), (LAS3 unsigned*)(uintptr_t)(ldsK + (unsigned)(b) * (unsigned)SHM_K + i_ * 1024u), 16, 0, 0); \
      __builtin_amdgcn_global_load_lds((const unsigned*)(vg_ + gv[i_]), (LAS3 unsigned*)(uintptr_t)(ldsV + (unsigned)(b) * (unsigned)SHM_V + i_ * 1024u), 16, 0, 0); } } while (0)
#define LANDED() do { asm volatile("s_waitcnt vmcnt(0)" ::: "memory"); __builtin_amdgcn_s_barrier(); asm volatile("" ::: "memory"); } while (0)
#define RESC(a) do { if (__any((a) < 1.f)) { if (hi == 0) al_l[r32] = (a); asm volatile("s_waitcnt lgkmcnt(0)" ::: "memory"); \
    for (int d = 0; d < 4; ++d) for (int r = 0; r < 16; ++r) o[d][r] *= al_l[crow(r, hi)]; } } while (0)
  f32x16 p0, p1; float al; bf16x8 pa0, pa1, pa2, pa3; const int NT = seq / KVBLK;
  DMA(0, 0); DMA(1, 1); DMA(2, 2); DMA(3, 3);
  asm volatile("s_waitcnt vmcnt(12)" ::: "memory"); SBAR(); __builtin_amdgcn_s_barrier(); SBAR();
#define BARP() do { SBAR(); asm volatile("" ::: "memory"); __builtin_amdgcn_s_barrier(); asm volatile("" ::: "memory"); SBAR(); } while (0)
#define BARD(t) do { SBAR(); if ((t) == 0) asm volatile("s_waitcnt vmcnt(8)" ::: "memory"); else if ((t) + 2 < NT) asm volatile("s_waitcnt vmcnt(4)" ::: "memory"); else asm volatile("s_waitcnt vmcnt(0)" ::: "memory"); \
    __builtin_amdgcn_s_barrier(); asm volatile("" ::: "memory"); SBAR(); } while (0)
#define SSTEP(first) do { softmax_step(p0, p1, mt, first, al, l_reg, pa0, pa1, pa2, pa3); RESC(al); } while (0)
  if (wid < 4) {
    KADDR(0); qkt(p0, p1, ka, qr, mt);
    BARP();
    for (int t = 0; t + 1 < NT; ++t) {
      if (t >= 2 && t + 2 < NT) DMA((t + 2) & 3, t + 2);
      SSTEP(t == 0);
      const TrPre h = pv_head(vb0 + (t & 3) * (int)SHM_V);
      BARD(t);
      KADDR((t + 1) & 3); mstep(o, vb0 + (t & 3) * (int)SHM_V, pa0, pa1, pa2, pa3, h, p0, p1, ka, qr, mt);
      BARP();
    }
    SSTEP(false); { const TrPre h = pv_head(vb0 + ((NT - 1) & 3) * (int)SHM_V); BARD(NT - 1);
    pv_d0(o, vb0 + ((NT - 1) & 3) * (int)SHM_V, pa0, pa1, pa2, pa3, h); }
  } else {
    BARP();
    TrPre h = pv_head(vb0);
    for (int t = 0; t < NT; ++t) {
      KADDR(t & 3);
      if (t > 0) mstep(o, vb0 + ((t - 1) & 3) * (int)SHM_V, pa0, pa1, pa2, pa3, h, p0, p1, ka, qr, mt); else qkt(p0, p1, ka, qr, mt);
      BARD(t);
      if (t >= 1 && t + 3 < NT) DMA((t + 3) & 3, t + 3);
      SSTEP(t == 0);
      h = pv_head(vb0 + (t & 3) * (int)SHM_V);
      if (t + 1 < NT) BARP();
    }
    pv_d0(o, vb0 + ((NT - 1) & 3) * (int)SHM_V, pa0, pa1, pa2, pa3, h);
  }
#undef BARP
#undef BARD
#undef SSTEP
  if (hi == 0) li_l[r32] = l_reg; asm volatile("s_waitcnt lgkmcnt(0)" ::: "memory");
  float rli[16];
#pragma unroll
  for (int r = 0; r < 16; ++r) rli[r] = __builtin_amdgcn_rcpf(li_l[crow(r, hi)]);
  bf16* Ow = Ob + (long)(wid * QBLK) * LDO; float* rw = rsa + wid * QBLK * 8;
  float gq[4];
#pragma unroll
  for (int d0 = 0; d0 < 4; ++d0) gq[d0] = gain[d0 * 32 + r32];
  const bool odd = (lane & 1) != 0; float srow = 0.f;
#pragma unroll
  for (int r = 0; r < 16; r += 2) { float ss0 = 0.f, ss1 = 0.f;
#pragma unroll
    for (int d0 = 0; d0 < 4; ++d0) { const float v0 = o[d0][r] * rli[r], v1 = o[d0][r + 1] * rli[r + 1]; ss0 += v0 * v0; ss1 += v1 * v1;
      const float g0 = v0 * gq[d0], g1 = v1 * gq[d0]; const float recv = __shfl_xor(odd ? g0 : g1, 1);
      const unsigned w = odd ? cvtpk(recv, g1) : cvtpk(g0, recv);
      *(unsigned*)(Ow + (long)crow(odd ? r + 1 : r, hi) * LDO + d0 * 32 + (r32 & ~1)) = w; }
#pragma unroll
    for (int sft = 1; sft < 32; sft <<= 1) { ss0 += __shfl_xor(ss0, sft); ss1 += __shfl_xor(ss1, sft); }
    srow = (r32 == r) ? ss0 : srow; srow = (r32 == r + 1) ? ss1 : srow; }
  if (r32 < 16) rw[crow(r32, hi) * 8] = srow;
#undef DMA
#undef LANDED
#undef RESC
#undef KADDR
}
#undef KSWZ
#undef SBAR
}

constexpr int NWAVES = 8;
constexpr int DM = 2048, NB = 4, SEQ = 4096, CTX = 256, NL = 4;
constexpr int HD = 128, NH = 8, NKV = 2, AW = 1024, KVW = 256, CW = 1024, INW = 4608, FF = 8192;
constexpr int ML = NB * SEQ, MC = NB * CTX, MT = ML + MC;
constexpr int SKV = SEQ + CTX;
constexpr int MODW = 6 * DM;
constexpr float EPS = 1e-6f;
constexpr int C_Q = 0, C_K = 1024, C_V = 1280, C_GB = 1536, C_GC = 2560, C_U = 3584, C_Z = 2560;

constexpr size_t MiB = 1u << 20;
constexpr size_t WS_CTL = 0, CTL_ZERO_BYTES = 64 * 1024;
constexpr size_t WS_MOD = 1 * MiB;
constexpr size_t WS_XC = 2 * MiB;
constexpr size_t WS_W = 16 * MiB;
constexpr size_t W_IN_E = (size_t)INW * DM, W_OUT_E = (size_t)DM * DM, W_1_E = (size_t)FF * DM, W_2_E = (size_t)DM * FF, W_LAYER_E = W_IN_E + W_OUT_E + W_1_E + W_2_E;
constexpr size_t WS_H = WS_W + NL * W_LAYER_E * 2 + 8 * MiB;
constexpr size_t WS_BIG = WS_H + (size_t)MT * DM * 2 + 4 * MiB;
constexpr size_t BIG_QKV = 0, BIG_Q = 156 * MiB, BIG_K = 192 * MiB, BIG_V = 202 * MiB;
constexpr size_t WS_MRG = WS_BIG + (size_t)MT * FF * 2 + 4 * MiB;
constexpr size_t WS_AO = WS_MRG + (size_t)MT * DM * 2 + 4 * MiB;
constexpr size_t WS_PART = WS_AO + (size_t)MT * AW * 4 + 4 * MiB;
constexpr size_t WS_END = WS_PART + (size_t)8 * MC * DM * 4 + 4 * MiB;
static_assert((size_t)MT * INW * 2 <= BIG_Q && BIG_Q + (size_t)MT * AW * 2 <= BIG_K && BIG_K + (size_t)NB * NKV * SKV * HD * 2 <= BIG_V && BIG_V + (size_t)NB * NKV * SKV * HD * 2 <= (size_t)MT * FF * 2, "overlay map");
static_assert((size_t)NL * 5 * MODW * 4 <= 1 * MiB && WS_XC + (size_t)MC * DM * 4 <= WS_W, "small map");
constexpr int CW_BAR = 4096;
constexpr size_t WS_RSA = 11 * MiB;
static_assert(WS_RSA >= WS_XC + (size_t)MC * DM * 4 && WS_RSA + (size_t)MT * 8 * 4 <= WS_W && (CW_BAR + 3456) * 4 <= (int)CTL_ZERO_BYTES, "CTL / RSA map");

constexpr int RING_OFF = 0, RING_BYTES = 131072;
constexpr int ROPE_OFF = RING_BYTES;
constexpr int MISC_OFF = ROPE_OFF + 16384;
constexpr int STASH_OFF = MISC_OFF + 256;
constexpr int LDS_BYTES = STASH_OFF + NWAVES * 64 * 16;

#define GAS __attribute__((address_space(1)))
#define LAS __attribute__((address_space(3)))
typedef unsigned short bf16;
typedef unsigned v4u __attribute__((ext_vector_type(4)));
typedef unsigned v2u __attribute__((ext_vector_type(2)));
typedef float f32x4 __attribute__((ext_vector_type(4)));
typedef float f32x2 __attribute__((ext_vector_type(2)));
#define LDS_WAIT() asm volatile("s_waitcnt lgkmcnt(0)" ::: "memory")
__device__ __forceinline__ unsigned pk2(float lo, float hi) { unsigned r; asm volatile("v_cvt_pk_bf16_f32 %0, %1, %2" : "=v"(r) : "v"(lo), "v"(hi)); return r; }
__device__ __forceinline__ float bflo(unsigned w) { return __builtin_bit_cast(float, w << 16); }
__device__ __forceinline__ float bfhi(unsigned w) { return __builtin_bit_cast(float, w & 0xffff0000u); }
__device__ __forceinline__ float wave_sum(float v) {
#pragma unroll
    for (int o = 1; o < 64; o <<= 1) v += __shfl_xor(v, o);
    return v;
}
__device__ __forceinline__ void ld16(const bf16* p, float (&x)[16]) {
    const v4u a = *(const v4u*)p, b = *(const v4u*)(p + 8);
    x[0] = bflo(a.x); x[1] = bfhi(a.x); x[2] = bflo(a.y); x[3] = bfhi(a.y); x[4] = bflo(a.z); x[5] = bfhi(a.z); x[6] = bflo(a.w); x[7] = bfhi(a.w);
    x[8] = bflo(b.x); x[9] = bfhi(b.x); x[10] = bflo(b.y); x[11] = bfhi(b.y); x[12] = bflo(b.z); x[13] = bfhi(b.z); x[14] = bflo(b.w); x[15] = bfhi(b.w);
}
struct Raw16 { v4u a, b; };
__device__ __forceinline__ Raw16 ldraw16(const bf16* p) { Raw16 r; r.a = *(const v4u*)p; r.b = *(const v4u*)(p + 8); return r; }
__device__ __forceinline__ void unpack16(const Raw16& r, float (&x)[16]) {
    x[0] = bflo(r.a.x); x[1] = bfhi(r.a.x); x[2] = bflo(r.a.y); x[3] = bfhi(r.a.y); x[4] = bflo(r.a.z); x[5] = bfhi(r.a.z); x[6] = bflo(r.a.w); x[7] = bfhi(r.a.w);
    x[8] = bflo(r.b.x); x[9] = bfhi(r.b.x); x[10] = bflo(r.b.y); x[11] = bfhi(r.b.y); x[12] = bflo(r.b.z); x[13] = bfhi(r.b.z); x[14] = bflo(r.b.w); x[15] = bfhi(r.b.w);
}
__device__ __forceinline__ void st16(bf16* p, const float (&x)[16]) {
    v4u a, b; a.x = pk2(x[0], x[1]); a.y = pk2(x[2], x[3]); a.z = pk2(x[4], x[5]); a.w = pk2(x[6], x[7]);
    b.x = pk2(x[8], x[9]); b.y = pk2(x[10], x[11]); b.z = pk2(x[12], x[13]); b.w = pk2(x[14], x[15]);
    *(v4u*)p = a; *(v4u*)(p + 8) = b;
}
__device__ __forceinline__ void ld16f(const float* p, float (&x)[16]) {
#pragma unroll
    for (int i = 0; i < 4; ++i) { const f32x4 v = *(const f32x4*)(p + 4 * i); x[4 * i] = v.x; x[4 * i + 1] = v.y; x[4 * i + 2] = v.z; x[4 * i + 3] = v.w; }
}
#define XB_TMO      128
#define XB_XCNT(j)  (256  + 64 * (j))
#define XB_XSUB(j)  (1280 + 64 * (j))
#define XB_XGEN(j)  (2304 + 64 * (j))
#define XB_TOP      3328
#define XB_TOPGEN   3392
#define XCD_BAR_WORDS 3456
#define XB_SPIN_CAP (1u << 18)

__device__ __forceinline__ unsigned xb_ld(unsigned* p)              { return __hip_atomic_load(p, __ATOMIC_RELAXED, __HIP_MEMORY_SCOPE_AGENT); }
__device__ __forceinline__ unsigned xb_add(unsigned* p, unsigned v) { return __hip_atomic_fetch_add(p, v, __ATOMIC_RELAXED, __HIP_MEMORY_SCOPE_AGENT); }
__device__ __forceinline__ unsigned xb_xcc_id() { return (unsigned)__builtin_amdgcn_s_getreg((3 << 11) | 20) & 0xFu; }
#define XB_SPIN(cond, bar) do { unsigned _sp = 0; while (cond) { __builtin_amdgcn_s_sleep(1); \
    if ((++_sp & 255u) == 0u) { if (xb_ld(&(bar)[XB_TMO])) break; if (_sp > XB_SPIN_CAP) { atomicAdd(&(bar)[XB_TMO], 1u); break; } } } } while (0)

struct XcdBarrier {
    unsigned* bar; unsigned x;
    volatile LAS unsigned* st;
};

__device__ __forceinline__ XcdBarrier xcd_barrier_post(unsigned* bar, volatile LAS unsigned* st, bool leader) {
    XcdBarrier b; b.bar = bar; b.x = xb_xcc_id(); b.st = st;
    if (leader) (void)xb_add(&bar[XB_XCNT(b.x)], 1u);
    return b;
}
__device__ __forceinline__ void xcd_barrier_complete(unsigned* bar, unsigned x, unsigned& nloc, unsigned& nx) {
    const unsigned G = gridDim.x * gridDim.y * gridDim.z;
    unsigned sum, cnt, mine, sp = 0u;
    for (;;) {
        sum = 0u; cnt = 0u; mine = 0u;
#pragma unroll
        for (unsigned j = 0; j < 16; ++j) { const unsigned c = xb_ld(&bar[XB_XCNT(j)]); sum += c; cnt += (c > 0u) ? 1u : 0u; mine = (j == x) ? c : mine; }
        if (sum == G) break;
        __builtin_amdgcn_s_sleep(1);
        if ((++sp & 255u) == 0u) { if (xb_ld(&bar[XB_TMO])) break; if (sp > XB_SPIN_CAP) { atomicAdd(&bar[XB_TMO], 1u); break; } }
    }
    nloc = mine > 0u ? mine : 1u; nx = cnt > 0u ? cnt : 1u;
}

__device__ __forceinline__ void xcd_barrier(const XcdBarrier& b, bool leader) {
    asm volatile("s_waitcnt vmcnt(0)" ::: "memory");
    __syncthreads();
    if (leader) {
        unsigned* bar = b.bar;
        __builtin_amdgcn_s_waitcnt(0);
        unsigned nloc = b.st[0], nx = b.st[1];
        if (nloc == 0u) { xcd_barrier_complete(bar, b.x, nloc, nx); b.st[0] = nloc; b.st[1] = nx; }
        const unsigned old = xb_add(&bar[XB_XSUB(b.x)], 1u);
        const unsigned gen = old / nloc;
        if (old + 1u == (gen + 1u) * nloc) {
            __builtin_amdgcn_fence(__ATOMIC_RELEASE, "agent");
            asm volatile("s_waitcnt vmcnt(0)" ::: "memory");
            const unsigned og = xb_add(&bar[XB_TOP], 1u);
            const unsigned tg = og / nx;
            if (og + 1u == (tg + 1u) * nx) xb_add(&bar[XB_TOPGEN], 1u);
            else XB_SPIN(xb_ld(&bar[XB_TOPGEN]) == tg, bar);
            __builtin_amdgcn_fence(__ATOMIC_ACQUIRE, "agent");
            xb_add(&bar[XB_XGEN(b.x)], 1u);
            asm volatile("s_waitcnt vmcnt(0)" ::: "memory");
        } else {
            XB_SPIN(xb_ld(&bar[XB_XGEN(b.x)]) == gen, bar);
            __builtin_amdgcn_fence(__ATOMIC_ACQUIRE, "agent");
            asm volatile("s_waitcnt vmcnt(0)" ::: "memory");
        }
    }
    __syncthreads();
}


__device__ __forceinline__ void p0_transpose_item(const float* W, int K, int N, bf16* WT, LAS float* scr, int item, int lane, bool zperm = false) {
    const int nblk = N / 32, kb = item / nblk, nb = item % nblk, k0 = 64 * kb, n0 = 32 * nb;
    int nd0 = n0; if (zperm && n0 >= C_GC) { const int isu = n0 >= C_U, g = n0 - (isu ? C_U : C_GC); nd0 = C_GC + 256 * (g >> 7) + 64 * ((g >> 5) & 3) + 32 * isu + (g & 31); }
    {
        f32x4 t[8]; const int rr = lane >> 3, c4 = 4 * (lane & 7);
#pragma unroll
        for (int i = 0; i < 8; ++i) t[i] = *(const f32x4*)(W + (size_t)(k0 + rr + 8 * i) * N + n0 + c4);
        asm volatile("" ::: "memory");
#pragma unroll
        for (int i = 0; i < 8; ++i) { LAS float* d = scr + (rr + 8 * i) * 33 + c4; d[0] = t[i].x; d[1] = t[i].y; d[2] = t[i].z; d[3] = t[i].w; }
    }
    LDS_WAIT(); asm volatile("" ::: "memory");
    const int c = lane & 7;
#pragma unroll
    for (int j = 0; j < 4; ++j) { const int n = (lane >> 3) + 8 * j; const LAS float* s = scr + (8 * c) * 33 + n;
        v4u o; o.x = pk2(s[0 * 33], s[1 * 33]); o.y = pk2(s[2 * 33], s[3 * 33]); o.z = pk2(s[4 * 33], s[5 * 33]); o.w = pk2(s[6 * 33], s[7 * 33]);
        *(GAS v4u*)(WT + (size_t)(nd0 + n) * K + k0 + 8 * c) = o; }
    LDS_WAIT(); asm volatile("" ::: "memory");
}

__device__ __forceinline__ void adaln_item(const float* __restrict__ w_ada, const float* __restrict__ b_ada, float* __restrict__ mod, LAS float* sil, LAS float* red, int item, int tid, int wave, int lane) {
    const int l = item / 192, n0 = (item % 192) * 64, g = lane >> 4, c4 = lane & 15;
    const float* wp = w_ada + ((size_t)l * DM + wave * 256 + g) * MODW + n0 + 4 * c4;
    f32x4 acc[5];
#pragma unroll
    for (int r = 0; r < 5; ++r) acc[r] = (f32x4){0.f, 0.f, 0.f, 0.f};
    const LAS float* sp = sil + wave * 256 + g;
#pragma unroll 1
    for (int i0 = 0; i0 < 64; i0 += 8) {
        const float* wq = wp + (size_t)(4 * i0) * MODW;
        f32x4 wv[8];
#pragma unroll
        for (int i = 0; i < 8; ++i) wv[i] = *(const f32x4*)(wq + (size_t)(4 * i) * MODW);
        asm volatile("" ::: "memory");
#pragma unroll
        for (int i = 0; i < 8; ++i)
#pragma unroll
            for (int r = 0; r < 5; ++r) { const float s = sp[r * DM + 4 * (i0 + i)]; acc[r] = acc[r] + wv[i] * s; }
    }
#pragma unroll
    for (int r = 0; r < 5; ++r)
#pragma unroll
        for (int e = 0; e < 4; ++e) { float v = acc[r][e]; v += __shfl_xor(v, 16); v += __shfl_xor(v, 32); acc[r][e] = v; }
    if (g == 0) {
#pragma unroll
        for (int r = 0; r < 5; ++r) *(LAS f32x4*)(red + (wave * 5 + r) * 64 + 4 * c4) = acc[r];
    }
    __syncthreads();
    if (tid < 320) { const int r = tid >> 6, cc = tid & 63; float s = b_ada[(size_t)l * MODW + n0 + cc];
#pragma unroll
        for (int w = 0; w < 8; ++w) s += red[(w * 5 + r) * 64 + cc];
        mod[((size_t)l * 5 + r) * MODW + n0 + cc] = s; }
    __syncthreads();
}

__device__ __forceinline__ void norm_mod_rows(const float* __restrict__ x, bf16* __restrict__ out, int nrows, const float* __restrict__ gain, const float* __restrict__ sh, const float* __restrict__ sc, int lane) {
    asm volatile("" : "+v"(lane));
    f32x4 a[8], bb[8];
    {
        f32x4 sv[8];
#pragma unroll
        for (int j = 0; j < 8; ++j) { a[j] = *(const f32x4*)(gain + 4 * lane + 256 * j); sv[j] = *(const f32x4*)(sc + 4 * lane + 256 * j); bb[j] = *(const f32x4*)(sh + 4 * lane + 256 * j); }
        asm volatile("" ::: "memory");
#pragma unroll
        for (int j = 0; j < 8; ++j) a[j] = a[j] * (sv[j] + 1.0f);
    }
    int i = 0;
    for (; i + 1 < nrows; i += 2) {
        const f32x4* xr0 = (const f32x4*)(x + (size_t)i * DM) + lane; const f32x4* xr1 = xr0 + DM / 4;
        f32x4 v0[8], v1[8]; float s0 = 0.f, s1 = 0.f;
#pragma unroll
        for (int j = 0; j < 8; ++j) { v0[j] = xr0[64 * j]; v1[j] = xr1[64 * j]; }
#pragma unroll
        for (int j = 0; j < 8; ++j) { s0 += (v0[j].x * v0[j].x + v0[j].y * v0[j].y) + (v0[j].z * v0[j].z + v0[j].w * v0[j].w); s1 += (v1[j].x * v1[j].x + v1[j].y * v1[j].y) + (v1[j].z * v1[j].z + v1[j].w * v1[j].w); }
        const float r0 = 1.0f / sqrtf(wave_sum(s0) * (1.f / DM) + EPS), r1 = 1.0f / sqrtf(wave_sum(s1) * (1.f / DM) + EPS);
        v2u* o0 = (v2u*)(out + (size_t)i * DM) + lane; v2u* o1 = o0 + DM / 4;
#pragma unroll
        for (int j = 0; j < 8; ++j) { const f32x4 y0 = v0[j] * r0 * a[j] + bb[j], y1 = v1[j] * r1 * a[j] + bb[j]; v2u w0, w1; w0.x = pk2(y0.x, y0.y); w0.y = pk2(y0.z, y0.w); w1.x = pk2(y1.x, y1.y); w1.y = pk2(y1.z, y1.w); o0[64 * j] = w0; o1[64 * j] = w1; }
    }
    for (; i < nrows; ++i) {
        const f32x4* xr = (const f32x4*)(x + (size_t)i * DM) + lane;
        f32x4 v[8]; float ss = 0.f;
#pragma unroll
        for (int j = 0; j < 8; ++j) { v[j] = xr[64 * j]; ss += (v[j].x * v[j].x + v[j].y * v[j].y) + (v[j].z * v[j].z + v[j].w * v[j].w); }
        const float rstd = 1.0f / sqrtf(wave_sum(ss) * (1.f / DM) + EPS);
        v2u* o8 = (v2u*)(out + (size_t)i * DM) + lane;
#pragma unroll
        for (int j = 0; j < 8; ++j) { const f32x4 y = v[j] * rstd * a[j] + bb[j]; v2u w; w.x = pk2(y.x, y.y); w.y = pk2(y.z, y.w); o8[64 * j] = w; }
    }
}
__device__ __forceinline__ void norm_mod_rows_b(const bf16* __restrict__ x, bf16* __restrict__ out, int nrows, const float* __restrict__ gain, const float* __restrict__ sh, const float* __restrict__ sc, int lane) {
    asm volatile("" : "+v"(lane));
    f32x4 a[4][2], bb[4][2];
    {
        f32x4 sv[4][2];
#pragma unroll
        for (int j = 0; j < 4; ++j)
#pragma unroll
            for (int h = 0; h < 2; ++h) { const int e = 8 * lane + 512 * j + 4 * h; a[j][h] = *(const f32x4*)(gain + e); sv[j][h] = *(const f32x4*)(sc + e); bb[j][h] = *(const f32x4*)(sh + e); }
        asm volatile("" ::: "memory");
#pragma unroll
        for (int j = 0; j < 4; ++j)
#pragma unroll
            for (int h = 0; h < 2; ++h) a[j][h] = a[j][h] * (sv[j][h] + 1.0f);
    }
    for (int i = 0; i < nrows; i += 4) {
        v4u raw[4][4]; float ss[4];
#pragma unroll
        for (int r = 0; r < 4; ++r)
#pragma unroll
            for (int j = 0; j < 4; ++j) raw[r][j] = *(const v4u*)(x + (size_t)(i + r) * DM + 8 * lane + 512 * j);
        asm volatile("" ::: "memory");
#pragma unroll
        for (int r = 0; r < 4; ++r) { float s = 0.f;
#pragma unroll
            for (int j = 0; j < 4; ++j) { const v4u w = raw[r][j];
                const float x0 = bflo(w.x), x1 = bfhi(w.x), x2 = bflo(w.y), x3 = bfhi(w.y), x4 = bflo(w.z), x5 = bfhi(w.z), x6 = bflo(w.w), x7 = bfhi(w.w);
                s += ((x0 * x0 + x1 * x1) + (x2 * x2 + x3 * x3)) + ((x4 * x4 + x5 * x5) + (x6 * x6 + x7 * x7)); }
            ss[r] = s; }
#pragma unroll
        for (int r = 0; r < 4; ++r) ss[r] = 1.0f / sqrtf(wave_sum(ss[r]) * (1.f / DM) + EPS);
#pragma unroll
        for (int r = 0; r < 4; ++r)
#pragma unroll
            for (int j = 0; j < 4; ++j) { const v4u w = raw[r][j];
                f32x4 x0, x1; x0.x = bflo(w.x); x0.y = bfhi(w.x); x0.z = bflo(w.y); x0.w = bfhi(w.y); x1.x = bflo(w.z); x1.y = bfhi(w.z); x1.z = bflo(w.w); x1.w = bfhi(w.w);
                const f32x4 y0 = x0 * ss[r] * a[j][0] + bb[j][0], y1 = x1 * ss[r] * a[j][1] + bb[j][1];
                v4u o; o.x = pk2(y0.x, y0.y); o.y = pk2(y0.z, y0.w); o.z = pk2(y1.x, y1.y); o.w = pk2(y1.z, y1.w);
                *(v4u*)(out + (size_t)(i + r) * DM + 8 * lane + 512 * j) = o; }
    }
}
__device__ __forceinline__ void ctx_fix_norm_row(const float* __restrict__ xin, const bf16* __restrict__ part, const float* __restrict__ gate, const float* __restrict__ rsa_row, float* __restrict__ xout, bf16* __restrict__ out,
                                                 const float* __restrict__ gain, const float* __restrict__ sh, const float* __restrict__ sc, int lane) {
    asm volatile("" : "+v"(lane));
    f32x4 v[4][2]; float ss = 0.f; float ra = 1.0f;
    if (rsa_row) { const f32x4 q0 = *(const f32x4*)rsa_row, q1 = *(const f32x4*)(rsa_row + 4); ra = 1.0f / sqrtf((((q0.x + q0.y) + (q0.z + q0.w)) + ((q1.x + q1.y) + (q1.z + q1.w))) * (1.f / AW) + EPS); }
    if (part) {
#pragma unroll
        for (int j0 = 0; j0 < 4; j0 += 2) {
            v4u pp[2][8];
#pragma unroll
            for (int jj = 0; jj < 2; ++jj) { const int e = 8 * lane + 512 * (j0 + jj); v[j0 + jj][0] = *(const f32x4*)(xin + e); v[j0 + jj][1] = *(const f32x4*)(xin + e + 4);
#pragma unroll
                for (int ks = 0; ks < 8; ++ks) pp[jj][ks] = *(const v4u*)(part + (size_t)ks * MC * DM + e); }
            asm volatile("" ::: "memory");
#pragma unroll
            for (int jj = 0; jj < 2; ++jj) { const int j = j0 + jj, e = 8 * lane + 512 * j;
                f32x4 q[8][2];
#pragma unroll
                for (int ks = 0; ks < 8; ++ks) { const v4u w = pp[jj][ks]; q[ks][0].x = bflo(w.x); q[ks][0].y = bfhi(w.x); q[ks][0].z = bflo(w.y); q[ks][0].w = bfhi(w.y); q[ks][1].x = bflo(w.z); q[ks][1].y = bfhi(w.z); q[ks][1].z = bflo(w.w); q[ks][1].w = bfhi(w.w); }
#pragma unroll
                for (int h = 0; h < 2; ++h) {
                    const f32x4 pa = (q[0][h] + q[1][h]) + (q[2][h] + q[3][h]), pc = (q[4][h] + q[5][h]) + (q[6][h] + q[7][h]);
                    v[j][h] = v[j][h] + *(const f32x4*)(gate + e + 4 * h) * (pa * ra + pc);
                    *(f32x4*)(xout + e + 4 * h) = v[j][h]; } }
            asm volatile("" ::: "memory");
        }
    } else {
#pragma unroll
        for (int j = 0; j < 4; ++j) { const int e = 8 * lane + 512 * j; v[j][0] = *(const f32x4*)(xin + e); v[j][1] = *(const f32x4*)(xin + e + 4); }
    }
#pragma unroll
    for (int j = 0; j < 4; ++j)
#pragma unroll
        for (int h = 0; h < 2; ++h) ss += (v[j][h].x * v[j][h].x + v[j][h].y * v[j][h].y) + (v[j][h].z * v[j][h].z + v[j][h].w * v[j][h].w);
    const float rstd = 1.0f / sqrtf(wave_sum(ss) * (1.f / DM) + EPS);
#pragma unroll
    for (int j = 0; j < 4; ++j) { const int e = 8 * lane + 512 * j; f32x4 y[2];
#pragma unroll
        for (int h = 0; h < 2; ++h) { const f32x4 g = *(const f32x4*)(gain + e + 4 * h), sv = *(const f32x4*)(sc + e + 4 * h), b = *(const f32x4*)(sh + e + 4 * h); y[h] = v[j][h] * rstd * (g * (sv + 1.0f)) + b; }
        v4u w; w.x = pk2(y[0].x, y[0].y); w.y = pk2(y[0].z, y[0].w); w.z = pk2(y[1].x, y[1].y); w.w = pk2(y[1].z, y[1].w);
        *(v4u*)(out + e) = w; }
}
__device__ __forceinline__ void norm_mod_phase(const float* xlat, const bf16* xlat_b, const float* xctx, float* xcout, const bf16* part, const float* cgate, const float* rsa_ctx, bool do_ctx, bf16* H, const float* gain, const float* modl, int shc, int scc, int bid, int G, int wave, int lane) {
    for (int c = bid; c < 256; c += G) {
        { const int r = c >> 6, row0 = 64 * c + 8 * wave;
          if (xlat_b) norm_mod_rows_b(xlat_b + (size_t)row0 * DM, H + (size_t)row0 * DM, 8, gain, modl + (size_t)r * MODW + shc * DM, modl + (size_t)r * MODW + scc * DM, lane);
          else norm_mod_rows(xlat + (size_t)row0 * DM, H + (size_t)row0 * DM, 8, gain, modl + (size_t)r * MODW + shc * DM, modl + (size_t)r * MODW + scc * DM, lane); }
        if (wave < 4 && do_ctx) { const int row = 4 * c + wave;
          ctx_fix_norm_row(xctx + (size_t)row * DM, part ? part + (size_t)row * DM : nullptr, cgate, rsa_ctx ? rsa_ctx + (size_t)row * 8 : nullptr, xcout + (size_t)row * DM, H + (size_t)(ML + row) * DM, gain, modl + (size_t)4 * MODW + shc * DM, modl + (size_t)4 * MODW + scc * DM, lane); }
    }
}

__device__ __forceinline__ void token_rows(const bf16* __restrict__ QKV, bf16* __restrict__ Ql, bf16* __restrict__ Qc, bf16* __restrict__ Kb, bf16* __restrict__ Vb, bf16* __restrict__ MRG,
                                           const float* __restrict__ qg_, const float* __restrict__ kg_, const float* __restrict__ cw, const float* __restrict__ cb, const float* __restrict__ cg_,
                                           const LAS f32x2* rope, int b, int t0, int n, bool latent, int lane) {
    const int seq_len = latent ? SEQ : CTX, rbase = latent ? b * SEQ : ML + b * CTX;
    const int j = lane & 7, h = lane >> 3;
    {
        float qg[16], kg[16];
        ld16f(qg_ + 16 * j, qg); ld16f(kg_ + 16 * j, kg);
#pragma unroll
        for (int e = 0; e < 16; ++e) qg[e] *= 0.12751743074602132f;
        const int l5 = lane & 31, isv = l5 >> 4, kvh = (l5 >> 3) & 1;
        const float sgn = (j & 2) ? 1.f : -1.f;
        const int qoff = C_Q + 128 * h + 16 * j, koff = C_K + 128 * kvh + 16 * j;
        Raw16 rq = ldraw16(QKV + (size_t)(rbase + t0) * INW + qoff), rk = ldraw16(QKV + (size_t)(rbase + t0) * INW + koff);
        for (int i = 0; i < n; ++i) {
            const int t = t0 + i;
            const Raw16 cq = rq, ck = rk;
            if (i + 1 < n) { const bf16* nsrc = QKV + (size_t)(rbase + t + 1) * INW; rq = ldraw16(nsrc + qoff); rk = ldraw16(nsrc + koff); }
            float cs[16], sn[16];
            if (latent) { const int pos = (j & 4) ? (t & 63) : (t >> 6); const LAS f32x2* tp = rope + pos * 32 + 16 * (j & 1);
#pragma unroll
                for (int e = 0; e < 16; ++e) { const f32x2 v = tp[e]; cs[e] = v.x; sn[e] = v.y; } }
            else {
#pragma unroll
                for (int e = 0; e < 16; ++e) { cs[e] = 1.f; sn[e] = 0.f; } }
            {
                float x[16]; unpack16(cq, x);
                float ss = 0.f;
#pragma unroll
                for (int e = 0; e < 16; ++e) ss += x[e] * x[e];
                ss += __shfl_xor(ss, 1); ss += __shfl_xor(ss, 2); ss += __shfl_xor(ss, 4);
                const float rstd = 1.0f / sqrtf(ss * (1.f / HD) + EPS);
#pragma unroll
                for (int e = 0; e < 16; ++e) x[e] = x[e] * rstd * qg[e];
                float y[16];
#pragma unroll
                for (int e = 0; e < 16; ++e) { const float p = __shfl_xor(x[e], 2); y[e] = x[e] * cs[e] + sgn * p * sn[e]; }
                bf16* dst = latent ? Ql + ((size_t)(b * NH + h) * SEQ + t) * HD + 16 * j : Qc + ((size_t)(b * NH + h) * CTX + t) * HD + 16 * j;
                st16(dst, y);
            }
            {
                float x[16]; unpack16(ck, x);
                float ss = 0.f;
#pragma unroll
                for (int e = 0; e < 16; ++e) ss += x[e] * x[e];
                ss += __shfl_xor(ss, 1); ss += __shfl_xor(ss, 2); ss += __shfl_xor(ss, 4);
                const float rstd = 1.0f / sqrtf(ss * (1.f / HD) + EPS);
                float y[16];
#pragma unroll
                for (int e = 0; e < 16; ++e) { const float xn = x[e] * rstd * kg[e]; const float p = __shfl_xor(xn, 2); const float kr = xn * cs[e] + sgn * p * sn[e]; y[e] = isv ? x[e] : kr; }
                const int pos = latent ? t : SEQ + t;
                bf16* dst = (isv ? Vb : Kb) + ((size_t)(b * NKV + kvh) * SKV + pos) * HD + 16 * j;
                if (lane < 16) st16(dst, y);
            }
        }
    }
    {
        const int ch = 16 * lane;
        float w0[16], w1[16], w2[16], bs[16], cg[16];
        ld16f(cw + ch, w0); ld16f(cw + CW + ch, w1); ld16f(cw + 2 * CW + ch, w2); ld16f(cb + ch, bs); ld16f(cg_ + ch, cg);
        float zp[16], zc[16], zn[16];
#define LOADZ(dst, tt) do { ld16(QKV + (size_t)(rbase + (tt)) * INW + C_Z + ch, dst); } while (0)
#define ZEROZ(dst) do { _Pragma("unroll") for (int e = 0; e < 16; ++e) dst[e] = 0.f; } while (0)
        if (t0 > 0) LOADZ(zp, t0 - 1); else ZEROZ(zp);
        LOADZ(zc, t0);
        const bf16* row0 = QKV + (size_t)(rbase + t0) * INW;
        Raw16 rgb = ldraw16(row0 + C_GB + ch), rz = rgb;
        if (t0 + 1 < seq_len) rz = ldraw16(row0 + INW + C_Z + ch);
        for (int i = 0; i < n; ++i) {
            const int t = t0 + i;
            const Raw16 cgb = rgb, cz = rz;
            if (i + 1 < n) { const bf16* nrow = QKV + (size_t)(rbase + t + 1) * INW; rgb = ldraw16(nrow + C_GB + ch);
                if (t + 2 < seq_len) rz = ldraw16(nrow + INW + C_Z + ch); }
            if (t + 1 < seq_len) unpack16(cz, zn);
            else ZEROZ(zn);
            float gb[16]; unpack16(cgb, gb);
            float y[16]; float ss = 0.f;
#pragma unroll
            for (int e = 0; e < 16; ++e) { const float cv = zp[e] * w0[e] + zc[e] * w1[e] + zn[e] * w2[e] + bs[e]; y[e] = gb[e] * cv; ss += y[e] * y[e]; }
            const float rstd = 1.0f / sqrtf(wave_sum(ss) * (1.f / CW) + EPS);
#pragma unroll
            for (int e = 0; e < 16; ++e) y[e] = y[e] * rstd * cg[e];
            st16(MRG + (size_t)(rbase + t) * DM + AW + ch, y);
#pragma unroll
            for (int e = 0; e < 16; ++e) { zp[e] = zc[e]; zc[e] = zn[e]; }
        }
#undef LOADZ
#undef ZEROZ
    }
}

__device__ __forceinline__ void attn_norm_rows(const float* __restrict__ ao, bf16* __restrict__ mrg, int nrows, const float* __restrict__ ag_, int lane) {
    f32x4 ag[4];
#pragma unroll
    for (int j = 0; j < 4; ++j) ag[j] = *(const f32x4*)(ag_ + 4 * lane + 256 * j);
    for (int i = 0; i < nrows; ++i) {
        const f32x4* xr = (const f32x4*)(ao + (size_t)i * AW) + lane;
        f32x4 v[4]; float ss = 0.f;
#pragma unroll
        for (int j = 0; j < 4; ++j) { v[j] = xr[64 * j]; ss += (v[j].x * v[j].x + v[j].y * v[j].y) + (v[j].z * v[j].z + v[j].w * v[j].w); }
        const float rstd = 1.0f / sqrtf(wave_sum(ss) * (1.f / AW) + EPS);
        v2u* o8 = (v2u*)(mrg + (size_t)i * DM) + lane;
#pragma unroll
        for (int j = 0; j < 4; ++j) { const f32x4 y = v[j] * rstd * ag[j]; v2u w; w.x = pk2(y.x, y.y); w.y = pk2(y.z, y.w); o8[64 * j] = w; }
    }
}

struct Args { const float* in[18]; float* out; unsigned char* ws; };
typedef const __attribute__((address_space(4))) Args* KArgs;
__device__ __forceinline__ int lane_id() { unsigned z = 0u; asm volatile("" : "+v"(z)); return (int)__builtin_amdgcn_mbcnt_hi(~0u, __builtin_amdgcn_mbcnt_lo(~0u, z)); }
__device__ __forceinline__ KArgs fresh_args() { KArgs p = (KArgs)__builtin_amdgcn_kernarg_segment_ptr(); asm volatile("" : "+s"(p)); return p; }
__device__ __forceinline__ int fresh_int(int v) { asm volatile("" : "+s"(v)); return v; }
#define BID() fresh_int((int)blockIdx.x)

struct Ptrs {
    const float *x_in, *c_in, *ctx_in, *cctx_in, *w_ada, *b_ada, *norm1_g, *w_in, *q_norm_g, *k_norm_g, *conv_w, *conv_b, *attn_out_g, *conv_out_g, *w_out, *norm2_g, *w_mlp_in, *w_mlp_out;
    float* out; float* MOD; float* XC; bf16* WT; bf16* H; bf16* HB; bf16* QKV; bf16* Qb; bf16* Qc; bf16* Kb; bf16* Vb; bf16* MRG; bf16* PART; float* RSA; unsigned* ctl; bf16* XB;
};
__device__ __forceinline__ Ptrs make_ptrs(KArgs a) {
    Ptrs p; unsigned char* ws = a->ws;
    p.x_in = a->in[0]; p.c_in = a->in[1]; p.ctx_in = a->in[2]; p.cctx_in = a->in[3]; p.w_ada = a->in[4]; p.b_ada = a->in[5]; p.norm1_g = a->in[6]; p.w_in = a->in[7];
    p.q_norm_g = a->in[8]; p.k_norm_g = a->in[9]; p.conv_w = a->in[10]; p.conv_b = a->in[11]; p.attn_out_g = a->in[12]; p.conv_out_g = a->in[13]; p.w_out = a->in[14]; p.norm2_g = a->in[15];
    p.w_mlp_in = a->in[16]; p.w_mlp_out = a->in[17]; p.out = a->out;
    p.MOD = (float*)(ws + WS_MOD); p.XC = (float*)(ws + WS_XC); p.WT = (bf16*)(ws + WS_W); p.H = (bf16*)(ws + WS_H);
    p.HB = (bf16*)(ws + WS_BIG); p.QKV = (bf16*)(ws + WS_BIG + BIG_QKV); p.Qb = (bf16*)(ws + WS_BIG + BIG_Q); p.Qc = p.Qb + (size_t)ML * AW;
    p.Kb = (bf16*)(ws + WS_BIG + BIG_K); p.Vb = (bf16*)(ws + WS_BIG + BIG_V); p.MRG = (bf16*)(ws + WS_MRG); p.PART = (bf16*)(ws + WS_PART); p.RSA = (float*)(ws + WS_RSA); p.ctl = (unsigned*)(ws + WS_CTL); p.XB = (bf16*)(ws + WS_AO);
    return p;
}

__device__ __forceinline__ void silu_table(const float* c_in, const float* cctx_in, LAS unsigned char* L, int tid) {
    LAS float* sil = (LAS float*)(L + RING_OFF);
    for (int idx = tid; idx < 5 * DM; idx += NWAVES * 64) { const int r = idx >> 11, k = idx & (DM - 1); const float v = (r < 4) ? c_in[r * DM + k] : cctx_in[k]; sil[idx] = v / (1.0f + __expf(-v)); }
    __syncthreads();
}
#define GRID_BAR() do { XcdBarrier b_; b_.bar = (unsigned*)(fresh_args()->ws + WS_CTL) + CW_BAR; b_.x = xb_xcc_id(); b_.st = (volatile LAS unsigned*)(L + MISC_OFF) + 8; xcd_barrier(b_, fresh_int(wave_s) == 0 && lane_id() == 0); } while (0)
__global__ void __launch_bounds__(NWAVES * 64, 2) fwd_kernel(Args args_unused) {
    extern __shared__ __attribute__((aligned(16))) unsigned char lds[];
    LAS unsigned char* L = (LAS unsigned char*)lds;
    const int wave_s = __builtin_amdgcn_readfirstlane((int)threadIdx.x >> 6);
    {
        volatile LAS unsigned* MISC = (volatile LAS unsigned*)(L + MISC_OFF);
        const int tid = (fresh_int(wave_s) * 64 + lane_id());
        for (int u = tid; u < 64; u += NWAVES * 64) MISC[u] = 0u;
        {
            LAS f32x2* rope = (LAS f32x2*)(L + ROPE_OFF);
            for (int idx = tid; idx < 2048; idx += NWAVES * 64) { const int pos = idx >> 5, i = idx & 31;
                const float f = exp2f(-(float)i * (13.287712379549449f / 32.f)); const float a = (float)pos * f;
                f32x2 v; v.x = __cosf(a); v.y = __sinf(a); rope[idx] = v; }
        }
        __syncthreads();
        const Ptrs P = make_ptrs(fresh_args());
        (void)xcd_barrier_post(P.ctl + CW_BAR, MISC + 8, tid == 0);
    }

    {
        const Ptrs P = make_ptrs(fresh_args()); const int tid = (fresh_int(wave_s) * 64 + lane_id()), lane = tid & 63, wave = __builtin_amdgcn_readfirstlane(tid >> 6), G = fresh_int((int)gridDim.x);
        LAS float* sil = (LAS float*)(L + RING_OFF); LAS float* red = sil + 5 * DM;
        silu_table(P.c_in, P.cctx_in, L, tid);
        if (G == 256) { for (int it = BID(); it < 192 + 8 * (NL - 1); it += G) adaln_item(P.w_ada, P.b_ada, P.MOD, sil, red, it < 192 ? it : (1 + (it - 192) / 8) * 192 + 184 + (it - 192) % 8, tid, wave, lane); }
        else { for (int it = BID(); it < NL * 192; it += G) adaln_item(P.w_ada, P.b_ada, P.MOD, sil, red, it, tid, wave, lane); }
        __syncthreads();
        LAS float* scr = (LAS float*)(L + RING_OFF + wave * 16384);
        constexpr int I_IN = (DM / 64) * (INW / 32), I_OUT = (DM / 64) * (DM / 32), I_1 = (DM / 64) * (FF / 32), I_2 = (FF / 64) * (DM / 32), I_LAYER = I_IN + I_OUT + I_1 + I_2;
        const int gw = BID() * NWAVES + wave, NGW = G * NWAVES;
        for (int it = gw; it < NL * I_LAYER; it += NGW) {
            const int l = it / I_LAYER; int r = it % I_LAYER; bf16* wl = P.WT + (size_t)l * W_LAYER_E;
            if (r < I_IN) { p0_transpose_item(P.w_in + (size_t)l * DM * INW, DM, INW, wl, scr, r, lane, true); continue; } r -= I_IN;
            if (r < I_OUT) { p0_transpose_item(P.w_out + (size_t)l * DM * DM, DM, DM, wl + W_IN_E, scr, r, lane); continue; } r -= I_OUT;
            if (r < I_1) { p0_transpose_item(P.w_mlp_in + (size_t)l * DM * FF, DM, FF, wl + W_IN_E + W_OUT_E, scr, r, lane); continue; } r -= I_1;
            p0_transpose_item(P.w_mlp_out + (size_t)l * FF * DM, FF, DM, wl + W_IN_E + W_OUT_E + W_1_E, scr, r, lane);
        }
    }
    GRID_BAR();

    for (int l = 0; l < NL; ++l) {
        {
            const Ptrs P = make_ptrs(fresh_args()); const int tid = (fresh_int(wave_s) * 64 + lane_id()), lane = tid & 63, wave = __builtin_amdgcn_readfirstlane(tid >> 6), G = fresh_int((int)gridDim.x);
            const float* xl_in = (l == 0) ? P.x_in : nullptr; const bf16* xl_b = (l == 0) ? nullptr : P.XB; const float* xc_in = (l == 0) ? P.ctx_in : P.XC;
            norm_mod_phase(xl_in, xl_b, xc_in, P.XC, (l == 0) ? nullptr : P.PART, P.MOD + (size_t)(l > 0 ? l - 1 : 0) * 5 * MODW + 4 * MODW + 5 * DM, nullptr, true, P.H, P.norm1_g + (size_t)l * DM, P.MOD + (size_t)l * 5 * MODW, 0, 1, BID(), G, wave, lane);
        }
        GRID_BAR();

        {
            const Ptrs P = make_ptrs(fresh_args()); const int G = fresh_int((int)gridDim.x);
            pg8::Gemm g{P.H, P.WT + (size_t)l * W_LAYER_E, MT, INW, DM}; pg8::StaticOrder S; S.init(MT, INW, DM, G, BID());
            pg8::EpiBf16<0, true> E{P.QKV, INW, P.Vb};
            pg8::gemm_phase<pg8::EpiBf16<0, true>, pg8::StaticOrder, true, true>(L + RING_OFF, g, S, E, fresh_int(wave_s));
            { const int rem = S.nwg % G, j = BID() - rem; if (l + 1 < NL && G == 256 && rem == 200 && j >= 0) { const int tid = (fresh_int(wave_s) * 64 + lane_id()), lane = tid & 63, wave = __builtin_amdgcn_readfirstlane(tid >> 6);
                silu_table(P.c_in, P.cctx_in, L, tid); adaln_item(P.w_ada, P.b_ada, P.MOD, (LAS float*)(L + RING_OFF), (LAS float*)(L + RING_OFF) + 5 * DM, (l + 1) * 192 + 128 + j, tid, wave, lane); } }
        }
        GRID_BAR();

        {
            const Ptrs P = make_ptrs(fresh_args()); const int tid = (fresh_int(wave_s) * 64 + lane_id()), lane = tid & 63, wave = __builtin_amdgcn_readfirstlane(tid >> 6), G = fresh_int((int)gridDim.x);
            const LAS f32x2* rope = (const LAS f32x2*)(L + ROPE_OFF);
            for (int c = BID(); c < 256; c += G) {
                const int b = c >> 6;
                token_rows(P.QKV, P.Qb, P.Qc, P.Kb, P.Vb, P.MRG, P.q_norm_g + l * HD, P.k_norm_g + l * HD, P.conv_w + (size_t)l * 3 * CW, P.conv_b + l * CW, P.conv_out_g + l * CW, rope, b, (c & 63) * 64 + 8 * wave, 8, true, lane);
                if (wave < 4) token_rows(P.QKV, P.Qb, P.Qc, P.Kb, P.Vb, P.MRG, P.q_norm_g + l * HD, P.k_norm_g + l * HD, P.conv_w + (size_t)l * 3 * CW, P.conv_b + l * CW, P.conv_out_g + l * CW, rope, b, (c & 63) * 4 + wave, 1, false, lane);
            }
        }
        GRID_BAR();

        {
            const Ptrs P = make_ptrs(fresh_args()); const int G = fresh_int((int)gridDim.x);
            const int nunits = (l == NL - 1) ? 512 : 544;
            for (int u = BID(); u < nunits; u += G) {
                const bf16 *q, *k, *v; bf16* o; float* rs; const float* gn; int seq;
                if (u < 512) { const int grp = u & 7, idx = u >> 3, b = grp >> 1, kv = grp & 1, h = kv * 4 + (idx >> 4), qb = idx & 15;
                    q = P.Qb + ((size_t)(b * NH + h) * SEQ + 256 * qb) * HD; k = P.Kb + (size_t)(b * NKV + kv) * SKV * HD; v = P.Vb + (size_t)(b * NKV + kv) * SKV * HD;
                    o = P.MRG + (size_t)(b * SEQ + 256 * qb) * DM + h * HD; rs = P.RSA + (size_t)(b * SEQ + 256 * qb) * 8 + h; gn = P.attn_out_g + l * AW + h * HD; seq = SKV; }
                else { const int cu = u - 512, b = cu >> 3, h = cu & 7, kv = h >> 2;
                    q = P.Qc + (size_t)(b * NH + h) * CTX * HD; k = P.Kb + ((size_t)(b * NKV + kv) * SKV + SEQ) * HD; v = P.Vb + ((size_t)(b * NKV + kv) * SKV + SEQ) * HD;
                    o = P.MRG + (size_t)(ML + b * CTX) * DM + h * HD; rs = P.RSA + (size_t)(ML + b * CTX) * 8 + h; gn = P.attn_out_g + l * AW + h * HD; seq = CTX; }
                attn::attn_dense_body(q, k, v, o, gn, rs, seq, (char*)lds + RING_OFF, (char*)lds + STASH_OFF, fresh_int(wave_s));
                __syncthreads();
            }
        }
        GRID_BAR();

        {
            const Ptrs P = make_ptrs(fresh_args()); const int G = fresh_int((int)gridDim.x); const int Mrows = (l == NL - 1) ? ML : MT;
            pg8::Gemm g{P.MRG, P.WT + (size_t)l * W_LAYER_E + W_IN_E, Mrows, DM, DM}; pg8::ResidOrder S; S.init(ML, DM, DM, G, BID(), l != NL - 1);
            pg8::EpiResid<true> E{(l == 0) ? P.x_in : nullptr, P.XB, nullptr, P.XB, P.MOD + (size_t)l * 5 * MODW + 2 * DM, MODW, P.PART, P.RSA, L + STASH_OFF};
            pg8::gemm_phase<pg8::EpiResid<true>, pg8::ResidOrder, true, true>(L + RING_OFF, g, S, E, fresh_int(wave_s));
        }
        GRID_BAR();

        {
            const Ptrs P = make_ptrs(fresh_args()); const int tid = (fresh_int(wave_s) * 64 + lane_id()), lane = tid & 63, wave = __builtin_amdgcn_readfirstlane(tid >> 6), G = fresh_int((int)gridDim.x);
            norm_mod_phase(nullptr, P.XB, (l == 0) ? P.ctx_in : P.XC, P.XC, P.PART, P.MOD + (size_t)l * 5 * MODW + 4 * MODW + 2 * DM, P.RSA + (size_t)ML * 8, l != NL - 1, P.H, P.norm2_g + (size_t)l * DM, P.MOD + (size_t)l * 5 * MODW, 3, 4, BID(), G, wave, lane);
        }
        GRID_BAR();

        {
            const Ptrs P = make_ptrs(fresh_args()); const int G = fresh_int((int)gridDim.x); const int Mrows = (l == NL - 1) ? ML : MT;
            pg8::Gemm g{P.H, P.WT + (size_t)l * W_LAYER_E + W_IN_E + W_OUT_E, Mrows, FF, DM}; pg8::StaticOrder S; S.init(Mrows, FF, DM, G, BID());
            pg8::EpiBf16<2> E{P.HB, FF, nullptr};
            pg8::gemm_phase<pg8::EpiBf16<2>, pg8::StaticOrder, true, true>(L + RING_OFF, g, S, E, fresh_int(wave_s));
            { const int rem = S.nwg % G, j = BID() - rem; if (l + 1 < NL && G == 256 && rem == 128 && j >= 0) { const int tid = (fresh_int(wave_s) * 64 + lane_id()), lane = tid & 63, wave = __builtin_amdgcn_readfirstlane(tid >> 6);
                silu_table(P.c_in, P.cctx_in, L, tid); adaln_item(P.w_ada, P.b_ada, P.MOD, (LAS float*)(L + RING_OFF), (LAS float*)(L + RING_OFF) + 5 * DM, (l + 1) * 192 + j, tid, wave, lane); } }
        }
        GRID_BAR();

        {
            const Ptrs P = make_ptrs(fresh_args()); const int G = fresh_int((int)gridDim.x); const int Mrows = (l == NL - 1) ? ML : MT;
            pg8::Gemm g{P.HB, P.WT + (size_t)l * W_LAYER_E + W_IN_E + W_OUT_E + W_1_E, Mrows, DM, FF}; pg8::ResidOrder S; S.init(ML, DM, FF, G, BID(), l != NL - 1);
            pg8::EpiResid<false> E{nullptr, P.XB, (l == NL - 1) ? P.out : nullptr, P.XB, P.MOD + (size_t)l * 5 * MODW + 5 * DM, MODW, P.PART, nullptr, L + STASH_OFF};
            pg8::gemm_phase<pg8::EpiResid<false>, pg8::ResidOrder, true, true>(L + RING_OFF, g, S, E, fresh_int(wave_s));
        }
        if (l != NL - 1) GRID_BAR();
    }
}

extern "C" void kernel_launch(void* const* d_in, const int* in_sizes, int n_in, void* d_out, int out_size, void* d_ws, size_t ws_size, hipStream_t stream) {
    static int grid = 0;
    if (grid == 0) {
        if (n_in != 18 || in_sizes[0] != ML * DM || out_size != ML * DM || ws_size < WS_END) {
            fprintf(stderr, "kernel_launch: shape mismatch: n_in %d in0 %d out %d ws %zu (need %zu)\n", n_in, n_in > 0 ? in_sizes[0] : -1, out_size, ws_size, (size_t)WS_END); grid = -1; return; }
        int dev = 0, cus = 0, per_cu = 0;
        if (hipGetDevice(&dev) != hipSuccess || hipDeviceGetAttribute(&cus, hipDeviceAttributeMultiprocessorCount, dev) != hipSuccess) { fprintf(stderr, "kernel_launch: device query failed\n"); grid = -1; return; }
        if (hipFuncSetAttribute((const void*)fwd_kernel, hipFuncAttributeMaxDynamicSharedMemorySize, LDS_BYTES) != hipSuccess) { fprintf(stderr, "kernel_launch: hipFuncSetAttribute failed\n"); grid = -1; return; }
        if (hipOccupancyMaxActiveBlocksPerMultiprocessor(&per_cu, (const void*)fwd_kernel, NWAVES * 64, LDS_BYTES) != hipSuccess || per_cu < 1)
            fprintf(stderr, "kernel_launch: note: occupancy query reports %d workgroups per CU\n", per_cu);
        (void)hipGetLastError();
        grid = cus < 256 ? (cus / 8) * 8 : 256;
        if (grid < 8) grid = cus;
    }
    if (grid < 0) return;
    if (hipMemsetAsync((char*)d_ws + WS_CTL, 0, CTL_ZERO_BYTES, stream) != hipSuccess) { fprintf(stderr, "kernel_launch: memset failed\n"); return; }
    Args a{};
    for (int i = 0; i < 18; ++i) a.in[i] = (const float*)d_in[i];
    a.out = (float*)d_out; a.ws = (unsigned char*)d_ws;
    hipLaunchKernelGGL(fwd_kernel, dim3(grid), dim3(NWAVES * 64), LDS_BYTES, stream, a);
    const hipError_t le = hipPeekAtLastError();
    if (le != hipSuccess) fprintf(stderr, "kernel_launch: launch failed: %s\n", hipGetErrorName(le));
}
```

```cpp
#include <hip/hip_runtime.h>
#include <cstdio>
#include <cstdint>
namespace pg8 {
#define PG8_LAS __attribute__((address_space(3)))
typedef unsigned short bf16_t;
typedef short bf16x8 __attribute__((ext_vector_type(8)));
typedef float f32x4 __attribute__((ext_vector_type(4)));
typedef unsigned u32x4 __attribute__((ext_vector_type(4)));
constexpr int BM = 256, BK = 64, HALF = 128, HTB = HALF * BK * 2  , STAGE_BYTES = 8 * HTB, NXCD = 8, WGM = 8;

__host__ __device__ __forceinline__ int lds_byte(int r, int c) { const int st = (r >> 4) * 2 + (c >> 5), rr = r & 15, cc = c & 31, ob = rr * 64 + cc * 2; return st * 1024 + (ob ^ (((ob >> 9) & 1) << 5)); }
__host__ __device__ __forceinline__ void stage_rc(int b, int& R, int& C) { const int st = b / 1024, sb = b % 1024, swz = sb ^ (((sb >> 9) & 1) << 5); R = (st >> 1) * 16 + swz / 64; C = (st & 1) * 32 + (swz % 64) / 2; }
__host__ __device__ __forceinline__ int perm32(int rho) { const int n = rho >> 4, i = rho & 15; return 8 * (i >> 2) + 4 * n + (i & 3); }

struct Unit { int pm, pn, k0, nt, kind; };
struct Gemm { const bf16_t* A; const bf16_t* Bt; int M, N, K; };

struct StaticOrder {
    int nM, nN, nwg, G, c, ntf, tr = 0;
    __host__ __device__ void init(int M, int N, int K, int G_, int c_) { nM = M / BM; nN = N / BM; nwg = nM * nN; G = G_; c = c_; ntf = K / BK; }
    __host__ __device__ bool next(int i, Unit& u) const {
        const long L = (long)i * G + c; if (L >= nwg) return false;
        int wgid = (int)L; { const int q = nwg / NXCD, r = nwg % NXCD, xcd = wgid % NXCD, off = wgid / NXCD; wgid = (xcd < r ? xcd * (q + 1) : r * (q + 1) + (xcd - r) * q) + off; }
        const int nig = WGM * nN, gid = wgid / nig, fm = gid * WGM, gsz = (nM - fm) < WGM ? (nM - fm) : WGM;
        const int idx = wgid % nig; if (tr) { u.pm = fm + idx / nN; u.pn = idx % nN; } else { u.pm = fm + (idx % gsz); u.pn = idx / gsz; } u.k0 = 0; u.nt = ntf; u.kind = 0; return true;
    }
    __device__ __forceinline__ void a_ready(const Unit&) const {}
    __device__ __forceinline__ void done(const Unit&) const {}
};

__device__ __forceinline__ unsigned cvt_pk_bf16(float lo, float hi) { unsigned r; asm volatile("v_cvt_pk_bf16_f32 %0, %1, %2" : "=v"(r) : "v"(lo), "v"(hi)); return r; }
typedef float f32x2 __attribute__((ext_vector_type(2)));


__device__ __forceinline__ float relu1(float x) { float r; asm("v_max_f32 %0, 0, %1" : "=v"(r) : "v"(x)); return r; }
#define PG8_PAIR_STORE(P, LDC, W0, W1) do { const u32x4 snd_ = hb ? (W0) : (W1); u32x4 rcv_; \
    rcv_.x = (unsigned)__builtin_amdgcn_mov_dpp((int)snd_.x, 0xB1, 0xF, 0xF, true); rcv_.y = (unsigned)__builtin_amdgcn_mov_dpp((int)snd_.y, 0xB1, 0xF, 0xF, true); \
    rcv_.z = (unsigned)__builtin_amdgcn_mov_dpp((int)snd_.z, 0xB1, 0xF, 0xF, true); rcv_.w = (unsigned)__builtin_amdgcn_mov_dpp((int)snd_.w, 0xB1, 0xF, 0xF, true); \
    *(u32x4*)(P) = hb ? rcv_ : (W0); *(u32x4*)((P) + (LDC)) = hb ? (W1) : rcv_; } while (0)
typedef unsigned v4u32_t __attribute__((__vector_size__(16)));
#define PG8_PAIR_STORE_BUF(RS, VOFF, SOFF, ROWB, W0, W1) do { const u32x4 snd_ = hb ? (W0) : (W1); u32x4 rcv_; \
    rcv_.x = (unsigned)__builtin_amdgcn_mov_dpp((int)snd_.x, 0xB1, 0xF, 0xF, true); rcv_.y = (unsigned)__builtin_amdgcn_mov_dpp((int)snd_.y, 0xB1, 0xF, 0xF, true); \
    rcv_.z = (unsigned)__builtin_amdgcn_mov_dpp((int)snd_.z, 0xB1, 0xF, 0xF, true); rcv_.w = (unsigned)__builtin_amdgcn_mov_dpp((int)snd_.w, 0xB1, 0xF, 0xF, true); \
    const u32x4 s1_ = hb ? rcv_ : (W0), s2_ = hb ? (W1) : rcv_; \
    __builtin_amdgcn_raw_buffer_store_b128(__builtin_bit_cast(v4u32_t, s1_), (RS), (VOFF), (SOFF), 0); \
    __builtin_amdgcn_raw_buffer_store_b128(__builtin_bit_cast(v4u32_t, s2_), (RS), (VOFF), (SOFF) + (ROWB), 0); } while (0)
template <int ACT, bool ZF = false> struct EpiBf16 {
    static constexpr bool PERM = true, AFTER_DRAIN = false, MIDK = false; static constexpr int MIDK_TILE = 0;
    __device__ __forceinline__ void mid(f32x4 (&)[2][2][4][2], const Unit&, int) const {}
    __device__ __forceinline__ void pre(const Unit&, int, int, int) const {}
    bf16_t* O; int ldc; bf16_t* V;
    __device__ __forceinline__ void operator()(const f32x4 (&acc)[2][2][4][2], const Unit& u, int wr, int wc, int fr, int fq) const {
        const int row0 = u.pm * BM + wr * 64 + fr; const int col0 = u.pn * BM + wc * 64 + 8 * fq;
        if constexpr (ZF) {
            if (u.pn == 5) {
                const int hb = fr & 1, b = u.pm < 64 ? (u.pm >> 4) : (u.pm - 64), pos0 = (u.pm < 64 ? (u.pm & 15) * BM : 4096) + wr * 64 + fr - hb;
                bf16_t* vbase = V + ((size_t)(b * 2 + (wc >> 1)) * 4352 + pos0) * 128 + (wc & 1) * 64 + 8 * fq + 32 * hb;
#pragma unroll
                for (int ai = 0; ai < 2; ++ai)
#pragma unroll
                    for (int m = 0; m < 4; ++m) { u32x4 w[2];
#pragma unroll
                        for (int bj = 0; bj < 2; ++bj) { const f32x4 v0 = acc[ai][bj][m][0], v1 = acc[ai][bj][m][1];
                            w[bj].x = cvt_pk_bf16(v0[0], v0[1]); w[bj].y = cvt_pk_bf16(v0[2], v0[3]); w[bj].z = cvt_pk_bf16(v1[0], v1[1]); w[bj].w = cvt_pk_bf16(v1[2], v1[3]); }
                        bf16_t* rp = vbase + (size_t)(ai * HALF + m * 16) * 128;
                        PG8_PAIR_STORE(rp, 128, w[0], w[1]); }
                return;
            }
            if (u.pn >= 10) {
                const int zc0 = 2560 + (u.pn - 10) * HALF + wc * 32 + 8 * fq;
#pragma unroll
                for (int ai = 0; ai < 2; ++ai)
#pragma unroll
                    for (int m = 0; m < 4; ++m) { const f32x4 v0 = acc[ai][0][m][0] * acc[ai][1][m][0], v1 = acc[ai][0][m][1] * acc[ai][1][m][1];
                        u32x4 w; w.x = cvt_pk_bf16(v0[0], v0[1]); w.y = cvt_pk_bf16(v0[2], v0[3]); w.z = cvt_pk_bf16(v1[0], v1[1]); w.w = cvt_pk_bf16(v1[2], v1[3]);
                        *(u32x4*)(O + (size_t)(row0 + ai * HALF + m * 16) * ldc + zc0) = w; }
                return;
            }
        }
        const int hb = fr & 1;
        const __amdgpu_buffer_rsrc_t rs = __builtin_amdgcn_make_buffer_rsrc((void*)O, 0, 0x7ffff000, 0x00020000);
        const int rowb = ldc * 2;
        const int voff = ((row0 - hb) * ldc + col0 + 32 * hb) * 2;
#pragma unroll
        for (int ai = 0; ai < 2; ++ai)
#pragma unroll
            for (int m = 0; m < 4; ++m) { u32x4 w[2];
#pragma unroll
                for (int bj = 0; bj < 2; ++bj) { f32x4 v0 = acc[ai][bj][m][0], v1 = acc[ai][bj][m][1];
                    if (ACT == 2) { _Pragma("unroll") for (int e_ = 0; e_ < 4; ++e_) { v0[e_] = relu1(v0[e_]); v1[e_] = relu1(v1[e_]); } v0 = v0 * v0; v1 = v1 * v1; }
                    w[bj].x = cvt_pk_bf16(v0[0], v0[1]); w[bj].y = cvt_pk_bf16(v0[2], v0[3]); w[bj].z = cvt_pk_bf16(v1[0], v1[1]); w[bj].w = cvt_pk_bf16(v1[2], v1[3]); }
                PG8_PAIR_STORE_BUF(rs, voff, (ai * HALF + m * 16) * rowb, rowb, w[0], w[1]); }
    }
};

template <bool MIDK_> struct EpiResid {
    static constexpr bool PERM = true, AFTER_DRAIN = false, MIDK = MIDK_; static constexpr int MIDK_TILE = 16;
    const float* xin_f; const bf16_t* xin_b; float* xout_f; bf16_t* xout_b; const float* gate; int gstride; bf16_t* part; const float* rsa; PG8_LAS unsigned char* stash;
    __device__ __forceinline__ void pre(const Unit& u, int wr, int fr, int tid) const {
        if constexpr (MIDK_) {
            typedef __fp16 h2 __attribute__((ext_vector_type(2)));
            const int row0 = (u.kind == 0 ? u.pm * BM : 0) + wr * 64 + fr; float t[8], f[8];
            {
                f32x4 q[8][2];
#pragma unroll
                for (int i = 0; i < 8; ++i) { const float* rp = rsa + (size_t)(row0 + (i >> 2) * HALF + (i & 3) * 16) * 8; q[i][0] = *(const f32x4*)rp; q[i][1] = *(const f32x4*)(rp + 4); }
                asm volatile("" ::: "memory");
#pragma unroll
                for (int i = 0; i < 8; ++i) t[i] = ((q[i][0][0] + q[i][0][1]) + (q[i][0][2] + q[i][0][3])) + ((q[i][1][0] + q[i][1][1]) + (q[i][1][2] + q[i][1][3]));
            }
#pragma unroll
            for (int i = 0; i < 8; ++i) f[i] = 1.0f / sqrtf(t[i] * (1.f / 1024.f) + 1e-6f);
            u32x4 w;
            w.x = __builtin_bit_cast(unsigned, __builtin_amdgcn_cvt_pkrtz(f[0], f[1])); w.y = __builtin_bit_cast(unsigned, __builtin_amdgcn_cvt_pkrtz(f[2], f[3]));
            w.z = __builtin_bit_cast(unsigned, __builtin_amdgcn_cvt_pkrtz(f[4], f[5])); w.w = __builtin_bit_cast(unsigned, __builtin_amdgcn_cvt_pkrtz(f[6], f[7]));
            *(PG8_LAS u32x4*)(stash + tid * 16) = w;
        }
    }
    __device__ __forceinline__ void mid(f32x4 (&acc)[2][2][4][2], const Unit& u, int tid) const {
        if (u.kind != 0) return;
        typedef _Float16 hf2 __attribute__((ext_vector_type(2)));
        const u32x4 w = *(const PG8_LAS u32x4*)(stash + tid * 16);
        const unsigned wq[4] = {w.x, w.y, w.z, w.w}; float f[8];
#pragma unroll
        for (int i = 0; i < 4; ++i) { const hf2 p = __builtin_bit_cast(hf2, wq[i]); f[2 * i] = (float)p[0]; f[2 * i + 1] = (float)p[1]; }
#pragma unroll
        for (int ai = 0; ai < 2; ++ai)
#pragma unroll
            for (int m = 0; m < 4; ++m)
#pragma unroll
                for (int bj = 0; bj < 2; ++bj)
#pragma unroll
                    for (int n = 0; n < 2; ++n) acc[ai][bj][m][n] = acc[ai][bj][m][n] * f[ai * 4 + m];
    }
    __device__ __forceinline__ void operator()(const f32x4 (&acc)[2][2][4][2], const Unit& u, int wr, int wc, int fr, int fq) const {
        int prow = (u.pm < 64 ? u.pm : u.pm - 64) * BM + wr * 64 + fr, col0 = u.pn * BM + wc * 64 + 8 * fq;
        asm volatile("" : "+v"(prow), "+v"(col0));
        const int hb = prow & 1;
        if (u.kind == 0) {
            const float* gp = gate + (size_t)(u.pm >> 4) * gstride + col0;
            f32x4 gv[2][2];
#pragma unroll
            for (int bj = 0; bj < 2; ++bj)
#pragma unroll
                for (int n = 0; n < 2; ++n) gv[bj][n] = *(const f32x4*)(gp + bj * 32 + n * 4);
            if (xin_f) {
#pragma unroll
                for (int am = 0; am < 4; ++am) { const int ai = am >> 1, mh = am & 1;
                    f32x4 xv[2][2][2];
#pragma unroll
                    for (int mm = 0; mm < 2; ++mm) { const size_t off = (size_t)(prow + ai * HALF + (2 * mh + mm) * 16) * 2048 + col0;
#pragma unroll
                        for (int bj = 0; bj < 2; ++bj)
#pragma unroll
                            for (int n = 0; n < 2; ++n) xv[mm][bj][n] = *(const f32x4*)(xin_f + off + bj * 32 + n * 4); }
                    asm volatile("" ::: "memory");
#pragma unroll
                    for (int mm = 0; mm < 2; ++mm) { const int m = 2 * mh + mm; const size_t off = (size_t)(prow + ai * HALF + m * 16) * 2048 + col0;
                        u32x4 w[2];
#pragma unroll
                        for (int bj = 0; bj < 2; ++bj) { const f32x4 v0 = xv[mm][bj][0] + gv[bj][0] * acc[ai][bj][m][0], v1 = xv[mm][bj][1] + gv[bj][1] * acc[ai][bj][m][1];
                            w[bj].x = cvt_pk_bf16(v0[0], v0[1]); w[bj].y = cvt_pk_bf16(v0[2], v0[3]); w[bj].z = cvt_pk_bf16(v1[0], v1[1]); w[bj].w = cvt_pk_bf16(v1[2], v1[3]); }
                        PG8_PAIR_STORE(xout_b + off - (size_t)hb * 2048 + 32 * hb, 2048, w[0], w[1]); }
                    asm volatile("" ::: "memory");
                }
            } else {
                const bool of = xout_f != nullptr;
#pragma unroll
                for (int ai = 0; ai < 2; ++ai) {
                    u32x4 raw[4][2];
#pragma unroll
                    for (int m = 0; m < 4; ++m) { const size_t off = (size_t)(prow + ai * HALF + m * 16) * 2048 + col0;
#pragma unroll
                        for (int bj = 0; bj < 2; ++bj) raw[m][bj] = *(const u32x4*)(xin_b + off + bj * 32); }
                    asm volatile("" ::: "memory");
#pragma unroll
                    for (int m = 0; m < 4; ++m) { const size_t off = (size_t)(prow + ai * HALF + m * 16) * 2048 + col0;
                        u32x4 w[2];
#pragma unroll
                        for (int bj = 0; bj < 2; ++bj) { const u32x4 rw = raw[m][bj];
                            f32x4 x0, x1;
                            x0[0] = __builtin_bit_cast(float, rw.x << 16); x0[1] = __builtin_bit_cast(float, rw.x & 0xffff0000u); x0[2] = __builtin_bit_cast(float, rw.y << 16); x0[3] = __builtin_bit_cast(float, rw.y & 0xffff0000u);
                            x1[0] = __builtin_bit_cast(float, rw.z << 16); x1[1] = __builtin_bit_cast(float, rw.z & 0xffff0000u); x1[2] = __builtin_bit_cast(float, rw.w << 16); x1[3] = __builtin_bit_cast(float, rw.w & 0xffff0000u);
                            const f32x4 v0 = x0 + gv[bj][0] * acc[ai][bj][m][0], v1 = x1 + gv[bj][1] * acc[ai][bj][m][1];
                            if (of) { PG8_PAIR_STORE(xout_f + off - (size_t)hb * 2048 + bj * 32 + 4 * hb, 2048, __builtin_bit_cast(u32x4, v0), __builtin_bit_cast(u32x4, v1)); }
                            else { w[bj].x = cvt_pk_bf16(v0[0], v0[1]); w[bj].y = cvt_pk_bf16(v0[2], v0[3]); w[bj].z = cvt_pk_bf16(v1[0], v1[1]); w[bj].w = cvt_pk_bf16(v1[2], v1[3]); } }
                        if (!of) PG8_PAIR_STORE(xout_b + off - (size_t)hb * 2048 + 32 * hb, 2048, w[0], w[1]); }
                    asm volatile("" ::: "memory");
                }
            }
        } else {
            bf16_t* po = part + (size_t)(u.kind - 1) * 1024 * 2048;
#pragma unroll
            for (int ai = 0; ai < 2; ++ai)
#pragma unroll
                for (int m = 0; m < 4; ++m) { const size_t off = (size_t)(prow + ai * HALF + m * 16) * 2048 + col0;
                    u32x4 w[2];
#pragma unroll
                    for (int bj = 0; bj < 2; ++bj) { const f32x4 v0 = acc[ai][bj][m][0], v1 = acc[ai][bj][m][1];
                        w[bj].x = cvt_pk_bf16(v0[0], v0[1]); w[bj].y = cvt_pk_bf16(v0[2], v0[3]); w[bj].z = cvt_pk_bf16(v1[0], v1[1]); w[bj].w = cvt_pk_bf16(v1[2], v1[3]); }
                    PG8_PAIR_STORE(po + off - (size_t)hb * 2048 + 32 * hb, 2048, w[0], w[1]); }
        }
    }
};

struct ResidOrder {
    StaticOrder lat; int has_ctx, kc, ntc;
    __device__ void init(int Mlat, int N, int K, int G, int c, int has_ctx_) { lat.init(Mlat, N, K, G, c); lat.tr = 1; has_ctx = has_ctx_; kc = K / 8; ntc = kc / BK; }
    __device__ bool next(int i, Unit& u) const {
        if (lat.next(i, u)) return true;
        if (!has_ctx) return false;
        const long L = (long)i * lat.G + lat.c; const int j = (int)(L - lat.nwg); if (j >= 256) return false;
        const int ks = j & 7; u.pn = (j >> 3) & 7; u.pm = lat.nM + (j >> 6); u.k0 = ks * kc; u.nt = ntc; u.kind = 1 + ks; return true;
    }
    __device__ __forceinline__ void a_ready(const Unit&) const {}
    __device__ __forceinline__ void done(const Unit&) const {}
};

template <class Epi, class Sched, bool ALIGN_EPI = false, bool SP2 = false>
__device__ __forceinline__ void gemm_phase(PG8_LAS unsigned char* lds, const Gemm g, const Sched& S, const Epi& E, int wave_id) {
    unsigned z_ = 0u; asm volatile("" : "+v"(z_)); const int lane_ = (int)__builtin_amdgcn_mbcnt_hi(~0u, __builtin_amdgcn_mbcnt_lo(~0u, z_));
    const int wid = wave_id, lane = lane_, tid = wid * 64 + lane, wr = wid >> 2, wc = wid & 3, fr = lane & 15, fq = lane >> 4;
    const int K = g.K;
    unsigned voffA[2], voffB[2];
#pragma unroll
    for (int i = 0; i < 2; ++i) { int R, C; stage_rc(tid * 16 + i * 8192, R, C); const int Rb = Epi::PERM ? (64 * (R >> 5) + perm32(R & 31)) : R;
        voffA[i] = (unsigned)(R * K + C) * 2u; voffB[i] = (unsigned)(Rb * K + C) * 2u; }
    const size_t kstep = (size_t)(BK * 2);
    const size_t hstep = (size_t)HALF * K * 2;
    const size_t hstepB = Epi::PERM ? (size_t)32 * K * 2 : hstep;
    const size_t tstep = 2 * hstep;
    const unsigned ldsw = (unsigned)wid * 1024u;
    const int aoff = lds_byte(wr * 64 + fr, fq * 8), boff = lds_byte(wc * 32 + fr, fq * 8);
#define PG8_SA(b, h) (((b) * 2 + (h)) * HTB)
#define PG8_SB(b, h) ((4 + (b) * 2 + (h)) * HTB)
#define PG8_STAGE(bufoff, gbase, voff) do { _Pragma("unroll") for (int _i = 0; _i < 2; ++_i) \
        __builtin_amdgcn_global_load_lds((const unsigned*)((const char*)(gbase) + (voff)[_i]), (PG8_LAS unsigned*)(lds + (bufoff) + ldsw + _i * 8192), 16, 0, 0); } while (0)
#define PG8_LDA(dst, b, h) do { _Pragma("unroll") for (int m = 0; m < 4; ++m) _Pragma("unroll") for (int k = 0; k < 2; ++k) dst[m][k] = *(const PG8_LAS bf16x8*)(lds + PG8_SA(b, h) + aoff + m * 2048 + k * 1024); } while (0)
#define PG8_LDB(dst, b, h) do { _Pragma("unroll") for (int n = 0; n < 2; ++n) _Pragma("unroll") for (int k = 0; k < 2; ++k) dst[n][k] = *(const PG8_LAS bf16x8*)(lds + PG8_SB(b, h) + boff + n * 2048 + k * 1024); } while (0)
#define PG8_MMA(ai, bj, At, Bt) do { __builtin_amdgcn_s_setprio(1); _Pragma("unroll") for (int m = 0; m < 4; ++m) _Pragma("unroll") for (int n = 0; n < 2; ++n) _Pragma("unroll") for (int k = 0; k < 2; ++k) \
        acc[ai][bj][m][n] = __builtin_amdgcn_mfma_f32_16x16x32_bf16(Bt[n][k], At[m][k], acc[ai][bj][m][n], 0, 0, 0); __builtin_amdgcn_s_setprio(0); } while (0)
#define PG8_WAIT_V(n) asm volatile("s_waitcnt vmcnt(" #n ")" ::: "memory")
#define PG8_WAIT_L(n) asm volatile("s_waitcnt lgkmcnt(" #n ")" ::: "memory")
#define PG8_BAR __builtin_amdgcn_s_barrier()
#define PG8_SCHED __builtin_amdgcn_sched_barrier(0)
    Unit cur, nxt; int ui = 0;
    if (!S.next(0, cur)) return;
    f32x4 acc[2][2][4][2];
#pragma unroll
    for (int a = 0; a < 2; ++a)
#pragma unroll
        for (int b = 0; b < 2; ++b)
#pragma unroll
            for (int m = 0; m < 4; ++m)
#pragma unroll
                for (int n = 0; n < 2; ++n) acc[a][b][m][n] = (f32x4){0.f, 0.f, 0.f, 0.f};
    bf16x8 At[4][2], B0[2][2], B1[2][2];
    const char* cA = (const char*)g.A + (size_t)cur.pm * tstep + (size_t)cur.k0 * 2; const char* cB = (const char*)g.Bt + (size_t)cur.pn * tstep + (size_t)cur.k0 * 2;
    S.a_ready(cur);
    if constexpr (Epi::MIDK) E.pre(cur, wr, fr, tid);
    if constexpr (SP2) {
        PG8_STAGE(PG8_SB(0, 0), cB, voffB); PG8_STAGE(PG8_SB(0, 1), cB + hstepB, voffB); PG8_STAGE(PG8_SA(0, 0), cA, voffA); PG8_STAGE(PG8_SA(0, 1), cA + hstep, voffA);
        if (wr == 1) PG8_BAR;
        PG8_WAIT_V(2); PG8_BAR;
        PG8_STAGE(PG8_SB(1, 0), cB + kstep, voffB); PG8_STAGE(PG8_SA(1, 0), cA + kstep, voffA); PG8_STAGE(PG8_SB(1, 1), cB + hstepB + kstep, voffB);
        PG8_WAIT_V(6); PG8_BAR;
    } else {
        PG8_STAGE(PG8_SB(0, 0), cB, voffB); PG8_STAGE(PG8_SA(0, 0), cA, voffA); PG8_STAGE(PG8_SB(0, 1), cB + hstepB, voffB); PG8_STAGE(PG8_SA(0, 1), cA + hstep, voffA);
        if (wr == 1) PG8_BAR;
        PG8_WAIT_V(4); PG8_BAR;
        PG8_STAGE(PG8_SB(1, 0), cB + kstep, voffB); PG8_STAGE(PG8_SA(1, 0), cA + kstep, voffA); PG8_STAGE(PG8_SB(1, 1), cB + hstepB + kstep, voffB);
        PG8_WAIT_V(6); PG8_BAR;
    }
    for (;;) {
        const bool has_next = S.next(ui + 1, nxt);
        const char* nA = has_next ? (const char*)g.A + (size_t)nxt.pm * tstep + (size_t)nxt.k0 * 2 : cA; const char* nB = has_next ? (const char*)g.Bt + (size_t)nxt.pn * tstep + (size_t)nxt.k0 * 2 : cB;
        const int nt = cur.nt;
        for (int t = 0; t < nt; t += 2) {
            const bool last = (t == nt - 2);
            const char* a1 = cA + (size_t)(t + 1) * kstep;
            const char* a2 = last ? nA : cA + (size_t)(t + 2) * kstep; const char* b2 = last ? nB : cB + (size_t)(t + 2) * kstep;
            const char* a3 = a2 + kstep; const char* b3 = b2 + kstep;
            if (last && has_next) S.a_ready(nxt);
            if constexpr (Epi::MIDK) { if (t == Epi::MIDK_TILE) E.mid(acc, cur, tid); }
            if constexpr (SP2) {
            PG8_LDB(B0, 0, 0); PG8_LDB(B1, 0, 1); PG8_SCHED; PG8_LDA(At, 0, 0); PG8_STAGE(PG8_SA(1, 1), a1 + hstep, voffA);
            PG8_WAIT_V(8); PG8_WAIT_L(0); PG8_BAR; PG8_MMA(0, 0, At, B0); PG8_MMA(0, 1, At, B1); PG8_BAR; PG8_SCHED;
            PG8_LDA(At, 0, 1); PG8_STAGE(PG8_SB(0, 0), b2, voffB); PG8_STAGE(PG8_SB(0, 1), b2 + hstepB, voffB); PG8_STAGE(PG8_SA(0, 0), a2, voffA);
            PG8_WAIT_V(8); PG8_WAIT_L(0); PG8_BAR; PG8_MMA(1, 0, At, B0); PG8_MMA(1, 1, At, B1); PG8_BAR; PG8_SCHED;
            PG8_LDB(B0, 1, 0); PG8_LDB(B1, 1, 1); PG8_SCHED; PG8_LDA(At, 1, 0); PG8_STAGE(PG8_SA(0, 1), a2 + hstep, voffA);
            PG8_WAIT_V(8); PG8_WAIT_L(0); PG8_BAR; PG8_MMA(0, 0, At, B0); PG8_MMA(0, 1, At, B1); PG8_BAR; PG8_SCHED;
            PG8_LDA(At, 1, 1); PG8_STAGE(PG8_SB(1, 0), b3, voffB); PG8_STAGE(PG8_SB(1, 1), b3 + hstepB, voffB); PG8_STAGE(PG8_SA(1, 0), a3, voffA);
            PG8_WAIT_V(8); PG8_WAIT_L(0); PG8_BAR; PG8_MMA(1, 0, At, B0); PG8_MMA(1, 1, At, B1); PG8_BAR; PG8_SCHED;
            } else {
            PG8_LDB(B0, 0, 0); PG8_SCHED; PG8_LDA(At, 0, 0); PG8_STAGE(PG8_SA(1, 1), a1 + hstep, voffA);
            PG8_WAIT_L(8); PG8_BAR; PG8_WAIT_L(0); PG8_MMA(0, 0, At, B0); PG8_BAR; PG8_SCHED;
            PG8_LDB(B1, 0, 1); PG8_STAGE(PG8_SB(0, 0), b2, voffB);
            PG8_BAR; PG8_WAIT_L(0); PG8_MMA(0, 1, At, B1); PG8_BAR;
            PG8_LDA(At, 0, 1); PG8_STAGE(PG8_SA(0, 0), a2, voffA);
            PG8_BAR; PG8_WAIT_L(0); PG8_MMA(1, 0, At, B0); PG8_BAR; PG8_SCHED;
            PG8_STAGE(PG8_SB(0, 1), b2 + hstepB, voffB);
            PG8_WAIT_V(6); PG8_BAR; PG8_MMA(1, 1, At, B1); PG8_BAR;
            PG8_LDB(B0, 1, 0); PG8_SCHED; PG8_LDA(At, 1, 0); PG8_STAGE(PG8_SA(0, 1), a2 + hstep, voffA);
            PG8_WAIT_L(8); PG8_BAR; PG8_WAIT_L(0); PG8_MMA(0, 0, At, B0); PG8_BAR; PG8_SCHED;
            PG8_LDB(B1, 1, 1); PG8_STAGE(PG8_SB(1, 0), b3, voffB);
            PG8_BAR; PG8_WAIT_L(0); PG8_MMA(0, 1, At, B1); PG8_BAR;
            PG8_LDA(At, 1, 1); PG8_STAGE(PG8_SA(1, 0), a3, voffA);
            PG8_BAR; PG8_WAIT_L(0); PG8_MMA(1, 0, At, B0); PG8_BAR; PG8_SCHED;
            PG8_STAGE(PG8_SB(1, 1), b3 + hstepB, voffB);
            PG8_WAIT_V(6); PG8_BAR; PG8_MMA(1, 1, At, B1); PG8_BAR;
            }
        }
        if constexpr (ALIGN_EPI) { if (wr == 0) PG8_BAR; }
        if constexpr (!Epi::AFTER_DRAIN) { E(acc, cur, wr, wc, fr, fq); S.done(cur); }
        if (!has_next) break;
        if constexpr (Epi::MIDK) E.pre(nxt, wr, fr, tid);
#pragma unroll
        for (int a = 0; a < 2; ++a)
#pragma unroll
            for (int b = 0; b < 2; ++b)
#pragma unroll
                for (int m = 0; m < 4; ++m)
#pragma unroll
                    for (int n = 0; n < 2; ++n) acc[a][b][m][n] = (f32x4){0.f, 0.f, 0.f, 0.f};
        cur = nxt; cA = nA; cB = nB; ++ui;
        if constexpr (ALIGN_EPI) { if (wr == 1) PG8_BAR; }
    }
    PG8_WAIT_V(0);
    if constexpr (!ALIGN_EPI) { if (wr == 0) PG8_BAR; }
    PG8_BAR;
    if constexpr (Epi::AFTER_DRAIN) { E.fused(acc, cur, wr, wc, fr, fq, lds, wid, lane); S.done(cur); }
#undef PG8_SA
#undef PG8_SB
#undef PG8_STAGE
#undef PG8_LDA
#undef PG8_LDB
#undef PG8_MMA
#undef PG8_WAIT_V
#undef PG8_WAIT_L
#undef PG8_BAR
#undef PG8_SCHED
}
}

namespace attn {
typedef unsigned short bf16;
using bf16x8 = __attribute__((ext_vector_type(8))) short;
using s16x4  = __attribute__((ext_vector_type(4))) short;
using f32x16 = __attribute__((ext_vector_type(16))) float;
using u32x4  = __attribute__((ext_vector_type(4))) unsigned;
constexpr int   D = 128, NW = 8, QBLK = 32, KVBLK = 64;
constexpr float SCALE = 0.088388347648318440f;
constexpr float THR = 8.f;
constexpr int SDEPTH = 2;
constexpr int LDQ = 128, LDK = 128, LDO = 2048;
constexpr size_t SHM_V = KVBLK * D * 2, SHM_K = KVBLK * D * 2, SHM_ATTN = 4 * SHM_V + 4 * SHM_K;
#define LAS3 __attribute__((address_space(3)))
#define KSWZ(row, colB) ((row) * 256 + ((colB) ^ (((row) & 7) << 4)))
#define SBAR() __builtin_amdgcn_sched_barrier(0)
__device__ __forceinline__ int crow(int r, int hi) { return (r & 3) + 8 * (r >> 2) + 4 * hi; }
__device__ __forceinline__ unsigned cvtpk(float lo, float hi) {
  unsigned r; asm volatile("v_cvt_pk_bf16_f32 %0, %1, %2" : "=v"(r) : "v"(lo), "v"(hi)); return r;
}
__device__ __forceinline__ bf16x8 ld8(const bf16* p) { return *reinterpret_cast<const bf16x8*>(p); }

__device__ __forceinline__ void partialSM(f32x16& p0, f32x16& p1, float& m_reg, float& mn, float& alpha) {
  constexpr float C = SCALE * 1.4426950408889634f;
  float pmax = p0[0]; for (int r = 1; r < 16; ++r) pmax = fmaxf(pmax, p0[r]); for (int r = 0; r < 16; ++r) pmax = fmaxf(pmax, p1[r]);
  { auto rr = __builtin_amdgcn_permlane32_swap(__float_as_uint(pmax), __float_as_uint(pmax), false, false);
    pmax = fmaxf(__uint_as_float(rr[0]), __uint_as_float(rr[1])); }
  if (__builtin_expect(__all(pmax - m_reg <= THR / SCALE), 1)) { mn = m_reg; alpha = 1.f; }
  else { mn = fmaxf(m_reg, pmax); alpha = __builtin_amdgcn_exp2f((m_reg - mn) * C); m_reg = mn; }
  float mnC = -mn * C;
  for (int r = 0; r < 16; ++r) p0[r] = fmaf(p0[r], C, mnC); for (int r = 0; r < 16; ++r) p1[r] = fmaf(p1[r], C, mnC);
  for (int r = 0; r < 16; ++r) p0[r] = __builtin_amdgcn_exp2f(p0[r]);
}
__device__ __forceinline__ void finishSM(f32x16& p0, f32x16& p1, float alpha, float& l_reg, bf16x8& pa0, bf16x8& pa1, bf16x8& pa2, bf16x8& pa3) {
  for (int r = 0; r < 16; ++r) p1[r] = __builtin_amdgcn_exp2f(p1[r]);
  float ps = 0; for (int r = 0; r < 16; ++r) ps += p0[r]; for (int r = 0; r < 16; ++r) ps += p1[r];
  { auto rr = __builtin_amdgcn_permlane32_swap(__float_as_uint(ps), __float_as_uint(ps), false, false);
    ps = __uint_as_float(rr[0]) + __uint_as_float(rr[1]); }
  l_reg = l_reg * alpha + ps;
#define PK4(P, BASE, OUT) do { unsigned a0 = cvtpk(P[BASE + 0], P[BASE + 1]), a1 = cvtpk(P[BASE + 2], P[BASE + 3]);   \
    unsigned b0 = cvtpk(P[BASE + 4], P[BASE + 5]), b1 = cvtpk(P[BASE + 6], P[BASE + 7]);                              \
    auto r0 = __builtin_amdgcn_permlane32_swap(a0, b0, false, false); auto r1 = __builtin_amdgcn_permlane32_swap(a1, b1, false, false); \
    u32x4 w = {r0[0], r1[0], r0[1], r1[1]}; OUT = *reinterpret_cast<bf16x8*>(&w); } while (0)
  PK4(p0, 0, pa0); PK4(p0, 8, pa1); PK4(p1, 0, pa2); PK4(p1, 8, pa3);
#undef PK4
}
__device__ __forceinline__ float amax3(float a, float b, float c) { float r; asm("v_max3_f32 %0, %1, %2, %3" : "=v"(r) : "v"(a), "v"(b), "v"(c)); return r; }
__device__ __forceinline__ float amax2(float a, float b) { float r; asm("v_max_f32 %0, %1, %2" : "=v"(r) : "v"(a), "v"(b)); return r; }
constexpr float THR2 = 11.541560327111707f;
__device__ __forceinline__ void softmax_step(f32x16& p0, f32x16& p1, f32x16& mt, bool first, float& alpha, float& l_reg, bf16x8& pa0, bf16x8& pa1, bf16x8& pa2, bf16x8& pa3) {
  float mc[4];
#pragma unroll
  for (int k = 0; k < 4; ++k) { float m = amax3(p0[k], p0[k + 4], p0[k + 8]); m = amax3(m, p0[k + 12], p1[k]); m = amax3(m, p1[k + 4], p1[k + 8]); mc[k] = amax2(m, p1[k + 12]); }
  float pmax = amax2(amax3(mc[0], mc[1], mc[2]), mc[3]);
  { auto rr = __builtin_amdgcn_permlane32_swap(__float_as_uint(pmax), __float_as_uint(pmax), false, false);
    pmax = amax2(__uint_as_float(rr[0]), __uint_as_float(rr[1])); }
  alpha = 1.f;
  if (__builtin_expect(first || !__all(pmax <= THR2), 0)) {
    const float delta = first ? pmax : fmaxf(pmax, 0.f);
    alpha = first ? 1.f : __builtin_amdgcn_exp2f(-delta);
    for (int r = 0; r < 16; ++r) { p0[r] -= delta; p1[r] -= delta; mt[r] -= delta; }
  }
  for (int r = 0; r < 16; ++r) p0[r] = __builtin_amdgcn_exp2f(p0[r]);
  for (int r = 0; r < 16; ++r) p1[r] = __builtin_amdgcn_exp2f(p1[r]);
  float s0 = p0[0] + p0[4], s1 = p0[1] + p0[5], s2 = p0[2] + p0[6], s3 = p0[3] + p0[7];
  s0 += p0[8]; s1 += p0[9]; s2 += p0[10]; s3 += p0[11]; s0 += p0[12]; s1 += p0[13]; s2 += p0[14]; s3 += p0[15];
  s0 += p1[0]; s1 += p1[1]; s2 += p1[2]; s3 += p1[3]; s0 += p1[4]; s1 += p1[5]; s2 += p1[6]; s3 += p1[7];
  s0 += p1[8]; s1 += p1[9]; s2 += p1[10]; s3 += p1[11]; s0 += p1[12]; s1 += p1[13]; s2 += p1[14]; s3 += p1[15];
  float ps = (s0 + s1) + (s2 + s3);
  { auto rr = __builtin_amdgcn_permlane32_swap(__float_as_uint(ps), __float_as_uint(ps), false, false);
    ps = __uint_as_float(rr[0]) + __uint_as_float(rr[1]); }
  l_reg = l_reg * alpha + ps;
#define PK4(P, BASE, OUT) do { unsigned a0 = cvtpk(P[BASE + 0], P[BASE + 1]), a1 = cvtpk(P[BASE + 2], P[BASE + 3]);   \
    unsigned b0 = cvtpk(P[BASE + 4], P[BASE + 5]), b1 = cvtpk(P[BASE + 6], P[BASE + 7]);                              \
    auto r0 = __builtin_amdgcn_permlane32_swap(a0, b0, false, false); auto r1 = __builtin_amdgcn_permlane32_swap(a1, b1, false, false); \
    u32x4 w = {r0[0], r1[0], r0[1], r1[1]}; OUT = *reinterpret_cast<bf16x8*>(&w); } while (0)
  PK4(p0, 0, pa0); PK4(p0, 8, pa1); PK4(p1, 0, pa2); PK4(p1, 8, pa3);
#undef PK4
}
template <int OFF> __device__ __forceinline__ bf16x8 kread(int a) { bf16x8 r; asm volatile("ds_read_b128 %0, %1 offset:%2" : "=&v"(r) : "v"(a), "i"(OFF) : "memory"); return r; }
#define KWAIT(N, X, Y) asm volatile("s_waitcnt lgkmcnt(" #N ")" : "+v"(X), "+v"(Y) :: "memory")
#define QM(X, D0) do { p0 = __builtin_amdgcn_mfma_f32_32x32x16_bf16(X##0, qr[D0], p0, 0, 0, 0); p1 = __builtin_amdgcn_mfma_f32_32x32x16_bf16(X##1, qr[D0], p1, 0, 0, 0); } while (0)
#define QKT_ISSUE2() bf16x8 a0 = kread<0>(ka[0]), a1 = kread<8192>(ka[0]); bf16x8 b0 = kread<0>(ka[1]), b1 = kread<8192>(ka[1])
#define QKT_REST() do { \
  KWAIT(2, a0, a1); p0 = __builtin_amdgcn_mfma_f32_32x32x16_bf16(a0, qr[0], mt, 0, 0, 0); p1 = __builtin_amdgcn_mfma_f32_32x32x16_bf16(a1, qr[0], mt, 0, 0, 0); \
  bf16x8 c0 = kread<0>(ka[2]), c1 = kread<8192>(ka[2]); \
  KWAIT(2, b0, b1); QM(b, 1); \
  a0 = kread<0>(ka[3]); a1 = kread<8192>(ka[3]); \
  KWAIT(2, c0, c1); QM(c, 2); \
  b0 = kread<128>(ka[0]); b1 = kread<8320>(ka[0]); \
  KWAIT(2, a0, a1); QM(a, 3); \
  c0 = kread<128>(ka[1]); c1 = kread<8320>(ka[1]); \
  KWAIT(2, b0, b1); QM(b, 4); \
  a0 = kread<128>(ka[2]); a1 = kread<8320>(ka[2]); \
  KWAIT(2, c0, c1); QM(c, 5); \
  b0 = kread<128>(ka[3]); b1 = kread<8320>(ka[3]); \
  KWAIT(2, a0, a1); QM(a, 6); \
  KWAIT(0, b0, b1); QM(b, 7); } while (0)
__device__ __forceinline__ void qkt(f32x16& p0, f32x16& p1, const int (&ka)[4], const bf16x8* qr, const f32x16& mt) {
  QKT_ISSUE2(); QKT_REST();
}
__device__ __forceinline__ int v_st(int k, int c) { const int kk = (k & ~0xC) | ((k & 4) << 1) | ((k & 8) >> 1); return ((kk >> 3) * 4 + (c >> 5)) * 512 + ((kk & 7) * 32 + (c & 31)) * 2; }
__device__ __forceinline__ int v_rd_base(int lane) { return ((lane & 3) << 3) | (((lane >> 2) & 3) << 6) | (((lane >> 4) & 1) << 5) | (((lane >> 5) & 1) << 8); }
constexpr int v_rd_off(int d0, int ks, int half) { return d0 * 512 + ks * 4096 + half * 2048; }
template <int OFF> __device__ __forceinline__ s16x4 tr_read(int vb) {
  s16x4 r; asm volatile("ds_read_b64_tr_b16 %0, %1 offset:%2" : "=&v"(r) : "v"(vb), "i"(OFF) : "memory"); return r;
}
#define TRSET(S, D0) do { S##0 = tr_read<v_rd_off(D0, 0, 0)>(vb); S##1 = tr_read<v_rd_off(D0, 0, 1)>(vb); S##2 = tr_read<v_rd_off(D0, 1, 0)>(vb); S##3 = tr_read<v_rd_off(D0, 1, 1)>(vb); \
    S##4 = tr_read<v_rd_off(D0, 2, 0)>(vb); S##5 = tr_read<v_rd_off(D0, 2, 1)>(vb); S##6 = tr_read<v_rd_off(D0, 3, 0)>(vb); S##7 = tr_read<v_rd_off(D0, 3, 1)>(vb); } while (0)
#define TWAIT(N, S) asm volatile("s_waitcnt lgkmcnt(" #N ")" : "+v"(S##0), "+v"(S##1), "+v"(S##2), "+v"(S##3), "+v"(S##4), "+v"(S##5), "+v"(S##6), "+v"(S##7) :: "memory")
#define PK(L, H) (bf16x8){L[0], L[1], L[2], L[3], H[0], H[1], H[2], H[3]}
#define PVM(OD, S) do { OD = __builtin_amdgcn_mfma_f32_32x32x16_bf16(pa0, PK(S##0, S##1), OD, 0, 0, 0); OD = __builtin_amdgcn_mfma_f32_32x32x16_bf16(pa1, PK(S##2, S##3), OD, 0, 0, 0); \
    OD = __builtin_amdgcn_mfma_f32_32x32x16_bf16(pa2, PK(S##4, S##5), OD, 0, 0, 0); OD = __builtin_amdgcn_mfma_f32_32x32x16_bf16(pa3, PK(S##6, S##7), OD, 0, 0, 0); } while (0)
struct TrPre { s16x4 a0, a1, a2, a3, a4, a5, a6, a7, b0, b1, b2, b3, b4, b5, b6, b7; };
__device__ __forceinline__ TrPre pv_head(int vb) {
  s16x4 a0, a1, a2, a3, a4, a5, a6, a7, b0, b1, b2, b3, b4, b5, b6, b7;
  TRSET(a, 0); TRSET(b, 1);
  return TrPre{a0, a1, a2, a3, a4, a5, a6, a7, b0, b1, b2, b3, b4, b5, b6, b7};
}
__device__ __forceinline__ void pv_d0(f32x16* o, int vb, bf16x8 pa0, bf16x8 pa1, bf16x8 pa2, bf16x8 pa3, const TrPre& h) {
  s16x4 a0 = h.a0, a1 = h.a1, a2 = h.a2, a3 = h.a3, a4 = h.a4, a5 = h.a5, a6 = h.a6, a7 = h.a7, b0 = h.b0, b1 = h.b1, b2 = h.b2, b3 = h.b3, b4 = h.b4, b5 = h.b5, b6 = h.b6, b7 = h.b7;
  TWAIT(8, a); PVM(o[0], a);
  TRSET(a, 2);
  TWAIT(8, b); PVM(o[1], b);
  TRSET(b, 3);
  TWAIT(8, a); PVM(o[2], a);
  TWAIT(0, b); PVM(o[3], b);
}
__device__ __forceinline__ void mstep(f32x16* o, int vb, bf16x8 pa0, bf16x8 pa1, bf16x8 pa2, bf16x8 pa3, const TrPre& h, f32x16& p0, f32x16& p1, const int (&ka)[4], const bf16x8* qr, const f32x16& mt) {
  s16x4 u0 = h.a0, u1 = h.a1, u2 = h.a2, u3 = h.a3, u4 = h.a4, u5 = h.a5, u6 = h.a6, u7 = h.a7, w0 = h.b0, w1 = h.b1, w2 = h.b2, w3 = h.b3, w4 = h.b4, w5 = h.b5, w6 = h.b6, w7 = h.b7;
#define TDONE(S) asm volatile("" : "+v"(S##0), "+v"(S##1), "+v"(S##2), "+v"(S##3), "+v"(S##4), "+v"(S##5), "+v"(S##6), "+v"(S##7) :: "memory")
  bf16x8 a0 = kread<0>(ka[0]), a1 = kread<8192>(ka[0]);
  bf16x8 b0 = kread<0>(ka[1]), b1 = kread<8192>(ka[1]);
  TWAIT(12, u); PVM(o[0], u);
  TRSET(u, 2);
  KWAIT(10, a0, a1); TDONE(w);
  p0 = __builtin_amdgcn_mfma_f32_32x32x16_bf16(a0, qr[0], mt, 0, 0, 0); p1 = __builtin_amdgcn_mfma_f32_32x32x16_bf16(a1, qr[0], mt, 0, 0, 0);
  bf16x8 c0 = kread<0>(ka[2]), c1 = kread<8192>(ka[2]);
  KWAIT(10, b0, b1); QM(b, 1);
  a0 = kread<0>(ka[3]); a1 = kread<8192>(ka[3]);
  PVM(o[1], w);
  TRSET(w, 3);
  KWAIT(10, c0, c1); TDONE(u);
  QM(c, 2);
  b0 = kread<128>(ka[0]); b1 = kread<8320>(ka[0]);
  KWAIT(10, a0, a1); QM(a, 3);
  c0 = kread<128>(ka[1]); c1 = kread<8320>(ka[1]);
  PVM(o[2], u);
  KWAIT(2, b0, b1); TDONE(w);
  QM(b, 4);
  a0 = kread<128>(ka[2]); a1 = kread<8320>(ka[2]);
  KWAIT(2, c0, c1); QM(c, 5);
  b0 = kread<128>(ka[3]); b1 = kread<8320>(ka[3]);
  PVM(o[3], w);
  KWAIT(2, a0, a1); QM(a, 6);
  KWAIT(0, b0, b1); QM(b, 7);
#undef TDONE
}
#undef TRSET
#undef TWAIT
#undef PK
#undef PVM

__device__ __forceinline__ void attn_dense_body(const bf16* __restrict__ Qb, const bf16* __restrict__ Kh, const bf16* __restrict__ Vh,
                                                bf16* __restrict__ Ob, const float* __restrict__ gain, float* __restrict__ rsa, int seq, char* lds, char* scratch, int wave_id) {
  unsigned z_ = 0u; asm volatile("" : "+v"(z_)); const int lane_ = (int)__builtin_amdgcn_mbcnt_hi(~0u, __builtin_amdgcn_mbcnt_lo(~0u, z_));
    const int wid = wave_id, lane = lane_, tid = wid * 64 + lane, r32 = lane & 31, hi = lane >> 5;
  bf16* V_lds = (bf16*)lds; bf16* K_lds = (bf16*)(lds + 4 * SHM_V);
  float* ws = (float*)scratch + wid * 64; float* li_l = ws; float* al_l = ws + 32;
  float l_reg = 0; f32x16 o[4] = {}; f32x16 mt = {}; bf16x8 qr[8];
  const bf16* Qw = Qb + (long)(wid * QBLK + r32) * LDQ + hi * 8;
#pragma unroll
  for (int d0 = 0; d0 < 8; ++d0) qr[d0] = ld8(Qw + d0 * 16);
  const int vb0 = (int)(uintptr_t)V_lds + v_rd_base(lane);
  int kb4[4];
#pragma unroll
  for (int q = 0; q < 4; ++q) kb4[q] = (int)(uintptr_t)K_lds + r32 * 256 + ((32 * q + 16 * hi) ^ ((r32 & 7) << 4));
#define KADDR(b) do { _Pragma("unroll") for (int q_ = 0; q_ < 4; ++q_) ka[q_] = kb4[q_] + (b) * (int)SHM_K; } while (0)
  int ka[4];
  unsigned gk[2], gv[2];
#pragma unroll
  for (int i = 0; i < 2; ++i) { const int blk = 2 * wid + i, row = blk * 4 + (lane >> 4); gk[i] = (unsigned)(row * 256 + (((lane & 15) ^ (row & 7)) << 4));
    const int st = blk * 2 + (lane >> 5), kk = (st >> 2) * 8 + ((lane >> 2) & 7), key = (kk & ~0xC) | ((kk & 4) << 1) | ((kk & 8) >> 1); gv[i] = (unsigned)(key * 256 + ((st & 3) * 32 + (lane & 3) * 8) * 2); }
  const unsigned ldsV = (unsigned)(uintptr_t)V_lds + (unsigned)wid * 2048u, ldsK = (unsigned)(uintptr_t)K_lds + (unsigned)wid * 2048u;
#define DMA(b, t) do { const char* kg_ = (const char*)Kh + (size_t)(t) * (KVBLK * LDK * 2); const char* vg_ = (const char*)Vh + (size_t)(t) * (KVBLK * LDK * 2); \
    _Pragma("unroll") for (int i_ = 0; i_ < 2; ++i_) { \
      __builtin_amdgcn_global_load_lds((const unsigned*)(kg_ + gk[i_]), (LAS3 unsigned*)(uintptr_t)(ldsK + (unsigned)(b) * (unsigned)SHM_K + i_ * 1024u), 16, 0, 0); \
      __builtin_amdgcn_global_load_lds((const unsigned*)(vg_ + gv[i_]), (LAS3 unsigned*)(uintptr_t)(ldsV + (unsigned)(b) * (unsigned)SHM_V + i_ * 1024u), 16, 0, 0); } } while (0)
#define LANDED() do { asm volatile("s_waitcnt vmcnt(0)" ::: "memory"); __builtin_amdgcn_s_barrier(); asm volatile("" ::: "memory"); } while (0)
#define RESC(a) do { if (__any((a) < 1.f)) { if (hi == 0) al_l[r32] = (a); asm volatile("s_waitcnt lgkmcnt(0)" ::: "memory"); \
    for (int d = 0; d < 4; ++d) for (int r = 0; r < 16; ++r) o[d][r] *= al_l[crow(r, hi)]; } } while (0)
  f32x16 p0, p1; float al; bf16x8 pa0, pa1, pa2, pa3; const int NT = seq / KVBLK;
  DMA(0, 0); DMA(1, 1); DMA(2, 2); DMA(3, 3);
  asm volatile("s_waitcnt vmcnt(12)" ::: "memory"); SBAR(); __builtin_amdgcn_s_barrier(); SBAR();
#define BARP() do { SBAR(); asm volatile("" ::: "memory"); __builtin_amdgcn_s_barrier(); asm volatile("" ::: "memory"); SBAR(); } while (0)
#define BARD(t) do { SBAR(); if ((t) == 0) asm volatile("s_waitcnt vmcnt(8)" ::: "memory"); else if ((t) + 2 < NT) asm volatile("s_waitcnt vmcnt(4)" ::: "memory"); else asm volatile("s_waitcnt vmcnt(0)" ::: "memory"); \
    __builtin_amdgcn_s_barrier(); asm volatile("" ::: "memory"); SBAR(); } while (0)
#define SSTEP(first) do { softmax_step(p0, p1, mt, first, al, l_reg, pa0, pa1, pa2, pa3); RESC(al); } while (0)
  if (wid < 4) {
    KADDR(0); qkt(p0, p1, ka, qr, mt);
    BARP();
    for (int t = 0; t + 1 < NT; ++t) {
      if (t >= 2 && t + 2 < NT) DMA((t + 2) & 3, t + 2);
      SSTEP(t == 0);
      const TrPre h = pv_head(vb0 + (t & 3) * (int)SHM_V);
      BARD(t);
      KADDR((t + 1) & 3); mstep(o, vb0 + (t & 3) * (int)SHM_V, pa0, pa1, pa2, pa3, h, p0, p1, ka, qr, mt);
      BARP();
    }
    SSTEP(false); { const TrPre h = pv_head(vb0 + ((NT - 1) & 3) * (int)SHM_V); BARD(NT - 1);
    pv_d0(o, vb0 + ((NT - 1) & 3) * (int)SHM_V, pa0, pa1, pa2, pa3, h); }
  } else {
    BARP();
    TrPre h = pv_head(vb0);
    for (int t = 0; t < NT; ++t) {
      KADDR(t & 3);
      if (t > 0) mstep(o, vb0 + ((t - 1) & 3) * (int)SHM_V, pa0, pa1, pa2, pa3, h, p0, p1, ka, qr, mt); else qkt(p0, p1, ka, qr, mt);
      BARD(t);
      if (t >= 1 && t + 3 < NT) DMA((t + 3) & 3, t + 3);
      SSTEP(t == 0);
      h = pv_head(vb0 + (t & 3) * (int)SHM_V);
      if (t + 1 < NT) BARP();
    }
    pv_d0(o, vb0 + ((NT - 1) & 3) * (int)SHM_V, pa0, pa1, pa2, pa3, h);
  }
#undef BARP
#undef BARD
#undef SSTEP
  if (hi == 0) li_l[r32] = l_reg; asm volatile("s_waitcnt lgkmcnt(0)" ::: "memory");
  float rli[16];
#pragma unroll
  for (int r = 0; r < 16; ++r) rli[r] = __builtin_amdgcn_rcpf(li_l[crow(r, hi)]);
  bf16* Ow = Ob + (long)(wid * QBLK) * LDO; float* rw = rsa + wid * QBLK * 8;
  float gq[4];
#pragma unroll
  for (int d0 = 0; d0 < 4; ++d0) gq[d0] = gain[d0 * 32 + r32];
  const bool odd = (lane & 1) != 0; float srow = 0.f;
#pragma unroll
  for (int r = 0; r < 16; r += 2) { float ss0 = 0.f, ss1 = 0.f;
#pragma unroll
    for (int d0 = 0; d0 < 4; ++d0) { const float v0 = o[d0][r] * rli[r], v1 = o[d0][r + 1] * rli[r + 1]; ss0 += v0 * v0; ss1 += v1 * v1;
      const float g0 = v0 * gq[d0], g1 = v1 * gq[d0]; const float recv = __shfl_xor(odd ? g0 : g1, 1);
      const unsigned w = odd ? cvtpk(recv, g1) : cvtpk(g0, recv);
      *(unsigned*)(Ow + (long)crow(odd ? r + 1 : r, hi) * LDO + d0 * 32 + (r32 & ~1)) = w; }
#pragma unroll
    for (int sft = 1; sft < 32; sft <<= 1) { ss0 += __shfl_xor(ss0, sft); ss1 += __shfl_xor(ss1, sft); }
    srow = (r32 == r) ? ss0 : srow; srow = (r32 == r + 1) ? ss1 : srow; }
  if (r32 < 16) rw[crow(r32, hi) * 8] = srow;
#undef DMA
#undef LANDED
#undef RESC
#undef KADDR
}
#undef KSWZ
#undef SBAR
}

constexpr int NWAVES = 8;
constexpr int DM = 2048, NB = 4, SEQ = 4096, CTX = 256, NL = 4;
constexpr int HD = 128, NH = 8, NKV = 2, AW = 1024, KVW = 256, CW = 1024, INW = 4608, FF = 8192;
constexpr int ML = NB * SEQ, MC = NB * CTX, MT = ML + MC;
constexpr int SKV = SEQ + CTX;
constexpr int MODW = 6 * DM;
constexpr float EPS = 1e-6f;
constexpr int C_Q = 0, C_K = 1024, C_V = 1280, C_GB = 1536, C_GC = 2560, C_U = 3584, C_Z = 2560;

constexpr size_t MiB = 1u << 20;
constexpr size_t WS_CTL = 0, CTL_ZERO_BYTES = 64 * 1024;
constexpr size_t WS_MOD = 1 * MiB;
constexpr size_t WS_XC = 2 * MiB;
constexpr size_t WS_W = 16 * MiB;
constexpr size_t W_IN_E = (size_t)INW * DM, W_OUT_E = (size_t)DM * DM, W_1_E = (size_t)FF * DM, W_2_E = (size_t)DM * FF, W_LAYER_E = W_IN_E + W_OUT_E + W_1_E + W_2_E;
constexpr size_t WS_H = WS_W + NL * W_LAYER_E * 2 + 8 * MiB;
constexpr size_t WS_BIG = WS_H + (size_t)MT * DM * 2 + 4 * MiB;
constexpr size_t BIG_QKV = 0, BIG_Q = 156 * MiB, BIG_K = 192 * MiB, BIG_V = 202 * MiB;
constexpr size_t WS_MRG = WS_BIG + (size_t)MT * FF * 2 + 4 * MiB;
constexpr size_t WS_AO = WS_MRG + (size_t)MT * DM * 2 + 4 * MiB;
constexpr size_t WS_PART = WS_AO + (size_t)MT * AW * 4 + 4 * MiB;
constexpr size_t WS_END = WS_PART + (size_t)8 * MC * DM * 4 + 4 * MiB;
static_assert((size_t)MT * INW * 2 <= BIG_Q && BIG_Q + (size_t)MT * AW * 2 <= BIG_K && BIG_K + (size_t)NB * NKV * SKV * HD * 2 <= BIG_V && BIG_V + (size_t)NB * NKV * SKV * HD * 2 <= (size_t)MT * FF * 2, "overlay map");
static_assert((size_t)NL * 5 * MODW * 4 <= 1 * MiB && WS_XC + (size_t)MC * DM * 4 <= WS_W, "small map");
constexpr int CW_BAR = 4096;
constexpr size_t WS_RSA = 11 * MiB;
static_assert(WS_RSA >= WS_XC + (size_t)MC * DM * 4 && WS_RSA + (size_t)MT * 8 * 4 <= WS_W && (CW_BAR + 3456) * 4 <= (int)CTL_ZERO_BYTES, "CTL / RSA map");

constexpr int RING_OFF = 0, RING_BYTES = 131072;
constexpr int ROPE_OFF = RING_BYTES;
constexpr int MISC_OFF = ROPE_OFF + 16384;
constexpr int STASH_OFF = MISC_OFF + 256;
constexpr int LDS_BYTES = STASH_OFF + NWAVES * 64 * 16;

#define GAS __attribute__((address_space(1)))
#define LAS __attribute__((address_space(3)))
typedef unsigned short bf16;
typedef unsigned v4u __attribute__((ext_vector_type(4)));
typedef unsigned v2u __attribute__((ext_vector_type(2)));
typedef float f32x4 __attribute__((ext_vector_type(4)));
typedef float f32x2 __attribute__((ext_vector_type(2)));
#define LDS_WAIT() asm volatile("s_waitcnt lgkmcnt(0)" ::: "memory")
__device__ __forceinline__ unsigned pk2(float lo, float hi) { unsigned r; asm volatile("v_cvt_pk_bf16_f32 %0, %1, %2" : "=v"(r) : "v"(lo), "v"(hi)); return r; }
__device__ __forceinline__ float bflo(unsigned w) { return __builtin_bit_cast(float, w << 16); }
__device__ __forceinline__ float bfhi(unsigned w) { return __builtin_bit_cast(float, w & 0xffff0000u); }
__device__ __forceinline__ float wave_sum(float v) {
#pragma unroll
    for (int o = 1; o < 64; o <<= 1) v += __shfl_xor(v, o);
    return v;
}
__device__ __forceinline__ void ld16(const bf16* p, float (&x)[16]) {
    const v4u a = *(const v4u*)p, b = *(const v4u*)(p + 8);
    x[0] = bflo(a.x); x[1] = bfhi(a.x); x[2] = bflo(a.y); x[3] = bfhi(a.y); x[4] = bflo(a.z); x[5] = bfhi(a.z); x[6] = bflo(a.w); x[7] = bfhi(a.w);
    x[8] = bflo(b.x); x[9] = bfhi(b.x); x[10] = bflo(b.y); x[11] = bfhi(b.y); x[12] = bflo(b.z); x[13] = bfhi(b.z); x[14] = bflo(b.w); x[15] = bfhi(b.w);
}
struct Raw16 { v4u a, b; };
__device__ __forceinline__ Raw16 ldraw16(const bf16* p) { Raw16 r; r.a = *(const v4u*)p; r.b = *(const v4u*)(p + 8); return r; }
__device__ __forceinline__ void unpack16(const Raw16& r, float (&x)[16]) {
    x[0] = bflo(r.a.x); x[1] = bfhi(r.a.x); x[2] = bflo(r.a.y); x[3] = bfhi(r.a.y); x[4] = bflo(r.a.z); x[5] = bfhi(r.a.z); x[6] = bflo(r.a.w); x[7] = bfhi(r.a.w);
    x[8] = bflo(r.b.x); x[9] = bfhi(r.b.x); x[10] = bflo(r.b.y); x[11] = bfhi(r.b.y); x[12] = bflo(r.b.z); x[13] = bfhi(r.b.z); x[14] = bflo(r.b.w); x[15] = bfhi(r.b.w);
}
__device__ __forceinline__ void st16(bf16* p, const float (&x)[16]) {
    v4u a, b; a.x = pk2(x[0], x[1]); a.y = pk2(x[2], x[3]); a.z = pk2(x[4], x[5]); a.w = pk2(x[6], x[7]);
    b.x = pk2(x[8], x[9]); b.y = pk2(x[10], x[11]); b.z = pk2(x[12], x[13]); b.w = pk2(x[14], x[15]);
    *(v4u*)p = a; *(v4u*)(p + 8) = b;
}
__device__ __forceinline__ void ld16f(const float* p, float (&x)[16]) {
#pragma unroll
    for (int i = 0; i < 4; ++i) { const f32x4 v = *(const f32x4*)(p + 4 * i); x[4 * i] = v.x; x[4 * i + 1] = v.y; x[4 * i + 2] = v.z; x[4 * i + 3] = v.w; }
}
#define XB_TMO      128
#define XB_XCNT(j)  (256  + 64 * (j))
#define XB_XSUB(j)  (1280 + 64 * (j))
#define XB_XGEN(j)  (2304 + 64 * (j))
#define XB_TOP      3328
#define XB_TOPGEN   3392
#define XCD_BAR_WORDS 3456
#define XB_SPIN_CAP (1u << 18)

__device__ __forceinline__ unsigned xb_ld(unsigned* p)              { return __hip_atomic_load(p, __ATOMIC_RELAXED, __HIP_MEMORY_SCOPE_AGENT); }
__device__ __forceinline__ unsigned xb_add(unsigned* p, unsigned v) { return __hip_atomic_fetch_add(p, v, __ATOMIC_RELAXED, __HIP_MEMORY_SCOPE_AGENT); }
__device__ __forceinline__ unsigned xb_xcc_id() { return (unsigned)__builtin_amdgcn_s_getreg((3 << 11) | 20) & 0xFu; }
#define XB_SPIN(cond, bar) do { unsigned _sp = 0; while (cond) { __builtin_amdgcn_s_sleep(1); \
    if ((++_sp & 255u) == 0u) { if (xb_ld(&(bar)[XB_TMO])) break; if (_sp > XB_SPIN_CAP) { atomicAdd(&(bar)[XB_TMO], 1u); break; } } } } while (0)

struct XcdBarrier {
    unsigned* bar; unsigned x;
    volatile LAS unsigned* st;
};

__device__ __forceinline__ XcdBarrier xcd_barrier_post(unsigned* bar, volatile LAS unsigned* st, bool leader) {
    XcdBarrier b; b.bar = bar; b.x = xb_xcc_id(); b.st = st;
    if (leader) (void)xb_add(&bar[XB_XCNT(b.x)], 1u);
    return b;
}
__device__ __forceinline__ void xcd_barrier_complete(unsigned* bar, unsigned x, unsigned& nloc, unsigned& nx) {
    const unsigned G = gridDim.x * gridDim.y * gridDim.z;
    unsigned sum, cnt, mine, sp = 0u;
    for (;;) {
        sum = 0u; cnt = 0u; mine = 0u;
#pragma unroll
        for (unsigned j = 0; j < 16; ++j) { const unsigned c = xb_ld(&bar[XB_XCNT(j)]); sum += c; cnt += (c > 0u) ? 1u : 0u; mine = (j == x) ? c : mine; }
        if (sum == G) break;
        __builtin_amdgcn_s_sleep(1);
        if ((++sp & 255u) == 0u) { if (xb_ld(&bar[XB_TMO])) break; if (sp > XB_SPIN_CAP) { atomicAdd(&bar[XB_TMO], 1u); break; } }
    }
    nloc = mine > 0u ? mine : 1u; nx = cnt > 0u ? cnt : 1u;
}

__device__ __forceinline__ void xcd_barrier(const XcdBarrier& b, bool leader) {
    asm volatile("s_waitcnt vmcnt(0)" ::: "memory");
    __syncthreads();
    if (leader) {
        unsigned* bar = b.bar;
        __builtin_amdgcn_s_waitcnt(0);
        unsigned nloc = b.st[0], nx = b.st[1];
        if (nloc == 0u) { xcd_barrier_complete(bar, b.x, nloc, nx); b.st[0] = nloc; b.st[1] = nx; }
        const unsigned old = xb_add(&bar[XB_XSUB(b.x)], 1u);
        const unsigned gen = old / nloc;
        if (old + 1u == (gen + 1u) * nloc) {
            __builtin_amdgcn_fence(__ATOMIC_RELEASE, "agent");
            asm volatile("s_waitcnt vmcnt(0)" ::: "memory");
            const unsigned og = xb_add(&bar[XB_TOP], 1u);
            const unsigned tg = og / nx;
            if (og + 1u == (tg + 1u) * nx) xb_add(&bar[XB_TOPGEN], 1u);
            else XB_SPIN(xb_ld(&bar[XB_TOPGEN]) == tg, bar);
            __builtin_amdgcn_fence(__ATOMIC_ACQUIRE, "agent");
            xb_add(&bar[XB_XGEN(b.x)], 1u);
            asm volatile("s_waitcnt vmcnt(0)" ::: "memory");
        } else {
            XB_SPIN(xb_ld(&bar[XB_XGEN(b.x)]) == gen, bar);
            __builtin_amdgcn_fence(__ATOMIC_ACQUIRE, "agent");
            asm volatile("s_waitcnt vmcnt(0)" ::: "memory");
        }
    }
    __syncthreads();
}


__device__ __forceinline__ void p0_transpose_item(const float* W, int K, int N, bf16* WT, LAS float* scr, int item, int lane, bool zperm = false) {
    const int nblk = N / 32, kb = item / nblk, nb = item % nblk, k0 = 64 * kb, n0 = 32 * nb;
    int nd0 = n0; if (zperm && n0 >= C_GC) { const int isu = n0 >= C_U, g = n0 - (isu ? C_U : C_GC); nd0 = C_GC + 256 * (g >> 7) + 64 * ((g >> 5) & 3) + 32 * isu + (g & 31); }
    {
        f32x4 t[8]; const int rr = lane >> 3, c4 = 4 * (lane & 7);
#pragma unroll
        for (int i = 0; i < 8; ++i) t[i] = *(const f32x4*)(W + (size_t)(k0 + rr + 8 * i) * N + n0 + c4);
        asm volatile("" ::: "memory");
#pragma unroll
        for (int i = 0; i < 8; ++i) { LAS float* d = scr + (rr + 8 * i) * 33 + c4; d[0] = t[i].x; d[1] = t[i].y; d[2] = t[i].z; d[3] = t[i].w; }
    }
    LDS_WAIT(); asm volatile("" ::: "memory");
    const int c = lane & 7;
#pragma unroll
    for (int j = 0; j < 4; ++j) { const int n = (lane >> 3) + 8 * j; const LAS float* s = scr + (8 * c) * 33 + n;
        v4u o; o.x = pk2(s[0 * 33], s[1 * 33]); o.y = pk2(s[2 * 33], s[3 * 33]); o.z = pk2(s[4 * 33], s[5 * 33]); o.w = pk2(s[6 * 33], s[7 * 33]);
        *(GAS v4u*)(WT + (size_t)(nd0 + n) * K + k0 + 8 * c) = o; }
    LDS_WAIT(); asm volatile("" ::: "memory");
}

__device__ __forceinline__ void adaln_item(const float* __restrict__ w_ada, const float* __restrict__ b_ada, float* __restrict__ mod, LAS float* sil, LAS float* red, int item, int tid, int wave, int lane) {
    const int l = item / 192, n0 = (item % 192) * 64, g = lane >> 4, c4 = lane & 15;
    const float* wp = w_ada + ((size_t)l * DM + wave * 256 + g) * MODW + n0 + 4 * c4;
    f32x4 acc[5];
#pragma unroll
    for (int r = 0; r < 5; ++r) acc[r] = (f32x4){0.f, 0.f, 0.f, 0.f};
    const LAS float* sp = sil + wave * 256 + g;
#pragma unroll 1
    for (int i0 = 0; i0 < 64; i0 += 8) {
        const float* wq = wp + (size_t)(4 * i0) * MODW;
        f32x4 wv[8];
#pragma unroll
        for (int i = 0; i < 8; ++i) wv[i] = *(const f32x4*)(wq + (size_t)(4 * i) * MODW);
        asm volatile("" ::: "memory");
#pragma unroll
        for (int i = 0; i < 8; ++i)
#pragma unroll
            for (int r = 0; r < 5; ++r) { const float s = sp[r * DM + 4 * (i0 + i)]; acc[r] = acc[r] + wv[i] * s; }
    }
#pragma unroll
    for (int r = 0; r < 5; ++r)
#pragma unroll
        for (int e = 0; e < 4; ++e) { float v = acc[r][e]; v += __shfl_xor(v, 16); v += __shfl_xor(v, 32); acc[r][e] = v; }
    if (g == 0) {
#pragma unroll
        for (int r = 0; r < 5; ++r) *(LAS f32x4*)(red + (wave * 5 + r) * 64 + 4 * c4) = acc[r];
    }
    __syncthreads();
    if (tid < 320) { const int r = tid >> 6, cc = tid & 63; float s = b_ada[(size_t)l * MODW + n0 + cc];
#pragma unroll
        for (int w = 0; w < 8; ++w) s += red[(w * 5 + r) * 64 + cc];
        mod[((size_t)l * 5 + r) * MODW + n0 + cc] = s; }
    __syncthreads();
}

__device__ __forceinline__ void norm_mod_rows(const float* __restrict__ x, bf16* __restrict__ out, int nrows, const float* __restrict__ gain, const float* __restrict__ sh, const float* __restrict__ sc, int lane) {
    asm volatile("" : "+v"(lane));
    f32x4 a[8], bb[8];
    {
        f32x4 sv[8];
#pragma unroll
        for (int j = 0; j < 8; ++j) { a[j] = *(const f32x4*)(gain + 4 * lane + 256 * j); sv[j] = *(const f32x4*)(sc + 4 * lane + 256 * j); bb[j] = *(const f32x4*)(sh + 4 * lane + 256 * j); }
        asm volatile("" ::: "memory");
#pragma unroll
        for (int j = 0; j < 8; ++j) a[j] = a[j] * (sv[j] + 1.0f);
    }
    int i = 0;
    for (; i + 1 < nrows; i += 2) {
        const f32x4* xr0 = (const f32x4*)(x + (size_t)i * DM) + lane; const f32x4* xr1 = xr0 + DM / 4;
        f32x4 v0[8], v1[8]; float s0 = 0.f, s1 = 0.f;
#pragma unroll
        for (int j = 0; j < 8; ++j) { v0[j] = xr0[64 * j]; v1[j] = xr1[64 * j]; }
#pragma unroll
        for (int j = 0; j < 8; ++j) { s0 += (v0[j].x * v0[j].x + v0[j].y * v0[j].y) + (v0[j].z * v0[j].z + v0[j].w * v0[j].w); s1 += (v1[j].x * v1[j].x + v1[j].y * v1[j].y) + (v1[j].z * v1[j].z + v1[j].w * v1[j].w); }
        const float r0 = 1.0f / sqrtf(wave_sum(s0) * (1.f / DM) + EPS), r1 = 1.0f / sqrtf(wave_sum(s1) * (1.f / DM) + EPS);
        v2u* o0 = (v2u*)(out + (size_t)i * DM) + lane; v2u* o1 = o0 + DM / 4;
#pragma unroll
        for (int j = 0; j < 8; ++j) { const f32x4 y0 = v0[j] * r0 * a[j] + bb[j], y1 = v1[j] * r1 * a[j] + bb[j]; v2u w0, w1; w0.x = pk2(y0.x, y0.y); w0.y = pk2(y0.z, y0.w); w1.x = pk2(y1.x, y1.y); w1.y = pk2(y1.z, y1.w); o0[64 * j] = w0; o1[64 * j] = w1; }
    }
    for (; i < nrows; ++i) {
        const f32x4* xr = (const f32x4*)(x + (size_t)i * DM) + lane;
        f32x4 v[8]; float ss = 0.f;
#pragma unroll
        for (int j = 0; j < 8; ++j) { v[j] = xr[64 * j]; ss += (v[j].x * v[j].x + v[j].y * v[j].y) + (v[j].z * v[j].z + v[j].w * v[j].w); }
        const float rstd = 1.0f / sqrtf(wave_sum(ss) * (1.f / DM) + EPS);
        v2u* o8 = (v2u*)(out + (size_t)i * DM) + lane;
#pragma unroll
        for (int j = 0; j < 8; ++j) { const f32x4 y = v[j] * rstd * a[j] + bb[j]; v2u w; w.x = pk2(y.x, y.y); w.y = pk2(y.z, y.w); o8[64 * j] = w; }
    }
}
__device__ __forceinline__ void norm_mod_rows_b(const bf16* __restrict__ x, bf16* __restrict__ out, int nrows, const float* __restrict__ gain, const float* __restrict__ sh, const float* __restrict__ sc, int lane) {
    asm volatile("" : "+v"(lane));
    f32x4 a[4][2], bb[4][2];
    {
        f32x4 sv[4][2];
#pragma unroll
        for (int j = 0; j < 4; ++j)
#pragma unroll
            for (int h = 0; h < 2; ++h) { const int e = 8 * lane + 512 * j + 4 * h; a[j][h] = *(const f32x4*)(gain + e); sv[j][h] = *(const f32x4*)(sc + e); bb[j][h] = *(const f32x4*)(sh + e); }
        asm volatile("" ::: "memory");
#pragma unroll
        for (int j = 0; j < 4; ++j)
#pragma unroll
            for (int h = 0; h < 2; ++h) a[j][h] = a[j][h] * (sv[j][h] + 1.0f);
    }
    for (int i = 0; i < nrows; i += 4) {
        v4u raw[4][4]; float ss[4];
#pragma unroll
        for (int r = 0; r < 4; ++r)
#pragma unroll
            for (int j = 0; j < 4; ++j) raw[r][j] = *(const v4u*)(x + (size_t)(i + r) * DM + 8 * lane + 512 * j);
        asm volatile("" ::: "memory");
#pragma unroll
        for (int r = 0; r < 4; ++r) { float s = 0.f;
#pragma unroll
            for (int j = 0; j < 4; ++j) { const v4u w = raw[r][j];
                const float x0 = bflo(w.x), x1 = bfhi(w.x), x2 = bflo(w.y), x3 = bfhi(w.y), x4 = bflo(w.z), x5 = bfhi(w.z), x6 = bflo(w.w), x7 = bfhi(w.w);
                s += ((x0 * x0 + x1 * x1) + (x2 * x2 + x3 * x3)) + ((x4 * x4 + x5 * x5) + (x6 * x6 + x7 * x7)); }
            ss[r] = s; }
#pragma unroll
        for (int r = 0; r < 4; ++r) ss[r] = 1.0f / sqrtf(wave_sum(ss[r]) * (1.f / DM) + EPS);
#pragma unroll
        for (int r = 0; r < 4; ++r)
#pragma unroll
            for (int j = 0; j < 4; ++j) { const v4u w = raw[r][j];
                f32x4 x0, x1; x0.x = bflo(w.x); x0.y = bfhi(w.x); x0.z = bflo(w.y); x0.w = bfhi(w.y); x1.x = bflo(w.z); x1.y = bfhi(w.z); x1.z = bflo(w.w); x1.w = bfhi(w.w);
                const f32x4 y0 = x0 * ss[r] * a[j][0] + bb[j][0], y1 = x1 * ss[r] * a[j][1] + bb[j][1];
                v4u o; o.x = pk2(y0.x, y0.y); o.y = pk2(y0.z, y0.w); o.z = pk2(y1.x, y1.y); o.w = pk2(y1.z, y1.w);
                *(v4u*)(out + (size_t)(i + r) * DM + 8 * lane + 512 * j) = o; }
    }
}
__device__ __forceinline__ void ctx_fix_norm_row(const float* __restrict__ xin, const bf16* __restrict__ part, const float* __restrict__ gate, const float* __restrict__ rsa_row, float* __restrict__ xout, bf16* __restrict__ out,
                                                 const float* __restrict__ gain, const float* __restrict__ sh, const float* __restrict__ sc, int lane) {
    asm volatile("" : "+v"(lane));
    f32x4 v[4][2]; float ss = 0.f; float ra = 1.0f;
    if (rsa_row) { const f32x4 q0 = *(const f32x4*)rsa_row, q1 = *(const f32x4*)(rsa_row + 4); ra = 1.0f / sqrtf((((q0.x + q0.y) + (q0.z + q0.w)) + ((q1.x + q1.y) + (q1.z + q1.w))) * (1.f / AW) + EPS); }
    if (part) {
#pragma unroll
        for (int j0 = 0; j0 < 4; j0 += 2) {
            v4u pp[2][8];
#pragma unroll
            for (int jj = 0; jj < 2; ++jj) { const int e = 8 * lane + 512 * (j0 + jj); v[j0 + jj][0] = *(const f32x4*)(xin + e); v[j0 + jj][1] = *(const f32x4*)(xin + e + 4);
#pragma unroll
                for (int ks = 0; ks < 8; ++ks) pp[jj][ks] = *(const v4u*)(part + (size_t)ks * MC * DM + e); }
            asm volatile("" ::: "memory");
#pragma unroll
            for (int jj = 0; jj < 2; ++jj) { const int j = j0 + jj, e = 8 * lane + 512 * j;
                f32x4 q[8][2];
#pragma unroll
                for (int ks = 0; ks < 8; ++ks) { const v4u w = pp[jj][ks]; q[ks][0].x = bflo(w.x); q[ks][0].y = bfhi(w.x); q[ks][0].z = bflo(w.y); q[ks][0].w = bfhi(w.y); q[ks][1].x = bflo(w.z); q[ks][1].y = bfhi(w.z); q[ks][1].z = bflo(w.w); q[ks][1].w = bfhi(w.w); }
#pragma unroll
                for (int h = 0; h < 2; ++h) {
                    const f32x4 pa = (q[0][h] + q[1][h]) + (q[2][h] + q[3][h]), pc = (q[4][h] + q[5][h]) + (q[6][h] + q[7][h]);
                    v[j][h] = v[j][h] + *(const f32x4*)(gate + e + 4 * h) * (pa * ra + pc);
                    *(f32x4*)(xout + e + 4 * h) = v[j][h]; } }
            asm volatile("" ::: "memory");
        }
    } else {
#pragma unroll
        for (int j = 0; j < 4; ++j) { const int e = 8 * lane + 512 * j; v[j][0] = *(const f32x4*)(xin + e); v[j][1] = *(const f32x4*)(xin + e + 4); }
    }
#pragma unroll
    for (int j = 0; j < 4; ++j)
#pragma unroll
        for (int h = 0; h < 2; ++h) ss += (v[j][h].x * v[j][h].x + v[j][h].y * v[j][h].y) + (v[j][h].z * v[j][h].z + v[j][h].w * v[j][h].w);
    const float rstd = 1.0f / sqrtf(wave_sum(ss) * (1.f / DM) + EPS);
#pragma unroll
    for (int j = 0; j < 4; ++j) { const int e = 8 * lane + 512 * j; f32x4 y[2];
#pragma unroll
        for (int h = 0; h < 2; ++h) { const f32x4 g = *(const f32x4*)(gain + e + 4 * h), sv = *(const f32x4*)(sc + e + 4 * h), b = *(const f32x4*)(sh + e + 4 * h); y[h] = v[j][h] * rstd * (g * (sv + 1.0f)) + b; }
        v4u w; w.x = pk2(y[0].x, y[0].y); w.y = pk2(y[0].z, y[0].w); w.z = pk2(y[1].x, y[1].y); w.w = pk2(y[1].z, y[1].w);
        *(v4u*)(out + e) = w; }
}
__device__ __forceinline__ void norm_mod_phase(const float* xlat, const bf16* xlat_b, const float* xctx, float* xcout, const bf16* part, const float* cgate, const float* rsa_ctx, bool do_ctx, bf16* H, const float* gain, const float* modl, int shc, int scc, int bid, int G, int wave, int lane) {
    for (int c = bid; c < 256; c += G) {
        { const int r = c >> 6, row0 = 64 * c + 8 * wave;
          if (xlat_b) norm_mod_rows_b(xlat_b + (size_t)row0 * DM, H + (size_t)row0 * DM, 8, gain, modl + (size_t)r * MODW + shc * DM, modl + (size_t)r * MODW + scc * DM, lane);
          else norm_mod_rows(xlat + (size_t)row0 * DM, H + (size_t)row0 * DM, 8, gain, modl + (size_t)r * MODW + shc * DM, modl + (size_t)r * MODW + scc * DM, lane); }
        if (wave < 4 && do_ctx) { const int row = 4 * c + wave;
          ctx_fix_norm_row(xctx + (size_t)row * DM, part ? part + (size_t)row * DM : nullptr, cgate, rsa_ctx ? rsa_ctx + (size_t)row * 8 : nullptr, xcout + (size_t)row * DM, H + (size_t)(ML + row) * DM, gain, modl + (size_t)4 * MODW + shc * DM, modl + (size_t)4 * MODW + scc * DM, lane); }
    }
}

__device__ __forceinline__ void token_rows(const bf16* __restrict__ QKV, bf16* __restrict__ Ql, bf16* __restrict__ Qc, bf16* __restrict__ Kb, bf16* __restrict__ Vb, bf16* __restrict__ MRG,
                                           const float* __restrict__ qg_, const float* __restrict__ kg_, const float* __restrict__ cw, const float* __restrict__ cb, const float* __restrict__ cg_,
                                           const LAS f32x2* rope, int b, int t0, int n, bool latent, int lane) {
    const int seq_len = latent ? SEQ : CTX, rbase = latent ? b * SEQ : ML + b * CTX;
    const int j = lane & 7, h = lane >> 3;
    {
        float qg[16], kg[16];
        ld16f(qg_ + 16 * j, qg); ld16f(kg_ + 16 * j, kg);
#pragma unroll
        for (int e = 0; e < 16; ++e) qg[e] *= 0.12751743074602132f;
        const int l5 = lane & 31, isv = l5 >> 4, kvh = (l5 >> 3) & 1;
        const float sgn = (j & 2) ? 1.f : -1.f;
        const int qoff = C_Q + 128 * h + 16 * j, koff = C_K + 128 * kvh + 16 * j;
        Raw16 rq = ldraw16(QKV + (size_t)(rbase + t0) * INW + qoff), rk = ldraw16(QKV + (size_t)(rbase + t0) * INW + koff);
        for (int i = 0; i < n; ++i) {
            const int t = t0 + i;
            const Raw16 cq = rq, ck = rk;
            if (i + 1 < n) { const bf16* nsrc = QKV + (size_t)(rbase + t + 1) * INW; rq = ldraw16(nsrc + qoff); rk = ldraw16(nsrc + koff); }
            float cs[16], sn[16];
            if (latent) { const int pos = (j & 4) ? (t & 63) : (t >> 6); const LAS f32x2* tp = rope + pos * 32 + 16 * (j & 1);
#pragma unroll
                for (int e = 0; e < 16; ++e) { const f32x2 v = tp[e]; cs[e] = v.x; sn[e] = v.y; } }
            else {
#pragma unroll
                for (int e = 0; e < 16; ++e) { cs[e] = 1.f; sn[e] = 0.f; } }
            {
                float x[16]; unpack16(cq, x);
                float ss = 0.f;
#pragma unroll
                for (int e = 0; e < 16; ++e) ss += x[e] * x[e];
                ss += __shfl_xor(ss, 1); ss += __shfl_xor(ss, 2); ss += __shfl_xor(ss, 4);
                const float rstd = 1.0f / sqrtf(ss * (1.f / HD) + EPS);
#pragma unroll
                for (int e = 0; e < 16; ++e) x[e] = x[e] * rstd * qg[e];
                float y[16];
#pragma unroll
                for (int e = 0; e < 16; ++e) { const float p = __shfl_xor(x[e], 2); y[e] = x[e] * cs[e] + sgn * p * sn[e]; }
                bf16* dst = latent ? Ql + ((size_t)(b * NH + h) * SEQ + t) * HD + 16 * j : Qc + ((size_t)(b * NH + h) * CTX + t) * HD + 16 * j;
                st16(dst, y);
            }
            {
                float x[16]; unpack16(ck, x);
                float ss = 0.f;
#pragma unroll
                for (int e = 0; e < 16; ++e) ss += x[e] * x[e];
                ss += __shfl_xor(ss, 1); ss += __shfl_xor(ss, 2); ss += __shfl_xor(ss, 4);
                const float rstd = 1.0f / sqrtf(ss * (1.f / HD) + EPS);
                float y[16];
#pragma unroll
                for (int e = 0; e < 16; ++e) { const float xn = x[e] * rstd * kg[e]; const float p = __shfl_xor(xn, 2); const float kr = xn * cs[e] + sgn * p * sn[e]; y[e] = isv ? x[e] : kr; }
                const int pos = latent ? t : SEQ + t;
                bf16* dst = (isv ? Vb : Kb) + ((size_t)(b * NKV + kvh) * SKV + pos) * HD + 16 * j;
                if (lane < 16) st16(dst, y);
            }
        }
    }
    {
        const int ch = 16 * lane;
        float w0[16], w1[16], w2[16], bs[16], cg[16];
        ld16f(cw + ch, w0); ld16f(cw + CW + ch, w1); ld16f(cw + 2 * CW + ch, w2); ld16f(cb + ch, bs); ld16f(cg_ + ch, cg);
        float zp[16], zc[16], zn[16];
#define LOADZ(dst, tt) do { ld16(QKV + (size_t)(rbase + (tt)) * INW + C_Z + ch, dst); } while (0)
#define ZEROZ(dst) do { _Pragma("unroll") for (int e = 0; e < 16; ++e) dst[e] = 0.f; } while (0)
        if (t0 > 0) LOADZ(zp, t0 - 1); else ZEROZ(zp);
        LOADZ(zc, t0);
        const bf16* row0 = QKV + (size_t)(rbase + t0) * INW;
        Raw16 rgb = ldraw16(row0 + C_GB + ch), rz = rgb;
        if (t0 + 1 < seq_len) rz = ldraw16(row0 + INW + C_Z + ch);
        for (int i = 0; i < n; ++i) {
            const int t = t0 + i;
            const Raw16 cgb = rgb, cz = rz;
            if (i + 1 < n) { const bf16* nrow = QKV + (size_t)(rbase + t + 1) * INW; rgb = ldraw16(nrow + C_GB + ch);
                if (t + 2 < seq_len) rz = ldraw16(nrow + INW + C_Z + ch); }
            if (t + 1 < seq_len) unpack16(cz, zn);
            else ZEROZ(zn);
            float gb[16]; unpack16(cgb, gb);
            float y[16]; float ss = 0.f;
#pragma unroll
            for (int e = 0; e < 16; ++e) { const float cv = zp[e] * w0[e] + zc[e] * w1[e] + zn[e] * w2[e] + bs[e]; y[e] = gb[e] * cv; ss += y[e] * y[e]; }
            const float rstd = 1.0f / sqrtf(wave_sum(ss) * (1.f / CW) + EPS);
#pragma unroll
            for (int e = 0; e < 16; ++e) y[e] = y[e] * rstd * cg[e];
            st16(MRG + (size_t)(rbase + t) * DM + AW + ch, y);
#pragma unroll
            for (int e = 0; e < 16; ++e) { zp[e] = zc[e]; zc[e] = zn[e]; }
        }
#undef LOADZ
#undef ZEROZ
    }
}

__device__ __forceinline__ void attn_norm_rows(const float* __restrict__ ao, bf16* __restrict__ mrg, int nrows, const float* __restrict__ ag_, int lane) {
    f32x4 ag[4];
#pragma unroll
    for (int j = 0; j < 4; ++j) ag[j] = *(const f32x4*)(ag_ + 4 * lane + 256 * j);
    for (int i = 0; i < nrows; ++i) {
        const f32x4* xr = (const f32x4*)(ao + (size_t)i * AW) + lane;
        f32x4 v[4]; float ss = 0.f;
#pragma unroll
        for (int j = 0; j < 4; ++j) { v[j] = xr[64 * j]; ss += (v[j].x * v[j].x + v[j].y * v[j].y) + (v[j].z * v[j].z + v[j].w * v[j].w); }
        const float rstd = 1.0f / sqrtf(wave_sum(ss) * (1.f / AW) + EPS);
        v2u* o8 = (v2u*)(mrg + (size_t)i * DM) + lane;
#pragma unroll
        for (int j = 0; j < 4; ++j) { const f32x4 y = v[j] * rstd * ag[j]; v2u w; w.x = pk2(y.x, y.y); w.y = pk2(y.z, y.w); o8[64 * j] = w; }
    }
}

struct Args { const float* in[18]; float* out; unsigned char* ws; };
typedef const __attribute__((address_space(4))) Args* KArgs;
__device__ __forceinline__ int lane_id() { unsigned z = 0u; asm volatile("" : "+v"(z)); return (int)__builtin_amdgcn_mbcnt_hi(~0u, __builtin_amdgcn_mbcnt_lo(~0u, z)); }
__device__ __forceinline__ KArgs fresh_args() { KArgs p = (KArgs)__builtin_amdgcn_kernarg_segment_ptr(); asm volatile("" : "+s"(p)); return p; }
__device__ __forceinline__ int fresh_int(int v) { asm volatile("" : "+s"(v)); return v; }
#define BID() fresh_int((int)blockIdx.x)

struct Ptrs {
    const float *x_in, *c_in, *ctx_in, *cctx_in, *w_ada, *b_ada, *norm1_g, *w_in, *q_norm_g, *k_norm_g, *conv_w, *conv_b, *attn_out_g, *conv_out_g, *w_out, *norm2_g, *w_mlp_in, *w_mlp_out;
    float* out; float* MOD; float* XC; bf16* WT; bf16* H; bf16* HB; bf16* QKV; bf16* Qb; bf16* Qc; bf16* Kb; bf16* Vb; bf16* MRG; bf16* PART; float* RSA; unsigned* ctl; bf16* XB;
};
__device__ __forceinline__ Ptrs make_ptrs(KArgs a) {
    Ptrs p; unsigned char* ws = a->ws;
    p.x_in = a->in[0]; p.c_in = a->in[1]; p.ctx_in = a->in[2]; p.cctx_in = a->in[3]; p.w_ada = a->in[4]; p.b_ada = a->in[5]; p.norm1_g = a->in[6]; p.w_in = a->in[7];
    p.q_norm_g = a->in[8]; p.k_norm_g = a->in[9]; p.conv_w = a->in[10]; p.conv_b = a->in[11]; p.attn_out_g = a->in[12]; p.conv_out_g = a->in[13]; p.w_out = a->in[14]; p.norm2_g = a->in[15];
    p.w_mlp_in = a->in[16]; p.w_mlp_out = a->in[17]; p.out = a->out;
    p.MOD = (float*)(ws + WS_MOD); p.XC = (float*)(ws + WS_XC); p.WT = (bf16*)(ws + WS_W); p.H = (bf16*)(ws + WS_H);
    p.HB = (bf16*)(ws + WS_BIG); p.QKV = (bf16*)(ws + WS_BIG + BIG_QKV); p.Qb = (bf16*)(ws + WS_BIG + BIG_Q); p.Qc = p.Qb + (size_t)ML * AW;
    p.Kb = (bf16*)(ws + WS_BIG + BIG_K); p.Vb = (bf16*)(ws + WS_BIG + BIG_V); p.MRG = (bf16*)(ws + WS_MRG); p.PART = (bf16*)(ws + WS_PART); p.RSA = (float*)(ws + WS_RSA); p.ctl = (unsigned*)(ws + WS_CTL); p.XB = (bf16*)(ws + WS_AO);
    return p;
}

__device__ __forceinline__ void silu_table(const float* c_in, const float* cctx_in, LAS unsigned char* L, int tid) {
    LAS float* sil = (LAS float*)(L + RING_OFF);
    for (int idx = tid; idx < 5 * DM; idx += NWAVES * 64) { const int r = idx >> 11, k = idx & (DM - 1); const float v = (r < 4) ? c_in[r * DM + k] : cctx_in[k]; sil[idx] = v / (1.0f + __expf(-v)); }
    __syncthreads();
}
#define GRID_BAR() do { XcdBarrier b_; b_.bar = (unsigned*)(fresh_args()->ws + WS_CTL) + CW_BAR; b_.x = xb_xcc_id(); b_.st = (volatile LAS unsigned*)(L + MISC_OFF) + 8; xcd_barrier(b_, fresh_int(wave_s) == 0 && lane_id() == 0); } while (0)
__global__ void __launch_bounds__(NWAVES * 64, 2) fwd_kernel(Args args_unused) {
    extern __shared__ __attribute__((aligned(16))) unsigned char lds[];
    LAS unsigned char* L = (LAS unsigned char*)lds;
    const int wave_s = __builtin_amdgcn_readfirstlane((int)threadIdx.x >> 6);
    {
        volatile LAS unsigned* MISC = (volatile LAS unsigned*)(L + MISC_OFF);
        const int tid = (fresh_int(wave_s) * 64 + lane_id());
        for (int u = tid; u < 64; u += NWAVES * 64) MISC[u] = 0u;
        {
            LAS f32x2* rope = (LAS f32x2*)(L + ROPE_OFF);
            for (int idx = tid; idx < 2048; idx += NWAVES * 64) { const int pos = idx >> 5, i = idx & 31;
                const float f = exp2f(-(float)i * (13.287712379549449f / 32.f)); const float a = (float)pos * f;
                f32x2 v; v.x = __cosf(a); v.y = __sinf(a); rope[idx] = v; }
        }
        __syncthreads();
        const Ptrs P = make_ptrs(fresh_args());
        (void)xcd_barrier_post(P.ctl + CW_BAR, MISC + 8, tid == 0);
    }

    {
        const Ptrs P = make_ptrs(fresh_args()); const int tid = (fresh_int(wave_s) * 64 + lane_id()), lane = tid & 63, wave = __builtin_amdgcn_readfirstlane(tid >> 6), G = fresh_int((int)gridDim.x);
        LAS float* sil = (LAS float*)(L + RING_OFF); LAS float* red = sil + 5 * DM;
        silu_table(P.c_in, P.cctx_in, L, tid);
        if (G == 256) { for (int it = BID(); it < 192 + 8 * (NL - 1); it += G) adaln_item(P.w_ada, P.b_ada, P.MOD, sil, red, it < 192 ? it : (1 + (it - 192) / 8) * 192 + 184 + (it - 192) % 8, tid, wave, lane); }
        else { for (int it = BID(); it < NL * 192; it += G) adaln_item(P.w_ada, P.b_ada, P.MOD, sil, red, it, tid, wave, lane); }
        __syncthreads();
        LAS float* scr = (LAS float*)(L + RING_OFF + wave * 16384);
        constexpr int I_IN = (DM / 64) * (INW / 32), I_OUT = (DM / 64) * (DM / 32), I_1 = (DM / 64) * (FF / 32), I_2 = (FF / 64) * (DM / 32), I_LAYER = I_IN + I_OUT + I_1 + I_2;
        const int gw = BID() * NWAVES + wave, NGW = G * NWAVES;
        for (int it = gw; it < NL * I_LAYER; it += NGW) {
            const int l = it / I_LAYER; int r = it % I_LAYER; bf16* wl = P.WT + (size_t)l * W_LAYER_E;
            if (r < I_IN) { p0_transpose_item(P.w_in + (size_t)l * DM * INW, DM, INW, wl, scr, r, lane, true); continue; } r -= I_IN;
            if (r < I_OUT) { p0_transpose_item(P.w_out + (size_t)l * DM * DM, DM, DM, wl + W_IN_E, scr, r, lane); continue; } r -= I_OUT;
            if (r < I_1) { p0_transpose_item(P.w_mlp_in + (size_t)l * DM * FF, DM, FF, wl + W_IN_E + W_OUT_E, scr, r, lane); continue; } r -= I_1;
            p0_transpose_item(P.w_mlp_out + (size_t)l * FF * DM, FF, DM, wl + W_IN_E + W_OUT_E + W_1_E, scr, r, lane);
        }
    }
    GRID_BAR();

    for (int l = 0; l < NL; ++l) {
        {
            const Ptrs P = make_ptrs(fresh_args()); const int tid = (fresh_int(wave_s) * 64 + lane_id()), lane = tid & 63, wave = __builtin_amdgcn_readfirstlane(tid >> 6), G = fresh_int((int)gridDim.x);
            const float* xl_in = (l == 0) ? P.x_in : nullptr; const bf16* xl_b = (l == 0) ? nullptr : P.XB; const float* xc_in = (l == 0) ? P.ctx_in : P.XC;
            norm_mod_phase(xl_in, xl_b, xc_in, P.XC, (l == 0) ? nullptr : P.PART, P.MOD + (size_t)(l > 0 ? l - 1 : 0) * 5 * MODW + 4 * MODW + 5 * DM, nullptr, true, P.H, P.norm1_g + (size_t)l * DM, P.MOD + (size_t)l * 5 * MODW, 0, 1, BID(), G, wave, lane);
        }
        GRID_BAR();

        {
            const Ptrs P = make_ptrs(fresh_args()); const int G = fresh_int((int)gridDim.x);
            pg8::Gemm g{P.H, P.WT + (size_t)l * W_LAYER_E, MT, INW, DM}; pg8::StaticOrder S; S.init(MT, INW, DM, G, BID());
            pg8::EpiBf16<0, true> E{P.QKV, INW, P.Vb};
            pg8::gemm_phase<pg8::EpiBf16<0, true>, pg8::StaticOrder, true, true>(L + RING_OFF, g, S, E, fresh_int(wave_s));
            { const int rem = S.nwg % G, j = BID() - rem; if (l + 1 < NL && G == 256 && rem == 200 && j >= 0) { const int tid = (fresh_int(wave_s) * 64 + lane_id()), lane = tid & 63, wave = __builtin_amdgcn_readfirstlane(tid >> 6);
                silu_table(P.c_in, P.cctx_in, L, tid); adaln_item(P.w_ada, P.b_ada, P.MOD, (LAS float*)(L + RING_OFF), (LAS float*)(L + RING_OFF) + 5 * DM, (l + 1) * 192 + 128 + j, tid, wave, lane); } }
        }
        GRID_BAR();

        {
            const Ptrs P = make_ptrs(fresh_args()); const int tid = (fresh_int(wave_s) * 64 + lane_id()), lane = tid & 63, wave = __builtin_amdgcn_readfirstlane(tid >> 6), G = fresh_int((int)gridDim.x);
            const LAS f32x2* rope = (const LAS f32x2*)(L + ROPE_OFF);
            for (int c = BID(); c < 256; c += G) {
                const int b = c >> 6;
                token_rows(P.QKV, P.Qb, P.Qc, P.Kb, P.Vb, P.MRG, P.q_norm_g + l * HD, P.k_norm_g + l * HD, P.conv_w + (size_t)l * 3 * CW, P.conv_b + l * CW, P.conv_out_g + l * CW, rope, b, (c & 63) * 64 + 8 * wave, 8, true, lane);
                if (wave < 4) token_rows(P.QKV, P.Qb, P.Qc, P.Kb, P.Vb, P.MRG, P.q_norm_g + l * HD, P.k_norm_g + l * HD, P.conv_w + (size_t)l * 3 * CW, P.conv_b + l * CW, P.conv_out_g + l * CW, rope, b, (c & 63) * 4 + wave, 1, false, lane);
            }
        }
        GRID_BAR();

        {
            const Ptrs P = make_ptrs(fresh_args()); const int G = fresh_int((int)gridDim.x);
            const int nunits = (l == NL - 1) ? 512 : 544;
            for (int u = BID(); u < nunits; u += G) {
                const bf16 *q, *k, *v; bf16* o; float* rs; const float* gn; int seq;
                if (u < 512) { const int grp = u & 7, idx = u >> 3, b = grp >> 1, kv = grp & 1, h = kv * 4 + (idx >> 4), qb = idx & 15;
                    q = P.Qb + ((size_t)(b * NH + h) * SEQ + 256 * qb) * HD; k = P.Kb + (size_t)(b * NKV + kv) * SKV * HD; v = P.Vb + (size_t)(b * NKV + kv) * SKV * HD;
                    o = P.MRG + (size_t)(b * SEQ + 256 * qb) * DM + h * HD; rs = P.RSA + (size_t)(b * SEQ + 256 * qb) * 8 + h; gn = P.attn_out_g + l * AW + h * HD; seq = SKV; }
                else { const int cu = u - 512, b = cu >> 3, h = cu & 7, kv = h >> 2;
                    q = P.Qc + (size_t)(b * NH + h) * CTX * HD; k = P.Kb + ((size_t)(b * NKV + kv) * SKV + SEQ) * HD; v = P.Vb + ((size_t)(b * NKV + kv) * SKV + SEQ) * HD;
                    o = P.MRG + (size_t)(ML + b * CTX) * DM + h * HD; rs = P.RSA + (size_t)(ML + b * CTX) * 8 + h; gn = P.attn_out_g + l * AW + h * HD; seq = CTX; }
                attn::attn_dense_body(q, k, v, o, gn, rs, seq, (char*)lds + RING_OFF, (char*)lds + STASH_OFF, fresh_int(wave_s));
                __syncthreads();
            }
        }
        GRID_BAR();

        {
            const Ptrs P = make_ptrs(fresh_args()); const int G = fresh_int((int)gridDim.x); const int Mrows = (l == NL - 1) ? ML : MT;
            pg8::Gemm g{P.MRG, P.WT + (size_t)l * W_LAYER_E + W_IN_E, Mrows, DM, DM}; pg8::ResidOrder S; S.init(ML, DM, DM, G, BID(), l != NL - 1);
            pg8::EpiResid<true> E{(l == 0) ? P.x_in : nullptr, P.XB, nullptr, P.XB, P.MOD + (size_t)l * 5 * MODW + 2 * DM, MODW, P.PART, P.RSA, L + STASH_OFF};
            pg8::gemm_phase<pg8::EpiResid<true>, pg8::ResidOrder, true, true>(L + RING_OFF, g, S, E, fresh_int(wave_s));
        }
        GRID_BAR();

        {
            const Ptrs P = make_ptrs(fresh_args()); const int tid = (fresh_int(wave_s) * 64 + lane_id()), lane = tid & 63, wave = __builtin_amdgcn_readfirstlane(tid >> 6), G = fresh_int((int)gridDim.x);
            norm_mod_phase(nullptr, P.XB, (l == 0) ? P.ctx_in : P.XC, P.XC, P.PART, P.MOD + (size_t)l * 5 * MODW + 4 * MODW + 2 * DM, P.RSA + (size_t)ML * 8, l != NL - 1, P.H, P.norm2_g + (size_t)l * DM, P.MOD + (size_t)l * 5 * MODW, 3, 4, BID(), G, wave, lane);
        }
        GRID_BAR();

        {
            const Ptrs P = make_ptrs(fresh_args()); const int G = fresh_int((int)gridDim.x); const int Mrows = (l == NL - 1) ? ML : MT;
            pg8::Gemm g{P.H, P.WT + (size_t)l * W_LAYER_E + W_IN_E + W_OUT_E, Mrows, FF, DM}; pg8::StaticOrder S; S.init(Mrows, FF, DM, G, BID());
            pg8::EpiBf16<2> E{P.HB, FF, nullptr};
            pg8::gemm_phase<pg8::EpiBf16<2>, pg8::StaticOrder, true, true>(L + RING_OFF, g, S, E, fresh_int(wave_s));
            { const int rem = S.nwg % G, j = BID() - rem; if (l + 1 < NL && G == 256 && rem == 128 && j >= 0) { const int tid = (fresh_int(wave_s) * 64 + lane_id()), lane = tid & 63, wave = __builtin_amdgcn_readfirstlane(tid >> 6);
                silu_table(P.c_in, P.cctx_in, L, tid); adaln_item(P.w_ada, P.b_ada, P.MOD, (LAS float*)(L + RING_OFF), (LAS float*)(L + RING_OFF) + 5 * DM, (l + 1) * 192 + j, tid, wave, lane); } }
        }
        GRID_BAR();

        {
            const Ptrs P = make_ptrs(fresh_args()); const int G = fresh_int((int)gridDim.x); const int Mrows = (l == NL - 1) ? ML : MT;
            pg8::Gemm g{P.HB, P.WT + (size_t)l * W_LAYER_E + W_IN_E + W_OUT_E + W_1_E, Mrows, DM, FF}; pg8::ResidOrder S; S.init(ML, DM, FF, G, BID(), l != NL - 1);
            pg8::EpiResid<false> E{nullptr, P.XB, (l == NL - 1) ? P.out : nullptr, P.XB, P.MOD + (size_t)l * 5 * MODW + 5 * DM, MODW, P.PART, nullptr, L + STASH_OFF};
            pg8::gemm_phase<pg8::EpiResid<false>, pg8::ResidOrder, true, true>(L + RING_OFF, g, S, E, fresh_int(wave_s));
        }
        if (l != NL - 1) GRID_BAR();
    }
}

extern "C" void kernel_launch(void* const* d_in, const int* in_sizes, int n_in, void* d_out, int out_size, void* d_ws, size_t ws_size, hipStream_t stream) {
    static int grid = 0;
    if (grid == 0) {
        if (n_in != 18 || in_sizes[0] != ML * DM || out_size != ML * DM || ws_size < WS_END) {
            fprintf(stderr, "kernel_launch: shape mismatch: n_in %d in0 %d out %d ws %zu (need %zu)\n", n_in, n_in > 0 ? in_sizes[0] : -1, out_size, ws_size, (size_t)WS_END); grid = -1; return; }
        int dev = 0, cus = 0, per_cu = 0;
        if (hipGetDevice(&dev) != hipSuccess || hipDeviceGetAttribute(&cus, hipDeviceAttributeMultiprocessorCount, dev) != hipSuccess) { fprintf(stderr, "kernel_launch: device query failed\n"); grid = -1; return; }
        if (hipFuncSetAttribute((const void*)fwd_kernel, hipFuncAttributeMaxDynamicSharedMemorySize, LDS_BYTES) != hipSuccess) { fprintf(stderr, "kernel_launch: hipFuncSetAttribute failed\n"); grid = -1; return; }
        if (hipOccupancyMaxActiveBlocksPerMultiprocessor(&per_cu, (const void*)fwd_kernel, NWAVES * 64, LDS_BYTES) != hipSuccess || per_cu < 1)
            fprintf(stderr, "kernel_launch: note: occupancy query reports %d workgroups per CU\n", per_cu);
        (void)hipGetLastError();
        grid = cus < 256 ? (cus / 8) * 8 : 256;
        if (grid < 8) grid = cus;
    }
    if (grid < 0) return;
    if (hipMemsetAsync((char*)d_ws + WS_CTL, 0, CTL_ZERO_BYTES, stream) != hipSuccess) { fprintf(stderr, "kernel_launch: memset failed\n"); return; }
    Args a{};
    for (int i = 0; i < 18; ++i) a.in[i] = (const float*)d_in[i];
    a.out = (float*)d_out; a.ws = (unsigned char*)d_ws;
    hipLaunchKernelGGL(fwd_kernel, dim3(grid), dim3(NWAVES * 64), LDS_BYTES, stream, a);
    const hipError_t le = hipPeekAtLastError();
    if (le != hipSuccess) fprintf(stderr, "kernel_launch: launch failed: %s\n", hipGetErrorName(le));
}
```
